# Optimizing an MI355X kernel written in HIP

```python
import math
import jax, jax.numpy as jnp
from jax import lax
import numpy as np

D_MODEL = 2048
BATCH = 4
SEQ = 2048
DEPTH = 2

CHUNK = 64
N_META = 16
D_FF = 4 * D_MODEL
MIX_WIDTH = D_MODEL
POOL_WIDTH = MIX_WIDTH // 2
POOL_WINDOWS = (2, 4, 8, 16)
POOL_GROUP = POOL_WIDTH // len(POOL_WINDOWS)
SSM_WIDTH = MIX_WIDTH - POOL_WIDTH
SSM_GROUP_CH = 16
SSM_GROUPS = SSM_WIDTH // SSM_GROUP_CH
SSM_STATE = 64
DT_MIN = 0.001
DT_MAX = 0.1
HEAD_DIM = 128
N_HEADS = D_MODEL // HEAD_DIM
N_KV_HEADS = 4
KV_GROUP = N_HEADS // N_KV_HEADS
IDX_HEADS = 16
IDX_DIM = 64
ROPE_THETA = 500000.0
ROPE_FRAC = 4
TOPK_MAX = 256
Q_BLOCK = 128
EPS = 1e-6
N_EVEN = (DEPTH + 1) // 2
N_ODD = DEPTH // 2
Q_W = N_HEADS * HEAD_DIM
KV_W = N_KV_HEADS * HEAD_DIM
IQ_W = IDX_HEADS * IDX_DIM
C_IN_WIDTH = Q_W + 2 * KV_W + IQ_W + IDX_DIM + IDX_HEADS

kernel_name = 'hybrid_pool_s5_dsa_block'


def rms_norm(x, g):
    xf = x.astype(jnp.float32)
    y = xf * lax.rsqrt(jnp.mean(xf * xf, axis=-1, keepdims=True) + EPS)
    return (y * g.astype(jnp.float32)).astype(x.dtype)


def chunk_ids(T):
    t = jnp.arange(T)
    return jnp.where(t < N_META, 0, (t - N_META) // CHUNK + 1)


def rope_partial(x, pos):
    d = x.shape[-1]
    r = d // ROPE_FRAC
    half = r // 2
    inv = ROPE_THETA ** (-jnp.arange(half, dtype=jnp.float32) / half)
    ang = pos.astype(jnp.float32)[:, None] * inv[None, :]
    cos = jnp.cos(ang)[:, None, :]
    sin = jnp.sin(ang)[:, None, :]
    x1 = x[..., :half].astype(jnp.float32)
    x2 = x[..., half:r].astype(jnp.float32)
    rot = jnp.concatenate([x1 * cos - x2 * sin, x2 * cos + x1 * sin], axis=-1).astype(x.dtype)
    return jnp.concatenate([rot, x[..., r:]], axis=-1)


def pool_mixer(u, w, scale):
    T = u.shape[1]
    uf = u.astype(jnp.float32)
    cs = jnp.pad(jnp.cumsum(uf, axis=1), ((0, 0), (1, 0), (0, 0)))
    count = jnp.arange(1, T + 1, dtype=jnp.float32)[None, :, None]
    outs = []
    for g, win in enumerate(POOL_WINDOWS):
        sl = slice(g * POOL_GROUP, (g + 1) * POOL_GROUP)
        c = cs[..., sl]
        lower = jnp.pad(c, ((0, 0), (win, 0), (0, 0)))[:, 1:T + 1]
        mean = (c[:, 1:] - lower) / jnp.minimum(count, float(win))
        diff = (mean - uf[..., sl]).astype(u.dtype)
        outs.append(diff @ w[g])
    return jnp.concatenate(outs, axis=-1) * scale


def _ssm_combine(e1, e2):
    a1r, a1i, b1r, b1i = e1
    a2r, a2i, b2r, b2i = e2
    return (a2r * a1r - a2i * a1i,
            a2r * a1i + a2i * a1r,
            a2r * b1r - a2i * b1i + b2r,
            a2r * b1i + a2i * b1r + b2i)


def s5_mixer(u, lam_re, lam_im, log_dt, b_re, b_im, c_re, c_im, d, w_glu):
    Bsz, T, _ = u.shape
    f32 = jnp.float32
    uf = u.astype(f32).reshape(Bsz, T, SSM_GROUPS, SSM_GROUP_CH)
    dt = jnp.exp(log_dt.astype(f32))[:, None]
    ar = lam_re.astype(f32)
    ai = lam_im.astype(f32)
    mag = jnp.exp(dt * ar)
    abar_re = mag * jnp.cos(dt * ai)
    abar_im = mag * jnp.sin(dt * ai)
    den = ar * ar + ai * ai
    zr = abar_re - 1.0
    zi = abar_im
    f_re = (zr * ar + zi * ai) / den
    f_im = (zi * ar - zr * ai) / den
    br = b_re.astype(f32)
    bi = b_im.astype(f32)
    bb_re = f_re[..., None] * br - f_im[..., None] * bi
    bb_im = f_re[..., None] * bi + f_im[..., None] * br
    bu_re = jnp.einsum('btgc,gnc->btgn', uf, bb_re)
    bu_im = jnp.einsum('btgc,gnc->btgn', uf, bb_im)
    a_re = jnp.broadcast_to(abar_re, bu_re.shape)
    a_im = jnp.broadcast_to(abar_im, bu_re.shape)
    _, _, h_re, h_im = lax.associative_scan(_ssm_combine, (a_re, a_im, bu_re, bu_im), axis=1)
    y = (jnp.einsum('btgn,gcn->btgc', h_re, c_re.astype(f32))
         - jnp.einsum('btgn,gcn->btgc', h_im, c_im.astype(f32))
         + d.astype(f32) * uf)
    y = jax.nn.gelu(y.reshape(Bsz, T, SSM_WIDTH)).astype(u.dtype)
    return y * jax.nn.sigmoid(y @ w_glu)


def dsa_mixer(h, w_in, w_out):
    Bsz, T, _ = h.shape
    f32 = jnp.float32
    kk = min(TOPK_MAX, (T - N_META) // 4)
    proj = h @ w_in
    o = 0
    q = proj[..., o:o + Q_W].reshape(Bsz, T, N_HEADS, HEAD_DIM); o += Q_W
    k = proj[..., o:o + KV_W].reshape(Bsz, T, N_KV_HEADS, HEAD_DIM); o += KV_W
    v = proj[..., o:o + KV_W].reshape(Bsz, T, N_KV_HEADS, HEAD_DIM); o += KV_W
    qi = proj[..., o:o + IQ_W].reshape(Bsz, T, IDX_HEADS, IDX_DIM); o += IQ_W
    ki = proj[..., o:o + IDX_DIM]; o += IDX_DIM
    wi = proj[..., o:o + IDX_HEADS]
    pos = jnp.arange(T)
    q = rope_partial(q, pos)
    k = rope_partial(k, pos)
    qi = rope_partial(qi, pos)
    ki = rope_partial(ki[:, :, None, :], pos)[:, :, 0, :].astype(f32)
    cid = chunk_ids(T)
    nb = -(-T // Q_BLOCK)
    pad = nb * Q_BLOCK - T

    def to_blocks(a):
        a = jnp.pad(a, [(0, 0), (0, pad)] + [(0, 0)] * (a.ndim - 2))
        return a.reshape((Bsz, nb, Q_BLOCK) + a.shape[2:]).swapaxes(0, 1)

    cid_q = jnp.pad(cid, (0, pad), mode='edge').reshape(nb, Q_BLOCK)
    w_scale = (IDX_HEADS ** -0.5) * (IDX_DIM ** -0.5)
    att_scale = HEAD_DIM ** -0.5

    def block(args):
        qb, qib, wib, cq = args
        s_idx = jax.nn.relu(jnp.einsum('bqhd,bsd->bqhs', qib.astype(f32), ki))
        score = jnp.einsum('bqh,bqhs->bqs', wib.astype(f32) * w_scale, s_idx)
        allowed = cid[None, :] <= cq[:, None]
        score = jnp.where(allowed[None], score, -jnp.inf)
        _, idx = lax.top_k(score, kk)
        valid = cid[idx] <= cq[None, :, None]
        k_sel = jax.vmap(lambda kb, ib: kb[ib])(k, idx)
        v_sel = jax.vmap(lambda vb, ib: vb[ib])(v, idx)
        qg = qb.reshape(Bsz, Q_BLOCK, N_KV_HEADS, KV_GROUP, HEAD_DIM)
        logits = jnp.einsum('bqhgd,bqshd->bqhgs', qg, k_sel).astype(f32) * att_scale
        logits = jnp.where(valid[:, :, None, None, :], logits, -jnp.inf)
        p = jax.nn.softmax(logits, axis=-1).astype(v.dtype)
        ob = jnp.einsum('bqhgs,bqshd->bqhgd', p, v_sel)
        return ob.reshape(Bsz, Q_BLOCK, Q_W)

    out = lax.map(block, (to_blocks(q), to_blocks(qi), to_blocks(wi), cid_q))
    out = out.swapaxes(0, 1).reshape(Bsz, nb * Q_BLOCK, Q_W)[:, :T]
    return out @ w_out


def setup_inputs(seed: int = 0) -> dict:
    key = jax.random.key(seed)
    ks = jax.random.split(key, 24)
    f32 = jnp.float32

    def nrm(k, shape, s):
        return jax.random.normal(k, shape, f32) * s

    n_idx = jnp.arange(SSM_STATE, dtype=f32)
    return {
        'x': nrm(ks[0], (BATCH, SEQ, D_MODEL), 1.0),
        'meta': nrm(ks[1], (N_META, D_MODEL), 1.0),
        'norm_g': 1.0 + nrm(ks[2], (DEPTH, 4, D_MODEL), 0.02),
        'ab_w_in': nrm(ks[3], (N_EVEN, D_MODEL, MIX_WIDTH), D_MODEL ** -0.5),
        'pool_w': nrm(ks[4], (N_EVEN, len(POOL_WINDOWS), POOL_GROUP, POOL_GROUP), POOL_GROUP ** -0.5),
        'pool_scale': 1.0 + nrm(ks[5], (N_EVEN, POOL_WIDTH), 0.02),
        's5_lambda_re': -0.5 + nrm(ks[6], (N_EVEN, SSM_GROUPS, SSM_STATE), 0.01),
        's5_lambda_im': math.pi * n_idx + nrm(ks[7], (N_EVEN, SSM_GROUPS, SSM_STATE), 0.01),
        's5_log_dt': jax.random.uniform(ks[8], (N_EVEN, SSM_GROUPS), f32, math.log(DT_MIN), math.log(DT_MAX)),
        's5_b_re': nrm(ks[9], (N_EVEN, SSM_GROUPS, SSM_STATE, SSM_GROUP_CH), (2.0 * SSM_GROUP_CH) ** -0.5),
        's5_b_im': nrm(ks[10], (N_EVEN, SSM_GROUPS, SSM_STATE, SSM_GROUP_CH), (2.0 * SSM_GROUP_CH) ** -0.5),
        's5_c_re': nrm(ks[11], (N_EVEN, SSM_GROUPS, SSM_GROUP_CH, SSM_STATE), (2.0 * SSM_STATE) ** -0.5),
        's5_c_im': nrm(ks[12], (N_EVEN, SSM_GROUPS, SSM_GROUP_CH, SSM_STATE), (2.0 * SSM_STATE) ** -0.5),
        's5_d': nrm(ks[13], (N_EVEN, SSM_GROUPS, SSM_GROUP_CH), 1.0),
        's5_w_glu': nrm(ks[14], (N_EVEN, SSM_WIDTH, SSM_WIDTH), SSM_WIDTH ** -0.5),
        'ab_w_out': nrm(ks[15], (N_EVEN, MIX_WIDTH, D_MODEL), MIX_WIDTH ** -0.5),
        'c_w_in': nrm(ks[16], (N_ODD, D_MODEL, C_IN_WIDTH), D_MODEL ** -0.5),
        'c_w_out': nrm(ks[17], (N_ODD, Q_W, D_MODEL), Q_W ** -0.5),
        'mlp_w1': nrm(ks[18], (DEPTH, D_MODEL, D_FF), D_MODEL ** -0.5),
        'mlp_w2': nrm(ks[19], (DEPTH, D_FF, D_MODEL), D_FF ** -0.5),
    }


def reference(x, meta, norm_g, ab_w_in, pool_w, pool_scale, s5_lambda_re, s5_lambda_im, s5_log_dt,
              s5_b_re, s5_b_im, s5_c_re, s5_c_im, s5_d, s5_w_glu, ab_w_out, c_w_in, c_w_out,
              mlp_w1, mlp_w2):
    Bsz = x.shape[0]
    meta_b = jnp.broadcast_to(meta[None].astype(x.dtype), (Bsz, N_META, x.shape[-1]))
    h = jnp.concatenate([meta_b, x], axis=1)
    for layer in range(DEPTH):
        g = norm_g[layer]
        a = rms_norm(h, g[0])
        if layer % 2 == 0:
            e = layer // 2
            u = a @ ab_w_in[e]
            y_pool = pool_mixer(u[..., :POOL_WIDTH], pool_w[e], pool_scale[e])
            y_ssm = s5_mixer(u[..., POOL_WIDTH:], s5_lambda_re[e], s5_lambda_im[e], s5_log_dt[e],
                             s5_b_re[e], s5_b_im[e], s5_c_re[e], s5_c_im[e], s5_d[e], s5_w_glu[e])
            mix = jnp.concatenate([y_pool, y_ssm], axis=-1) @ ab_w_out[e]
        else:
            o = layer // 2
            mix = dsa_mixer(a, c_w_in[o], c_w_out[o])
        h = h + rms_norm(mix, g[1])
        a = rms_norm(h, g[2])
        f = jnp.square(jax.nn.relu(a @ mlp_w1[layer])) @ mlp_w2[layer]
        h = h + rms_norm(f, g[3])
    return h[:, N_META:]
```

```cpp
#include <hip/hip_runtime.h>
#include <hip/hip_fp16.h>
#include <hip/hip_cooperative_groups.h>
#include <cstdio>
#include <cstdint>
#include <cmath>
namespace cg = cooperative_groups;

constexpr int D = 2048, NMETA = 16, SEQ = 2048, T = 2064, DFF = 8192;
constexpr int MMAIN = 8192;
constexpr int MREAL = 8208;
constexpr int MP = 8448;
constexpr int CIN = 4176;
constexpr int QOFF = 0, KOFF = 2048, VOFF = 2560, QIOFF = 3072, KIOFF = 4096, WIOFF = 4160;
constexpr int SROW = 2112;
constexpr float EPS = 1e-6f;
constexpr int NTHREADS = 512;

struct Params { const float* in[20]; float* out; unsigned char* ws; };
enum { I_X = 0, I_META, I_NORMG, I_ABWIN, I_POOLW, I_POOLS, I_LRE, I_LIM, I_LOGDT, I_BRE, I_BIM, I_CRE, I_CIM, I_S5D, I_WGLU, I_ABWOUT, I_CWIN, I_CWOUT, I_W1, I_W2 };

constexpr size_t SZ = (size_t)MP * D * 4;
constexpr size_t OFF_H = 0, OFF_A = SZ, OFF_U = 2 * SZ, OFF_DY = 3 * SZ, OFF_CAT = 4 * SZ, OFF_BIG = 5 * SZ;
constexpr size_t OFF_SCORE = OFF_DY, OFF_MASK = OFF_CAT, OFF_O = OFF_A;
constexpr size_t WS_NEED = OFF_BIG + (size_t)MP * CIN * 4;

__device__ __forceinline__ int otid() { int t = threadIdx.x; asm volatile("" : "+v"(t)); return t; }
__device__ __forceinline__ int obid() { int t = blockIdx.x; asm volatile("" : "+s"(t)); return t; }
__device__ __forceinline__ int row_of(int b, int t) { return t < NMETA ? MMAIN + t : b * SEQ + (t - NMETA); }
__device__ __forceinline__ float wave_sum(float v) {
#pragma unroll
    for (int o = 1; o < 64; o <<= 1) v += __shfl_xor(v, o);
    return v;
}
__device__ __forceinline__ float wave_max(float v) {
#pragma unroll
    for (int o = 1; o < 64; o <<= 1) v = fmaxf(v, __shfl_xor(v, o));
    return v;
}
__device__ __forceinline__ float4 ld4(const float* p) { return *(const float4*)p; }
__device__ __forceinline__ float4 ld4(const __half* p) {
    const uint2 r = *(const uint2*)p; const __half2 a = *(const __half2*)&r.x, b = *(const __half2*)&r.y;
    const float2 fa = __half22float2(a), fb = __half22float2(b); return make_float4(fa.x, fa.y, fb.x, fb.y);
}

__device__ __forceinline__ void sincos_d(double x, double& sn, double& cs) {
    const double q = rint(x * 0.6366197723675814);
    double r = fma(-q, 1.5707963267948966, x); r = fma(-q, 6.123233995736766e-17, r);
    const double r2 = r * r;
    double sp = -1.0 / 6227020800.0; sp = fma(sp, r2, 1.0 / 39916800.0); sp = fma(sp, r2, -1.0 / 362880.0); sp = fma(sp, r2, 1.0 / 5040.0); sp = fma(sp, r2, -1.0 / 120.0); sp = fma(sp, r2, 1.0 / 6.0); sp = fma(sp, r2, -1.0); sp = -sp * r;
    double cp = 1.0 / 87178291200.0; cp = fma(cp, r2, -1.0 / 479001600.0); cp = fma(cp, r2, 1.0 / 3628800.0); cp = fma(cp, r2, -1.0 / 40320.0); cp = fma(cp, r2, 1.0 / 720.0); cp = fma(cp, r2, -1.0 / 24.0); cp = fma(cp, r2, 0.5); cp = fma(-cp, r2, 1.0);
    const int n = ((int)q) & 3;
    sn = (n == 0) ? sp : (n == 1) ? cp : (n == 2) ? -sp : -cp;
    cs = (n == 0) ? cp : (n == 1) ? -sp : (n == 2) ? -cp : sp;
}
__device__ __forceinline__ float rope_inv16(int idx) {
    const double r = 1.0 / sqrt(sqrt(sqrt(sqrt(500000.0))));
    double v = 1.0;
    for (int i = 0; i < idx; ++i) v *= r;
    return (float)v;
}

template <typename TA, class Epi>
__device__ __forceinline__ void gemm_naive(float* lds, const TA* A, int lda, const float* B, int ldb, int M, int N, int K, Epi epi) {
    const int tid = otid(), bid = obid(), ty = tid >> 4, tx = tid & 15;
    float* As = lds;
    float* Bs = lds + 16 * 132;
    const int ntm = M / 128, ntn = (N + 127) / 128;
    const int arow = tid >> 2, akq = tid & 3, bk = tid >> 5, bn = (tid & 31) * 4;
    for (int tile = bid; tile < ntm * ntn; tile += gridDim.x) {
        const int tm = tile % ntm, tn = tile / ntm, m0 = tm * 128, n0 = tn * 128;
        float acc[4][8];
#pragma unroll
        for (int i = 0; i < 4; ++i)
#pragma unroll
            for (int j = 0; j < 8; ++j) acc[i][j] = 0.f;
        for (int k0 = 0; k0 < K; k0 += 16) {
            const float4 av = ld4(A + (size_t)(m0 + arow) * lda + k0 + 4 * akq);
            float4 bv = make_float4(0.f, 0.f, 0.f, 0.f);
            if (n0 + bn < N) bv = *(const float4*)(B + (size_t)(k0 + bk) * ldb + n0 + bn);
            __syncthreads();
            As[(4 * akq + 0) * 132 + arow] = av.x; As[(4 * akq + 1) * 132 + arow] = av.y; As[(4 * akq + 2) * 132 + arow] = av.z; As[(4 * akq + 3) * 132 + arow] = av.w;
            *(float4*)(Bs + bk * 132 + bn) = bv;
            __syncthreads();
#pragma unroll
            for (int k = 0; k < 16; ++k) {
                const float4 a = *(const float4*)(As + k * 132 + ty * 4);
                const float4 b0 = *(const float4*)(Bs + k * 132 + tx * 4);
                const float4 b1 = *(const float4*)(Bs + k * 132 + 64 + tx * 4);
                const float aa[4] = {a.x, a.y, a.z, a.w};
                const float bb[8] = {b0.x, b0.y, b0.z, b0.w, b1.x, b1.y, b1.z, b1.w};
#pragma unroll
                for (int i = 0; i < 4; ++i)
#pragma unroll
                    for (int j = 0; j < 8; ++j) acc[i][j] = fmaf(aa[i], bb[j], acc[i][j]);
            }
        }
#pragma unroll
        for (int i = 0; i < 4; ++i)
#pragma unroll
            for (int j = 0; j < 8; ++j) {
                const int row = m0 + ty * 4 + i, col = n0 + (j < 4 ? tx * 4 + j : 64 + tx * 4 + (j - 4));
                if (col < N) epi(row, col, acc[i][j]);
            }
    }
}

__device__ __forceinline__ void init_rows(const Params& p, float* H, float* A) {
    const int tid_ = otid(), lane = tid_ & 63, gw = obid() * (NTHREADS / 64) + (tid_ >> 6), ngw = gridDim.x * (NTHREADS / 64);
    const float* g = p.in[I_NORMG];
    for (int row = gw; row < MP; row += ngw) {
        float4 h[8]; float ss = 0.f;
#pragma unroll
        for (int j = 0; j < 8; ++j) {
            const int c = 4 * lane + 256 * j;
            if (row < MMAIN) h[j] = ld4(p.in[I_X] + (size_t)row * D + c);
            else if (row < MREAL) h[j] = ld4(p.in[I_META] + (size_t)(row - MMAIN) * D + c);
            else h[j] = make_float4(0.f, 0.f, 0.f, 0.f);
            ss += h[j].x * h[j].x + h[j].y * h[j].y + h[j].z * h[j].z + h[j].w * h[j].w;
        }
        const float r = rsqrtf(wave_sum(ss) * (1.f / D) + EPS);
#pragma unroll
        for (int j = 0; j < 8; ++j) {
            const int c = 4 * lane + 256 * j; const float4 gg = ld4(g + c);
            *(float4*)(H + (size_t)row * D + c) = h[j];
            *(float4*)(A + (size_t)row * D + c) = make_float4(h[j].x * r * gg.x, h[j].y * r * gg.y, h[j].z * r * gg.z, h[j].w * r * gg.w);
        }
    }
}
__device__ __forceinline__ void rowpass(const float* MIX, const float* ga, const float* gb, float* H, float* A, float* OUT, int nrows) {
    const int tid_ = otid(), lane = tid_ & 63, gw = obid() * (NTHREADS / 64) + (tid_ >> 6), ngw = gridDim.x * (NTHREADS / 64);
    for (int row = gw; row < nrows; row += ngw) {
        float4 m[8], h[8]; float ss = 0.f;
#pragma unroll
        for (int j = 0; j < 8; ++j) {
            const int c = 4 * lane + 256 * j;
            m[j] = ld4(MIX + (size_t)row * D + c); h[j] = ld4(H + (size_t)row * D + c);
            ss += m[j].x * m[j].x + m[j].y * m[j].y + m[j].z * m[j].z + m[j].w * m[j].w;
        }
        const float r = rsqrtf(wave_sum(ss) * (1.f / D) + EPS);
        float s2 = 0.f;
#pragma unroll
        for (int j = 0; j < 8; ++j) {
            const int c = 4 * lane + 256 * j; const float4 gg = ld4(ga + c);
            h[j].x += m[j].x * r * gg.x; h[j].y += m[j].y * r * gg.y; h[j].z += m[j].z * r * gg.z; h[j].w += m[j].w * r * gg.w;
            s2 += h[j].x * h[j].x + h[j].y * h[j].y + h[j].z * h[j].z + h[j].w * h[j].w;
        }
        if (OUT) {
#pragma unroll
            for (int j = 0; j < 8; ++j) *(float4*)(OUT + (size_t)row * D + 4 * lane + 256 * j) = h[j];
        } else {
            const float r2 = rsqrtf(wave_sum(s2) * (1.f / D) + EPS);
#pragma unroll
            for (int j = 0; j < 8; ++j) {
                const int c = 4 * lane + 256 * j; const float4 gg = ld4(gb + c);
                *(float4*)(H + (size_t)row * D + c) = h[j];
                *(float4*)(A + (size_t)row * D + c) = make_float4(h[j].x * r2 * gg.x, h[j].y * r2 * gg.y, h[j].z * r2 * gg.z, h[j].w * r2 * gg.w);
            }
        }
    }
}

__device__ __forceinline__ void pool_diff(const float* U, float* DY) {
    const size_t total = (size_t)MREAL * 1024, stride = (size_t)gridDim.x * NTHREADS;
    for (size_t i = (size_t)obid() * NTHREADS + otid(); i < total; i += stride) {
        const int row = (int)(i >> 10), c = (int)(i & 1023);
        const int b = row < MMAIN ? row >> 11 : 0, t = row < MMAIN ? (row & 2047) + NMETA : row - MMAIN;
        const int win = 2 << (c >> 8);
        const int cnt = (t + 1) < win ? (t + 1) : win;
        float s = 0.f;
        for (int j = 0; j < cnt; ++j) s += U[(size_t)row_of(b, t - j) * D + c];
        DY[(size_t)row * D + c] = s / (float)cnt - U[(size_t)row * D + c];
    }
}

__device__ __forceinline__ float gelu_tanh(float x) {
    const float k0 = 0.7978845608028654f, k1 = 0.044715f;
    return 0.5f * x * (1.f + tanhf(k0 * (x + k1 * x * x * x)));
}

__device__ __forceinline__ void ssm_naive(const Params& p, const float* U, float* DY) {
    const int tid_ = otid(), lane = tid_ & 63, gw = obid() * (NTHREADS / 64) + (tid_ >> 6), ngw = gridDim.x * (NTHREADS / 64);
    for (int item = gw; item < 256; item += ngw) {
        const int b = item >> 6, g = item & 63, n = lane;
        const float dt = expf(p.in[I_LOGDT][g]);
        const float ar = p.in[I_LRE][g * 64 + n], ai = p.in[I_LIM][g * 64 + n];
        const float mag = expf(dt * ar); double sd, cd; sincos_d((double)(dt * ai), sd, cd); const float sn = (float)sd, cs = (float)cd;
        const float are = mag * cs, aim = mag * sn;
        const float den = ar * ar + ai * ai, zr = are - 1.f, zi = aim;
        const float fre = (zr * ar + zi * ai) / den, fim = (zi * ar - zr * ai) / den;
        float bbr[16], bbi[16], cr[16], ci[16];
#pragma unroll
        for (int c = 0; c < 16; ++c) {
            const float br = p.in[I_BRE][(g * 64 + n) * 16 + c], bi = p.in[I_BIM][(g * 64 + n) * 16 + c];
            bbr[c] = fre * br - fim * bi; bbi[c] = fre * bi + fim * br;
            cr[c] = p.in[I_CRE][(g * 16 + c) * 64 + n]; ci[c] = p.in[I_CIM][(g * 16 + c) * 64 + n];
        }
        const float dd = p.in[I_S5D][g * 16 + (lane & 15)];
        float hr = 0.f, hi = 0.f;
#pragma unroll 1
        for (int t = 0; t < T; ++t) {
            const int row = row_of(b, t);
            const float* ur = U + (size_t)row * D + 1024 + g * 16;
            const float4 u0 = ld4(ur), u1 = ld4(ur + 4), u2 = ld4(ur + 8), u3 = ld4(ur + 12);
            const float uu[16] = {u0.x, u0.y, u0.z, u0.w, u1.x, u1.y, u1.z, u1.w, u2.x, u2.y, u2.z, u2.w, u3.x, u3.y, u3.z, u3.w};
            float bur = 0.f, bui = 0.f;
#pragma unroll
            for (int c = 0; c < 16; ++c) { bur = fmaf(bbr[c], uu[c], bur); bui = fmaf(bbi[c], uu[c], bui); }
            const float nhr = are * hr - aim * hi + bur, nhi = are * hi + aim * hr + bui;
            hr = nhr; hi = nhi;
            float myy = 0.f;
#pragma unroll
            for (int c = 0; c < 16; ++c) { const float v = wave_sum(cr[c] * hr - ci[c] * hi); if (lane == c) myy = v; }
            if (lane < 16 && (t >= NMETA || b == 0)) {
                const float y = myy + dd * ur[lane];
                DY[(size_t)row * D + 1024 + g * 16 + lane] = gelu_tanh(y);
            }
        }
    }
}

__device__ __forceinline__ void rope_naive(float* PROJ) {
    const size_t total = (size_t)MREAL * 456, stride = (size_t)gridDim.x * NTHREADS;
    for (size_t i = (size_t)obid() * NTHREADS + otid(); i < total; i += stride) {
        const int row = (int)(i / 456); int r = (int)(i % 456);
        const int t = row < MMAIN ? (row & 2047) + NMETA : row - MMAIN;
        int col, half, idx;
        if (r < 256) { col = QOFF + (r >> 4) * 128; half = 16; idx = r & 15; }
        else if (r < 320) { r -= 256; col = KOFF + (r >> 4) * 128; half = 16; idx = r & 15; }
        else if (r < 448) { r -= 320; col = QIOFF + (r >> 3) * 64; half = 8; idx = r & 7; }
        else { r -= 448; col = KIOFF; half = 8; idx = r; }
        const float inv = rope_inv16(half == 16 ? idx : 2 * idx);
        const float ang = (float)t * inv;
        double sd, cd; sincos_d((double)ang, sd, cd);
        const float cs = (float)cd, sn = (float)sd;
        float* px = PROJ + (size_t)row * CIN + col;
        const float x1 = px[idx], x2 = px[half + idx];
        px[idx] = x1 * cs - x2 * sn; px[half + idx] = x2 * cs + x1 * sn;
    }
}

__device__ __forceinline__ void idx_scores(const float* PROJ, float* SCORE) {
    const int tid_ = otid(), lane = tid_ & 63, gw = obid() * (NTHREADS / 64) + (tid_ >> 6), ngw = gridDim.x * (NTHREADS / 64);
    for (int q = gw; q < MMAIN; q += ngw) {
        const int b = q >> 11, s = q & 2047, nall = 80 + 64 * (s >> 6);
        const float* qi = PROJ + (size_t)q * CIN + QIOFF;
        const float* wi = PROJ + (size_t)q * CIN + WIOFF;
        for (int t = lane; t < nall; t += 64) {
            const float* kp = PROJ + (size_t)row_of(b, t) * CIN + KIOFF;
            float4 kv[16];
#pragma unroll
            for (int j = 0; j < 16; ++j) kv[j] = ld4(kp + 4 * j);
            float score = 0.f;
#pragma unroll 1
            for (int h = 0; h < 16; ++h) {
                float dot = 0.f;
#pragma unroll
                for (int j = 0; j < 16; ++j) { const float4 qv = ld4(qi + h * 64 + 4 * j); dot += qv.x * kv[j].x + qv.y * kv[j].y + qv.z * kv[j].z + qv.w * kv[j].w; }
                score += (wi[h] * 0.03125f) * fmaxf(dot, 0.f);
            }
            SCORE[(size_t)q * SROW + t] = score;
        }
    }
}

__device__ __forceinline__ unsigned okey(float f) { const unsigned u = __float_as_uint(f); return (u & 0x80000000u) ? ~u : (u | 0x80000000u); }
__device__ __forceinline__ void select_topk(const float* SCORE, unsigned long long* MASK) {
    const int tid_ = otid(), lane = tid_ & 63, gw = obid() * (NTHREADS / 64) + (tid_ >> 6), ngw = gridDim.x * (NTHREADS / 64);
    for (int q = gw; q < MMAIN; q += ngw) {
        const int s = q & 2047, nall = 80 + 64 * (s >> 6);
        unsigned key[33];
#pragma unroll
        for (int i = 0; i < 33; ++i) { const int t = 64 * i + lane; key[i] = (t < nall) ? okey(SCORE[(size_t)q * SROW + t]) : 0u; }
        unsigned long long mymask = 0ull;
        if (nall <= 256) {
#pragma unroll
            for (int i = 0; i < 33; ++i) { const unsigned long long m = __ballot(64 * i + lane < nall); if (lane == i) mymask = m; }
        } else {
            unsigned tau = 0u;
#pragma unroll 1
            for (int bit = 31; bit >= 0; --bit) {
                const unsigned cand = tau | (1u << bit); int cnt = 0;
#pragma unroll
                for (int i = 0; i < 33; ++i) cnt += __popcll(__ballot(key[i] >= cand));
                if (cnt >= 256) tau = cand;
            }
            int ngt = 0;
#pragma unroll
            for (int i = 0; i < 33; ++i) ngt += __popcll(__ballot(key[i] > tau));
            const int need = 256 - ngt; int eqb = 0;
            const unsigned long long lt = (1ull << lane) - 1ull;
#pragma unroll
            for (int i = 0; i < 33; ++i) {
                const unsigned long long gm = __ballot(key[i] > tau), em = __ballot(key[i] == tau);
                const int rank = eqb + __popcll(em & lt);
                const unsigned long long sm = __ballot(key[i] == tau && rank < need);
                if (lane == i) mymask = gm | sm;
                eqb += __popcll(em);
            }
        }
        if (lane < 33) MASK[(size_t)q * 33 + lane] = mymask;
    }
}

__device__ __forceinline__ void attn_naive(float* lds, const float* PROJ, const unsigned long long* MASK, float* O) {
    const int tid_ = otid(), lane = tid_ & 63, wv = tid_ >> 6, gw = obid() * (NTHREADS / 64) + wv, ngw = gridDim.x * (NTHREADS / 64);
    int* list = (int*)(lds + wv * 640);
    float* pl = lds + wv * 640 + 256;
    float* ql = lds + wv * 640 + 512;
    for (int item = gw; item < MMAIN * 16; item += ngw) {
        const int q = item >> 4, hq = item & 15, b = q >> 11, kvh = hq >> 2;
        int base = 0;
        for (int i = 0; i < 33; ++i) {
            const unsigned long long w = MASK[(size_t)q * 33 + i];
            if ((w >> lane) & 1ull) list[base + __popcll(w & ((1ull << lane) - 1ull))] = 64 * i + lane;
            base += __popcll(w);
        }
        const int nk = base;
        const float* qp = PROJ + (size_t)q * CIN + QOFF + hq * 128;
        ql[lane] = qp[lane]; ql[64 + lane] = qp[64 + lane];
        __builtin_amdgcn_s_waitcnt(0); __builtin_amdgcn_wave_barrier();
        float lg[4]; float mx = -INFINITY;
#pragma unroll
        for (int j = 0; j < 4; ++j) {
            const int kk = lane + 64 * j; lg[j] = -INFINITY;
            if (kk < nk) {
                const float* kp = PROJ + (size_t)row_of(b, list[kk]) * CIN + KOFF + kvh * 128;
                float dot = 0.f;
#pragma unroll 4
                for (int d = 0; d < 128; d += 4) { const float4 kv = ld4(kp + d); dot += kv.x * ql[d] + kv.y * ql[d + 1] + kv.z * ql[d + 2] + kv.w * ql[d + 3]; }
                lg[j] = dot * 0.08838834764831845f;
            }
            mx = fmaxf(mx, lg[j]);
        }
        mx = wave_max(mx);
        float sm = 0.f;
#pragma unroll
        for (int j = 0; j < 4; ++j) { const int kk = lane + 64 * j; const float e = (kk < nk) ? expf(lg[j] - mx) : 0.f; sm += e; pl[kk] = e; }
        sm = wave_sum(sm);
        __builtin_amdgcn_s_waitcnt(0); __builtin_amdgcn_wave_barrier();
        float o0 = 0.f, o1 = 0.f;
#pragma unroll 2
        for (int kk = 0; kk < nk; ++kk) {
            const float* vp = PROJ + (size_t)row_of(b, list[kk]) * CIN + VOFF + kvh * 128;
            const float pw = pl[kk];
            o0 = fmaf(pw, vp[lane], o0); o1 = fmaf(pw, vp[64 + lane], o1);
        }
        const float inv = 1.f / sm;
        O[(size_t)q * D + hq * 128 + lane] = o0 * inv; O[(size_t)q * D + hq * 128 + 64 + lane] = o1 * inv;
        __builtin_amdgcn_s_waitcnt(0); __builtin_amdgcn_wave_barrier();
    }
}

__global__ void __launch_bounds__(NTHREADS) fwd(Params p) {
    cg::grid_group grid = cg::this_grid();
    __shared__ __attribute__((aligned(16))) float lds[8 * 640 > 2 * 16 * 132 ? 8 * 640 : 2 * 16 * 132];
    float* H = (float*)(p.ws + OFF_H); float* A = (float*)(p.ws + OFF_A); float* U = (float*)(p.ws + OFF_U);
    float* DY = (float*)(p.ws + OFF_DY); float* CAT = (float*)(p.ws + OFF_CAT);
    __half* HID = (__half*)(p.ws + OFF_BIG); float* PROJ = (float*)(p.ws + OFF_BIG);
    float* SCORE = (float*)(p.ws + OFF_SCORE); unsigned long long* MASK = (unsigned long long*)(p.ws + OFF_MASK); float* O = (float*)(p.ws + OFF_O);
    const float* ng = p.in[I_NORMG];

    init_rows(p, H, A);
    grid.sync();
    gemm_naive<float>(lds, A, D, p.in[I_ABWIN], D, MP, D, D, [=](int r, int c, float v) { U[(size_t)r * D + c] = v; });
    grid.sync();
    pool_diff(U, DY);
    ssm_naive(p, U, DY);
    grid.sync();
    for (int g = 0; g < 4; ++g) {
        const float* ps = p.in[I_POOLS];
        gemm_naive<float>(lds, DY + g * 256, D, p.in[I_POOLW] + (size_t)g * 256 * 256, 256, MP, 256, 256,
                          [=](int r, int c, float v) { CAT[(size_t)r * D + g * 256 + c] = v * ps[g * 256 + c]; });
    }
    gemm_naive<float>(lds, DY + 1024, D, p.in[I_WGLU], 1024, MP, 1024, 1024,
                      [=](int r, int c, float v) { const float y = DY[(size_t)r * D + 1024 + c]; CAT[(size_t)r * D + 1024 + c] = y / (1.f + expf(-v)); });
    grid.sync();
    gemm_naive<float>(lds, CAT, D, p.in[I_ABWOUT], D, MP, D, D, [=](int r, int c, float v) { U[(size_t)r * D + c] = v; });
    grid.sync();
    rowpass(U, ng + 1 * D, ng + 2 * D, H, A, nullptr, MP);
    grid.sync();
    gemm_naive<float>(lds, A, D, p.in[I_W1], DFF, MP, DFF, D, [=](int r, int c, float v) { const float z = fmaxf(v, 0.f); HID[(size_t)r * DFF + c] = __float2half(z * z); });
    grid.sync();
    gemm_naive<__half>(lds, HID, DFF, p.in[I_W2], D, MP, D, DFF, [=](int r, int c, float v) { U[(size_t)r * D + c] = v; });
    grid.sync();
    rowpass(U, ng + 3 * D, ng + 4 * D, H, A, nullptr, MP);
    grid.sync();
    gemm_naive<float>(lds, A, D, p.in[I_CWIN], CIN, MP, CIN, D, [=](int r, int c, float v) { PROJ[(size_t)r * CIN + c] = v; });
    grid.sync();
    rope_naive(PROJ);
    grid.sync();
    idx_scores(PROJ, SCORE);
    grid.sync();
    select_topk(SCORE, MASK);
    grid.sync();
    attn_naive(lds, PROJ, MASK, O);
    grid.sync();
    gemm_naive<float>(lds, O, D, p.in[I_CWOUT], D, MMAIN, D, D, [=](int r, int c, float v) { U[(size_t)r * D + c] = v; });
    grid.sync();
    rowpass(U, ng + 5 * D, ng + 6 * D, H, A, nullptr, MMAIN);
    grid.sync();
    gemm_naive<float>(lds, A, D, p.in[I_W1] + (size_t)D * DFF, DFF, MMAIN, DFF, D, [=](int r, int c, float v) { const float z = fmaxf(v, 0.f); HID[(size_t)r * DFF + c] = __float2half(z * z); });
    grid.sync();
    gemm_naive<__half>(lds, HID, DFF, p.in[I_W2] + (size_t)DFF * D, D, MMAIN, D, DFF, [=](int r, int c, float v) { U[(size_t)r * D + c] = v; });
    grid.sync();
    rowpass(U, ng + 7 * D, nullptr, H, nullptr, p.out, MMAIN);
}

extern "C" void kernel_launch(void* const* d_in, const int* in_sizes, int n_in, void* d_out, int out_size, void* d_ws, size_t ws_size, hipStream_t stream) {
    static int grid_blocks = 0;
    if (!grid_blocks) {
        if (n_in != 20 || out_size != MMAIN * D || ws_size < WS_NEED) { fprintf(stderr, "kernel_launch: unexpected shapes n_in %d out %d ws %zu (need %zu)\n", n_in, out_size, ws_size, (size_t)WS_NEED); grid_blocks = -1; return; }
        int dev = 0, cus = 0, per_cu = 0;
        hipGetDevice(&dev);
        hipDeviceGetAttribute(&cus, hipDeviceAttributeMultiprocessorCount, dev);
        hipOccupancyMaxActiveBlocksPerMultiprocessor(&per_cu, fwd, NTHREADS, 0);
        if (per_cu < 1) per_cu = 1;
        if (per_cu > 2) per_cu = 2;
        grid_blocks = cus * per_cu;
    }
    if (grid_blocks < 0) return;
    Params p{};
    for (int i = 0; i < 20; ++i) p.in[i] = (const float*)d_in[i];
    p.out = (float*)d_out; p.ws = (unsigned char*)d_ws;
    void* args[] = {&p};
    hipError_t e = hipLaunchCooperativeKernel((void*)fwd, dim3(grid_blocks), dim3(NTHREADS), args, 0, stream);
    if (e != hipSuccess) fprintf(stderr, "cooperative launch failed: %s (grid %d)\n", hipGetErrorString(e), grid_blocks);
}
```

```cpp
#include <hip/hip_runtime.h>
#include <hip/hip_fp16.h>
#include <hip/hip_cooperative_groups.h>
#include <cstdio>
#include <cstdint>
#include <cmath>
namespace cg = cooperative_groups;
__device__ __forceinline__ int otid() { int t = threadIdx.x; asm volatile("" : "+v"(t)); return t; }
__device__ __forceinline__ int obid() { int t = blockIdx.x; asm volatile("" : "+s"(t)); return t; }

namespace pg8 {
#define PG8_LAS __attribute__((address_space(3)))
typedef _Float16 f16_t;
typedef _Float16 f16x8 __attribute__((ext_vector_type(8)));
typedef float f32x4 __attribute__((ext_vector_type(4)));
typedef unsigned u32x4 __attribute__((ext_vector_type(4)));
constexpr int BM = 256, BK = 64, HALF = 128, HTB = HALF * BK * 2  , STAGE_BYTES = 8 * HTB, NXCD = 8, WGM = 8;

__host__ __device__ __forceinline__ int lds_byte(int r, int c) { const int st = (r >> 4) * 2 + (c >> 5), rr = r & 15, cc = c & 31, ob = rr * 64 + cc * 2; return st * 1024 + (ob ^ (((ob >> 9) & 1) << 5)); }
__host__ __device__ __forceinline__ void stage_rc(int b, int& R, int& C) { const int st = b / 1024, sb = b % 1024, swz = sb ^ (((sb >> 9) & 1) << 5); R = (st >> 1) * 16 + swz / 64; C = (st & 1) * 32 + (swz % 64) / 2; }
__host__ __device__ __forceinline__ int perm32(int rho) { const int n = rho >> 4, i = rho & 15; return 8 * (i >> 2) + 4 * n + (i & 3); }

struct Unit { int pm, pn; };
struct Gemm { const f16_t* A; const f16_t* Bt; int M, N, K, lda, ldb; };

struct StaticOrder {
    int nM, nN, nwg, G, c;
    __host__ __device__ void init(int M, int N, int G_, int c_) { nM = M / BM; nN = N / BM; nwg = nM * nN; G = G_; c = c_; }
    __host__ __device__ bool next(int i, Unit& u) const {
        const long L = (long)i * G + c; if (L >= nwg) return false;
        int wgid = (int)L; { const int q = nwg / NXCD, r = nwg % NXCD, xcd = wgid % NXCD, off = wgid / NXCD; wgid = (xcd < r ? xcd * (q + 1) : r * (q + 1) + (xcd - r) * q) + off; }
        const int nig = WGM * nN, gid = wgid / nig, fm = gid * WGM, gsz = (nM - fm) < WGM ? (nM - fm) : WGM;
        u.pm = fm + ((wgid % nig) % gsz); u.pn = (wgid % nig) / gsz; return true;
    }
    __device__ __forceinline__ void a_ready(const Unit&) const {}
    __device__ __forceinline__ void done(const Unit&) const {}
};


template <class Epi, class Sched, bool ALIGN_EPI = false, bool SP2 = false>
__device__ __forceinline__ void gemm_phase(PG8_LAS unsigned char* lds, const Gemm g, const Sched& S, const Epi& E) {
    const int tid = otid(), wid = __builtin_amdgcn_readfirstlane(tid >> 6), lane = tid & 63, wr = wid >> 2, wc = wid & 3, fr = lane & 15, fq = lane >> 4;
    const int K = g.K, nt = K / BK;
    unsigned voffA[2], voffB[2];
#pragma unroll
    for (int i = 0; i < 2; ++i) { int R, C; stage_rc(tid * 16 + i * 8192, R, C); const int Rb = Epi::PERM ? ((R & ~31) + perm32(R & 31)) : R;
        voffA[i] = (unsigned)(R * g.lda + C) * 2u; voffB[i] = (unsigned)(Rb * g.ldb + C) * 2u; }
    const size_t kstep = (size_t)(BK * 2);
    const size_t hstepA = (size_t)HALF * g.lda * 2, hstepB = (size_t)HALF * g.ldb * 2;
    const size_t tstepA = 2 * hstepA, tstepB = 2 * hstepB;
    const unsigned ldsw = (unsigned)wid * 1024u;
    const int aoff = lds_byte(wr * 64 + fr, fq * 8), boff = lds_byte(wc * 32 + fr, fq * 8);
#define PG8_SA(b, h) (((b) * 2 + (h)) * HTB)
#define PG8_SB(b, h) ((4 + (b) * 2 + (h)) * HTB)
#define PG8_STAGE(bufoff, gbase, voff) do { _Pragma("unroll") for (int _i = 0; _i < 2; ++_i) \
        __builtin_amdgcn_global_load_lds((const unsigned*)((const char*)(gbase) + (voff)[_i]), (PG8_LAS unsigned*)(lds + (bufoff) + ldsw + _i * 8192), 16, 0, 0); } while (0)
#define PG8_LDA(dst, b, h) do { _Pragma("unroll") for (int m = 0; m < 4; ++m) _Pragma("unroll") for (int k = 0; k < 2; ++k) dst[m][k] = *(const PG8_LAS f16x8*)(lds + PG8_SA(b, h) + aoff + m * 2048 + k * 1024); } while (0)
#define PG8_LDB(dst, b, h) do { _Pragma("unroll") for (int n = 0; n < 2; ++n) _Pragma("unroll") for (int k = 0; k < 2; ++k) dst[n][k] = *(const PG8_LAS f16x8*)(lds + PG8_SB(b, h) + boff + n * 2048 + k * 1024); } while (0)
#define PG8_MMA(ai, bj, At, Bt) do { __builtin_amdgcn_s_setprio(1); _Pragma("unroll") for (int m = 0; m < 4; ++m) _Pragma("unroll") for (int n = 0; n < 2; ++n) _Pragma("unroll") for (int k = 0; k < 2; ++k) \
        acc[ai][bj][m][n] = __builtin_amdgcn_mfma_f32_16x16x32_f16(Bt[n][k], At[m][k], acc[ai][bj][m][n], 0, 0, 0); __builtin_amdgcn_s_setprio(0); } while (0)
#define PG8_WAIT_V(n) asm volatile("s_waitcnt vmcnt(" #n ")" ::: "memory")
#define PG8_WAIT_L(n) asm volatile("s_waitcnt lgkmcnt(" #n ")" ::: "memory")
#define PG8_BAR __builtin_amdgcn_s_barrier()
#define PG8_SCHED __builtin_amdgcn_sched_barrier(0)
    Unit cur, nxt; int ui = 0;
    if (!S.next(0, cur)) return;
    f32x4 acc[2][2][4][2];
#pragma unroll
    for (int a = 0; a < 2; ++a)
#pragma unroll
        for (int b = 0; b < 2; ++b)
#pragma unroll
            for (int m = 0; m < 4; ++m)
#pragma unroll
                for (int n = 0; n < 2; ++n) acc[a][b][m][n] = (f32x4){0.f, 0.f, 0.f, 0.f};
    f16x8 At[4][2], B0[2][2], B1[2][2];
    const char* cA = (const char*)g.A + (size_t)cur.pm * tstepA; const char* cB = (const char*)g.Bt + (size_t)cur.pn * tstepB;
    S.a_ready(cur);
    if constexpr (SP2) {
        PG8_STAGE(PG8_SB(0, 0), cB, voffB); PG8_STAGE(PG8_SB(0, 1), cB + hstepB, voffB); PG8_STAGE(PG8_SA(0, 0), cA, voffA); PG8_STAGE(PG8_SA(0, 1), cA + hstepA, voffA);
        if (wr == 1) PG8_BAR;
        PG8_WAIT_V(2); PG8_BAR;
        PG8_STAGE(PG8_SB(1, 0), cB + kstep, voffB); PG8_STAGE(PG8_SA(1, 0), cA + kstep, voffA); PG8_STAGE(PG8_SB(1, 1), cB + hstepB + kstep, voffB);
        PG8_WAIT_V(6); PG8_BAR;
    } else {
        PG8_STAGE(PG8_SB(0, 0), cB, voffB); PG8_STAGE(PG8_SA(0, 0), cA, voffA); PG8_STAGE(PG8_SB(0, 1), cB + hstepB, voffB); PG8_STAGE(PG8_SA(0, 1), cA + hstepA, voffA);
        if (wr == 1) PG8_BAR;
        PG8_WAIT_V(4); PG8_BAR;
        PG8_STAGE(PG8_SB(1, 0), cB + kstep, voffB); PG8_STAGE(PG8_SA(1, 0), cA + kstep, voffA); PG8_STAGE(PG8_SB(1, 1), cB + hstepB + kstep, voffB);
        PG8_WAIT_V(6); PG8_BAR;
    }
    for (;;) {
        const bool has_next = S.next(ui + 1, nxt);
        const char* nA = has_next ? (const char*)g.A + (size_t)nxt.pm * tstepA : cA; const char* nB = has_next ? (const char*)g.Bt + (size_t)nxt.pn * tstepB : cB;
        for (int t = 0; t < nt; t += 2) {
            const bool last = (t == nt - 2);
            const char* a1 = cA + (size_t)(t + 1) * kstep;
            const char* a2 = last ? nA : cA + (size_t)(t + 2) * kstep; const char* b2 = last ? nB : cB + (size_t)(t + 2) * kstep;
            const char* a3 = a2 + kstep; const char* b3 = b2 + kstep;
            if (last && has_next) S.a_ready(nxt);
            if constexpr (SP2) {
            PG8_LDB(B0, 0, 0); PG8_LDB(B1, 0, 1); PG8_SCHED; PG8_LDA(At, 0, 0); PG8_STAGE(PG8_SA(1, 1), a1 + hstepA, voffA);
            PG8_WAIT_V(8); PG8_WAIT_L(0); PG8_BAR; PG8_MMA(0, 0, At, B0); PG8_MMA(0, 1, At, B1); PG8_BAR; PG8_SCHED;
            PG8_LDA(At, 0, 1); PG8_STAGE(PG8_SB(0, 0), b2, voffB); PG8_STAGE(PG8_SB(0, 1), b2 + hstepB, voffB); PG8_STAGE(PG8_SA(0, 0), a2, voffA);
            PG8_WAIT_V(8); PG8_WAIT_L(0); PG8_BAR; PG8_MMA(1, 0, At, B0); PG8_MMA(1, 1, At, B1); PG8_BAR; PG8_SCHED;
            PG8_LDB(B0, 1, 0); PG8_LDB(B1, 1, 1); PG8_SCHED; PG8_LDA(At, 1, 0); PG8_STAGE(PG8_SA(0, 1), a2 + hstepA, voffA);
            PG8_WAIT_V(8); PG8_WAIT_L(0); PG8_BAR; PG8_MMA(0, 0, At, B0); PG8_MMA(0, 1, At, B1); PG8_BAR; PG8_SCHED;
            PG8_LDA(At, 1, 1); PG8_STAGE(PG8_SB(1, 0), b3, voffB); PG8_STAGE(PG8_SB(1, 1), b3 + hstepB, voffB); PG8_STAGE(PG8_SA(1, 0), a3, voffA);
            PG8_WAIT_V(8); PG8_WAIT_L(0); PG8_BAR; PG8_MMA(1, 0, At, B0); PG8_MMA(1, 1, At, B1); PG8_BAR; PG8_SCHED;
            } else {
            PG8_LDB(B0, 0, 0); PG8_SCHED; PG8_LDA(At, 0, 0); PG8_STAGE(PG8_SA(1, 1), a1 + hstepA, voffA);
            PG8_WAIT_L(8); PG8_BAR; PG8_WAIT_L(0); PG8_MMA(0, 0, At, B0); PG8_BAR; PG8_SCHED;
            PG8_LDB(B1, 0, 1); PG8_STAGE(PG8_SB(0, 0), b2, voffB);
            PG8_BAR; PG8_WAIT_L(0); PG8_MMA(0, 1, At, B1); PG8_BAR;
            PG8_LDA(At, 0, 1); PG8_STAGE(PG8_SA(0, 0), a2, voffA);
            PG8_BAR; PG8_WAIT_L(0); PG8_MMA(1, 0, At, B0); PG8_BAR; PG8_SCHED;
            PG8_STAGE(PG8_SB(0, 1), b2 + hstepB, voffB);
            PG8_WAIT_V(6); PG8_BAR; PG8_MMA(1, 1, At, B1); PG8_BAR;
            PG8_LDB(B0, 1, 0); PG8_SCHED; PG8_LDA(At, 1, 0); PG8_STAGE(PG8_SA(0, 1), a2 + hstepA, voffA);
            PG8_WAIT_L(8); PG8_BAR; PG8_WAIT_L(0); PG8_MMA(0, 0, At, B0); PG8_BAR; PG8_SCHED;
            PG8_LDB(B1, 1, 1); PG8_STAGE(PG8_SB(1, 0), b3, voffB);
            PG8_BAR; PG8_WAIT_L(0); PG8_MMA(0, 1, At, B1); PG8_BAR;
            PG8_LDA(At, 1, 1); PG8_STAGE(PG8_SA(1, 0), a3, voffA);
            PG8_BAR; PG8_WAIT_L(0); PG8_MMA(1, 0, At, B0); PG8_BAR; PG8_SCHED;
            PG8_STAGE(PG8_SB(1, 1), b3 + hstepB, voffB);
            PG8_WAIT_V(6); PG8_BAR; PG8_MMA(1, 1, At, B1); PG8_BAR;
            }
        }
        if constexpr (ALIGN_EPI) { if (wr == 0) PG8_BAR; }
        if constexpr (!Epi::AFTER_DRAIN) { E(acc, cur, wr, wc, fr, fq); S.done(cur); }
        if (!has_next) break;
#pragma unroll
        for (int a = 0; a < 2; ++a)
#pragma unroll
            for (int b = 0; b < 2; ++b)
#pragma unroll
                for (int m = 0; m < 4; ++m)
#pragma unroll
                    for (int n = 0; n < 2; ++n) acc[a][b][m][n] = (f32x4){0.f, 0.f, 0.f, 0.f};
        cur = nxt; cA = nA; cB = nB; ++ui;
        if constexpr (ALIGN_EPI) { if (wr == 1) PG8_BAR; }
    }
    PG8_WAIT_V(0);
    if constexpr (!ALIGN_EPI) { if (wr == 0) PG8_BAR; }
    PG8_BAR;
    if constexpr (Epi::AFTER_DRAIN) { E.fused(acc, cur, wr, wc, fr, fq, lds, wid, lane); S.done(cur); }
#undef PG8_SA
#undef PG8_SB
#undef PG8_STAGE
#undef PG8_LDA
#undef PG8_LDB
#undef PG8_MMA
#undef PG8_WAIT_V
#undef PG8_WAIT_L
#undef PG8_BAR
#undef PG8_SCHED
}

template <class F> struct EpiRow8 {
    static constexpr bool PERM = true, AFTER_DRAIN = false;
    F f;
    __device__ __forceinline__ void operator()(const f32x4 (&acc)[2][2][4][2], const Unit& u, int wr, int wc, int fr, int fq) const {
        const int row0 = u.pm * BM + wr * 64 + fr, col0 = u.pn * BM + wc * 32 + 8 * fq;
#pragma unroll
        for (int ai = 0; ai < 2; ++ai)
#pragma unroll
            for (int m = 0; m < 4; ++m)
#pragma unroll
                for (int bj = 0; bj < 2; ++bj) f(row0 + ai * HALF + m * 16, col0 + bj * HALF, acc[ai][bj][m][0], acc[ai][bj][m][1]);
    }
};
}

#define LAS __attribute__((address_space(3)))
typedef _Float16 f16;
typedef float f32x4 __attribute__((ext_vector_type(4)));
typedef unsigned u32x4 __attribute__((ext_vector_type(4)));
typedef _Float16 h2v __attribute__((ext_vector_type(2)));

constexpr int D = 2048, NMETA = 16, SEQ = 2048, T = 2064, DFF = 8192;
constexpr int MMAIN = 8192;
constexpr int MREAL = 8208;
constexpr int MP = 8448;
constexpr int CIN = 4176, CINP = 4352;
constexpr int QOFF = 0, KOFF = 2048, VOFF = 2560, QIOFF = 3072, KIOFF = 4096, WIOFF = 4160;
constexpr int SROW = 2112;
constexpr float EPS = 1e-6f;
constexpr int NTHREADS = 512;
constexpr int LDS_BYTES = 147456;

struct Params { const float* in[20]; float* out; unsigned char* ws; };
enum { I_X = 0, I_META, I_NORMG, I_ABWIN, I_POOLW, I_POOLS, I_LRE, I_LIM, I_LOGDT, I_BRE, I_BIM, I_CRE, I_CIM, I_S5D, I_WGLU, I_ABWOUT, I_CWIN, I_CWOUT, I_W1, I_W2 };

constexpr size_t SZ4 = (size_t)MP * D * 4, SZ2 = (size_t)MP * D * 2;
constexpr size_t OFF_H = 0, OFF_A16 = OFF_H + SZ4, OFF_U16 = OFF_A16 + SZ2, OFF_DY16 = OFF_U16 + SZ2, OFF_CAT16 = OFF_DY16 + SZ2, OFF_BIG = OFF_CAT16 + SZ2;
constexpr size_t SZ_BIG = (size_t)MP * CIN * 4;
constexpr size_t OFF_MASK = OFF_BIG + SZ_BIG, SZ_MASK = (size_t)MMAIN * 33 * 8;
constexpr size_t OFF_W = OFF_MASK + SZ_MASK;
constexpr size_t OFF_SCORE = OFF_DY16, OFF_O16 = OFF_A16;
constexpr size_t W_IN = OFF_W, W_POOL = W_IN + (size_t)D * D * 2, W_GLU = W_POOL + (size_t)4 * 256 * 256 * 2, W_OUT = W_GLU + (size_t)1024 * 1024 * 2,
                 W_CIN = W_OUT + (size_t)D * D * 2, W_COUT = W_CIN + (size_t)CINP * D * 2, W_1 = W_COUT + (size_t)D * D * 2, W_2 = W_1 + (size_t)2 * D * DFF * 2,
                 WS_NEED = W_2 + (size_t)2 * D * DFF * 2;
static_assert(SZ_BIG >= (size_t)MP * DFF * 2, "BIG region holds HID16");
static_assert((size_t)MMAIN * SROW * 4 <= 2 * SZ2, "SCORE fits DY16+CAT16");

__device__ __forceinline__ int row_of(int b, int t) { return t < NMETA ? MMAIN + t : b * SEQ + (t - NMETA); }
__device__ __forceinline__ float wave_sum(float v) {
#pragma unroll
    for (int o = 1; o < 64; o <<= 1) v += __shfl_xor(v, o);
    return v;
}
__device__ __forceinline__ float wave_max(float v) {
#pragma unroll
    for (int o = 1; o < 64; o <<= 1) v = fmaxf(v, __shfl_xor(v, o));
    return v;
}
__device__ __forceinline__ float4 ld4(const float* p) { return *(const float4*)p; }
__device__ __forceinline__ unsigned pk2h(float a, float b) { h2v r; r.x = (_Float16)a; r.y = (_Float16)b; return __builtin_bit_cast(unsigned, r); }
__device__ __forceinline__ float2 up2h(unsigned u) { const h2v r = __builtin_bit_cast(h2v, u); return make_float2((float)r.x, (float)r.y); }
__device__ __forceinline__ float4 ld4(const f16* p) { const uint2 r = *(const uint2*)p; const float2 a = up2h(r.x), b = up2h(r.y); return make_float4(a.x, a.y, b.x, b.y); }
__device__ __forceinline__ void st4h(f16* p, float4 v) { uint2 r; r.x = pk2h(v.x, v.y); r.y = pk2h(v.z, v.w); *(uint2*)p = r; }
__device__ __forceinline__ void st8h(f16* p, f32x4 a, f32x4 b) { u32x4 w; w.x = pk2h(a[0], a[1]); w.y = pk2h(a[2], a[3]); w.z = pk2h(b[0], b[1]); w.w = pk2h(b[2], b[3]); *(u32x4*)p = w; }

__device__ __forceinline__ void sincos_d(double x, double& sn, double& cs) {
    const double q = rint(x * 0.6366197723675814);
    double r = fma(-q, 1.5707963267948966, x); r = fma(-q, 6.123233995736766e-17, r);
    const double r2 = r * r;
    double sp = -1.0 / 6227020800.0; sp = fma(sp, r2, 1.0 / 39916800.0); sp = fma(sp, r2, -1.0 / 362880.0); sp = fma(sp, r2, 1.0 / 5040.0); sp = fma(sp, r2, -1.0 / 120.0); sp = fma(sp, r2, 1.0 / 6.0); sp = fma(sp, r2, -1.0); sp = -sp * r;
    double cp = 1.0 / 87178291200.0; cp = fma(cp, r2, -1.0 / 479001600.0); cp = fma(cp, r2, 1.0 / 3628800.0); cp = fma(cp, r2, -1.0 / 40320.0); cp = fma(cp, r2, 1.0 / 720.0); cp = fma(cp, r2, -1.0 / 24.0); cp = fma(cp, r2, 0.5); cp = fma(-cp, r2, 1.0);
    const int n = ((int)q) & 3;
    sn = (n == 0) ? sp : (n == 1) ? cp : (n == 2) ? -sp : -cp;
    cs = (n == 0) ? cp : (n == 1) ? -sp : (n == 2) ? -cp : sp;
}
__device__ __forceinline__ float rope_inv16(int idx) {
    const double r = 1.0 / sqrt(sqrt(sqrt(sqrt(500000.0))));
    double v = 1.0;
    for (int i = 0; i < idx; ++i) v *= r;
    return (float)v;
}

__device__ __forceinline__ void cvt_item(const float* W, int K, int N, int NPAD, f16* WT, float* scr, int item, int lane) {
    const int nblk = NPAD / 32, kb = item / nblk, nb = item % nblk, k0 = 64 * kb, n0 = 32 * nb;
    const int n = n0 + (lane & 31);
#pragma unroll 8
    for (int i = 0; i < 32; ++i) { const int kk = 2 * i + (lane >> 5); scr[kk * 33 + (lane & 31)] = (n < N) ? W[(size_t)(k0 + kk) * N + n] : 0.f; }
    const int c = lane & 7;
#pragma unroll
    for (int j = 0; j < 4; ++j) { const int nn = (lane >> 3) + 8 * j; const float* s = scr + (8 * c) * 33 + nn;
        u32x4 o; o.x = pk2h(s[0 * 33], s[1 * 33]); o.y = pk2h(s[2 * 33], s[3 * 33]); o.z = pk2h(s[4 * 33], s[5 * 33]); o.w = pk2h(s[6 * 33], s[7 * 33]);
        *(u32x4*)(WT + (size_t)(n0 + nn) * K + k0 + 8 * c) = o; }
}
__device__ __forceinline__ void convert_weights(const Params& p, float* ldsf) {
    const int tid_ = otid(), lane = tid_ & 63, wv = tid_ >> 6, gw = obid() * (NTHREADS / 64) + wv, ngw = gridDim.x * (NTHREADS / 64);
    float* scr = ldsf + wv * (64 * 33);
    unsigned char* ws = p.ws;
    constexpr int I_IN = 32 * 64, I_PG = 4 * 8, I_GLU = 16 * 32, I_OUT = 32 * 64, I_CI = 32 * (CINP / 32), I_CO = 32 * 64, I_M1 = 32 * 256, I_M2 = 128 * 64;
    constexpr int NITEMS = I_IN + 4 * I_PG + I_GLU + I_OUT + I_CI + I_CO + 2 * I_M1 + 2 * I_M2;
    for (int it = gw; it < NITEMS; it += ngw) {
        int r = it;
        if (r < I_IN) { cvt_item(p.in[I_ABWIN], D, D, D, (f16*)(ws + W_IN), scr, r, lane); continue; } r -= I_IN;
        if (r < 4 * I_PG) { const int g = r / I_PG; cvt_item(p.in[I_POOLW] + (size_t)g * 65536, 256, 256, 256, (f16*)(ws + W_POOL) + (size_t)g * 65536, scr, r % I_PG, lane); continue; } r -= 4 * I_PG;
        if (r < I_GLU) { cvt_item(p.in[I_WGLU], 1024, 1024, 1024, (f16*)(ws + W_GLU), scr, r, lane); continue; } r -= I_GLU;
        if (r < I_OUT) { cvt_item(p.in[I_ABWOUT], D, D, D, (f16*)(ws + W_OUT), scr, r, lane); continue; } r -= I_OUT;
        if (r < I_CI) { cvt_item(p.in[I_CWIN], D, CIN, CINP, (f16*)(ws + W_CIN), scr, r, lane); continue; } r -= I_CI;
        if (r < I_CO) { cvt_item(p.in[I_CWOUT], D, D, D, (f16*)(ws + W_COUT), scr, r, lane); continue; } r -= I_CO;
        if (r < 2 * I_M1) { const int l = r / I_M1; cvt_item(p.in[I_W1] + (size_t)l * D * DFF, D, DFF, DFF, (f16*)(ws + W_1) + (size_t)l * D * DFF, scr, r % I_M1, lane); continue; } r -= 2 * I_M1;
        { const int l = r / I_M2; cvt_item(p.in[I_W2] + (size_t)l * D * DFF, DFF, D, D, (f16*)(ws + W_2) + (size_t)l * D * DFF, scr, r % I_M2, lane); }
    }
}

__device__ __forceinline__ void init_rows(const Params& p, float* H, f16* A) {
    const int tid_ = otid(), lane = tid_ & 63, gw = obid() * (NTHREADS / 64) + (tid_ >> 6), ngw = gridDim.x * (NTHREADS / 64);
    const float* g = p.in[I_NORMG];
    for (int row = gw; row < MP; row += ngw) {
        float4 h[8]; float ss = 0.f;
#pragma unroll
        for (int j = 0; j < 8; ++j) {
            const int c = 4 * lane + 256 * j;
            if (row < MMAIN) h[j] = ld4(p.in[I_X] + (size_t)row * D + c);
            else if (row < MREAL) h[j] = ld4(p.in[I_META] + (size_t)(row - MMAIN) * D + c);
            else h[j] = make_float4(0.f, 0.f, 0.f, 0.f);
            ss += h[j].x * h[j].x + h[j].y * h[j].y + h[j].z * h[j].z + h[j].w * h[j].w;
        }
        const float r = rsqrtf(wave_sum(ss) * (1.f / D) + EPS);
#pragma unroll
        for (int j = 0; j < 8; ++j) {
            const int c = 4 * lane + 256 * j; const float4 gg = ld4(g + c);
            *(float4*)(H + (size_t)row * D + c) = h[j];
            st4h(A + (size_t)row * D + c, make_float4(h[j].x * r * gg.x, h[j].y * r * gg.y, h[j].z * r * gg.z, h[j].w * r * gg.w));
        }
    }
}
__device__ __forceinline__ void rowpass(const f16* MIX, const float* ga, const float* gb, float* H, f16* A, float* OUT, int nrows) {
    const int tid_ = otid(), lane = tid_ & 63, gw = obid() * (NTHREADS / 64) + (tid_ >> 6), ngw = gridDim.x * (NTHREADS / 64);
    for (int row = gw; row < nrows; row += ngw) {
        float4 m[8], h[8]; float ss = 0.f;
#pragma unroll
        for (int j = 0; j < 8; ++j) {
            const int c = 4 * lane + 256 * j;
            m[j] = ld4(MIX + (size_t)row * D + c); h[j] = ld4(H + (size_t)row * D + c);
            ss += m[j].x * m[j].x + m[j].y * m[j].y + m[j].z * m[j].z + m[j].w * m[j].w;
        }
        const float r = rsqrtf(wave_sum(ss) * (1.f / D) + EPS);
        float s2 = 0.f;
#pragma unroll
        for (int j = 0; j < 8; ++j) {
            const int c = 4 * lane + 256 * j; const float4 gg = ld4(ga + c);
            h[j].x += m[j].x * r * gg.x; h[j].y += m[j].y * r * gg.y; h[j].z += m[j].z * r * gg.z; h[j].w += m[j].w * r * gg.w;
            s2 += h[j].x * h[j].x + h[j].y * h[j].y + h[j].z * h[j].z + h[j].w * h[j].w;
        }
        if (OUT) {
#pragma unroll
            for (int j = 0; j < 8; ++j) *(float4*)(OUT + (size_t)row * D + 4 * lane + 256 * j) = h[j];
        } else {
            const float r2 = rsqrtf(wave_sum(s2) * (1.f / D) + EPS);
#pragma unroll
            for (int j = 0; j < 8; ++j) {
                const int c = 4 * lane + 256 * j; const float4 gg = ld4(gb + c);
                *(float4*)(H + (size_t)row * D + c) = h[j];
                st4h(A + (size_t)row * D + c, make_float4(h[j].x * r2 * gg.x, h[j].y * r2 * gg.y, h[j].z * r2 * gg.z, h[j].w * r2 * gg.w));
            }
        }
    }
}

__device__ __forceinline__ void pool_diff(const f16* U, f16* DY) {
    const size_t total = (size_t)MREAL * 1024, stride = (size_t)gridDim.x * NTHREADS;
    for (size_t i = (size_t)obid() * NTHREADS + otid(); i < total; i += stride) {
        const int row = (int)(i >> 10), c = (int)(i & 1023);
        const int b = row < MMAIN ? row >> 11 : 0, t = row < MMAIN ? (row & 2047) + NMETA : row - MMAIN;
        const int win = 2 << (c >> 8);
        const int cnt = (t + 1) < win ? (t + 1) : win;
        float s = 0.f;
        for (int j = 0; j < cnt; ++j) s += (float)U[(size_t)row_of(b, t - j) * D + c];
        DY[(size_t)row * D + c] = (f16)(s / (float)cnt - (float)U[(size_t)row * D + c]);
    }
}

__device__ __forceinline__ float gelu_tanh(float x) {
    const float k0 = 0.7978845608028654f, k1 = 0.044715f;
    return 0.5f * x * (1.f + tanhf(k0 * (x + k1 * x * x * x)));
}

__device__ __forceinline__ void ssm_naive(const Params& p, const f16* U, f16* DY) {
    const int tid_ = otid(), lane = tid_ & 63, gw = obid() * (NTHREADS / 64) + (tid_ >> 6), ngw = gridDim.x * (NTHREADS / 64);
    for (int item = gw; item < 256; item += ngw) {
        const int b = item >> 6, g = item & 63, n = lane;
        const float dt = expf(p.in[I_LOGDT][g]);
        const float ar = p.in[I_LRE][g * 64 + n], ai = p.in[I_LIM][g * 64 + n];
        const float mag = expf(dt * ar); double sd, cd; sincos_d((double)(dt * ai), sd, cd); const float sn = (float)sd, cs = (float)cd;
        const float are = mag * cs, aim = mag * sn;
        const float den = ar * ar + ai * ai, zr = are - 1.f, zi = aim;
        const float fre = (zr * ar + zi * ai) / den, fim = (zi * ar - zr * ai) / den;
        float bbr[16], bbi[16], cr[16], ci[16];
#pragma unroll
        for (int c = 0; c < 16; ++c) {
            const float br = p.in[I_BRE][(g * 64 + n) * 16 + c], bi = p.in[I_BIM][(g * 64 + n) * 16 + c];
            bbr[c] = fre * br - fim * bi; bbi[c] = fre * bi + fim * br;
            cr[c] = p.in[I_CRE][(g * 16 + c) * 64 + n]; ci[c] = p.in[I_CIM][(g * 16 + c) * 64 + n];
        }
        const float dd = p.in[I_S5D][g * 16 + (lane & 15)];
        float hr = 0.f, hi = 0.f;
#pragma unroll 1
        for (int t = 0; t < T; ++t) {
            const int row = row_of(b, t);
            const f16* ur = U + (size_t)row * D + 1024 + g * 16;
            const float4 u0 = ld4(ur), u1 = ld4(ur + 4), u2 = ld4(ur + 8), u3 = ld4(ur + 12);
            const float uu[16] = {u0.x, u0.y, u0.z, u0.w, u1.x, u1.y, u1.z, u1.w, u2.x, u2.y, u2.z, u2.w, u3.x, u3.y, u3.z, u3.w};
            float bur = 0.f, bui = 0.f;
#pragma unroll
            for (int c = 0; c < 16; ++c) { bur = fmaf(bbr[c], uu[c], bur); bui = fmaf(bbi[c], uu[c], bui); }
            const float nhr = are * hr - aim * hi + bur, nhi = are * hi + aim * hr + bui;
            hr = nhr; hi = nhi;
            float myy = 0.f;
#pragma unroll
            for (int c = 0; c < 16; ++c) { const float v = wave_sum(cr[c] * hr - ci[c] * hi); if (lane == c) myy = v; }
            if (lane < 16 && (t >= NMETA || b == 0)) {
                const float y = myy + dd * (float)ur[lane];
                DY[(size_t)row * D + 1024 + g * 16 + lane] = (f16)gelu_tanh(y);
            }
        }
    }
}

__device__ __forceinline__ void rope_naive(float* PROJ) {
    const size_t total = (size_t)MREAL * 456, stride = (size_t)gridDim.x * NTHREADS;
    for (size_t i = (size_t)obid() * NTHREADS + otid(); i < total; i += stride) {
        const int row = (int)(i / 456); int r = (int)(i % 456);
        const int t = row < MMAIN ? (row & 2047) + NMETA : row - MMAIN;
        int col, half, idx;
        if (r < 256) { col = QOFF + (r >> 4) * 128; half = 16; idx = r & 15; }
        else if (r < 320) { r -= 256; col = KOFF + (r >> 4) * 128; half = 16; idx = r & 15; }
        else if (r < 448) { r -= 320; col = QIOFF + (r >> 3) * 64; half = 8; idx = r & 7; }
        else { r -= 448; col = KIOFF; half = 8; idx = r; }
        const float inv = rope_inv16(half == 16 ? idx : 2 * idx);
        const float ang = (float)t * inv;
        double sd, cd; sincos_d((double)ang, sd, cd);
        const float cs = (float)cd, sn = (float)sd;
        float* px = PROJ + (size_t)row * CIN + col;
        const float x1 = px[idx], x2 = px[half + idx];
        px[idx] = x1 * cs - x2 * sn; px[half + idx] = x2 * cs + x1 * sn;
    }
}

__device__ __forceinline__ void idx_scores(const float* PROJ, float* SCORE) {
    const int tid_ = otid(), lane = tid_ & 63, gw = obid() * (NTHREADS / 64) + (tid_ >> 6), ngw = gridDim.x * (NTHREADS / 64);
    for (int q = gw; q < MMAIN; q += ngw) {
        const int b = q >> 11, s = q & 2047, nall = 80 + 64 * (s >> 6);
        const float* qi = PROJ + (size_t)q * CIN + QIOFF;
        const float* wi = PROJ + (size_t)q * CIN + WIOFF;
        for (int t = lane; t < nall; t += 64) {
            const float* kp = PROJ + (size_t)row_of(b, t) * CIN + KIOFF;
            float4 kv[16];
#pragma unroll
            for (int j = 0; j < 16; ++j) kv[j] = ld4(kp + 4 * j);
            float score = 0.f;
#pragma unroll 1
            for (int h = 0; h < 16; ++h) {
                float dot = 0.f;
#pragma unroll
                for (int j = 0; j < 16; ++j) { const float4 qv = ld4(qi + h * 64 + 4 * j); dot += qv.x * kv[j].x + qv.y * kv[j].y + qv.z * kv[j].z + qv.w * kv[j].w; }
                score += (wi[h] * 0.03125f) * fmaxf(dot, 0.f);
            }
            SCORE[(size_t)q * SROW + t] = score;
        }
    }
}

__device__ __forceinline__ unsigned okey(float f) { const unsigned u = __float_as_uint(f); return (u & 0x80000000u) ? ~u : (u | 0x80000000u); }
__device__ __forceinline__ void select_topk(const float* SCORE, unsigned long long* MASK) {
    const int tid_ = otid(), lane = tid_ & 63, gw = obid() * (NTHREADS / 64) + (tid_ >> 6), ngw = gridDim.x * (NTHREADS / 64);
    for (int q = gw; q < MMAIN; q += ngw) {
        const int s = q & 2047, nall = 80 + 64 * (s >> 6);
        unsigned key[33];
#pragma unroll
        for (int i = 0; i < 33; ++i) { const int t = 64 * i + lane; key[i] = (t < nall) ? okey(SCORE[(size_t)q * SROW + t]) : 0u; }
        unsigned long long mymask = 0ull;
        if (nall <= 256) {
#pragma unroll
            for (int i = 0; i < 33; ++i) { const unsigned long long m = __ballot(64 * i + lane < nall); if (lane == i) mymask = m; }
        } else {
            unsigned tau = 0u;
#pragma unroll 1
            for (int bit = 31; bit >= 0; --bit) {
                const unsigned cand = tau | (1u << bit); int cnt = 0;
#pragma unroll
                for (int i = 0; i < 33; ++i) cnt += __popcll(__ballot(key[i] >= cand));
                if (cnt >= 256) tau = cand;
            }
            int ngt = 0;
#pragma unroll
            for (int i = 0; i < 33; ++i) ngt += __popcll(__ballot(key[i] > tau));
            const int need = 256 - ngt; int eqb = 0;
            const unsigned long long lt = (1ull << lane) - 1ull;
#pragma unroll
            for (int i = 0; i < 33; ++i) {
                const unsigned long long gm = __ballot(key[i] > tau), em = __ballot(key[i] == tau);
                const int rank = eqb + __popcll(em & lt);
                const unsigned long long sm = __ballot(key[i] == tau && rank < need);
                if (lane == i) mymask = gm | sm;
                eqb += __popcll(em);
            }
        }
        if (lane < 33) MASK[(size_t)q * 33 + lane] = mymask;
    }
}

__device__ __forceinline__ void attn_naive(float* lds, const float* PROJ, const unsigned long long* MASK, f16* O) {
    const int tid_ = otid(), lane = tid_ & 63, wv = tid_ >> 6, gw = obid() * (NTHREADS / 64) + wv, ngw = gridDim.x * (NTHREADS / 64);
    int* list = (int*)(lds + wv * 640);
    float* pl = lds + wv * 640 + 256;
    float* ql = lds + wv * 640 + 512;
    for (int item = gw; item < MMAIN * 16; item += ngw) {
        const int q = item >> 4, hq = item & 15, b = q >> 11, kvh = hq >> 2;
        int base = 0;
        for (int i = 0; i < 33; ++i) {
            const unsigned long long w = MASK[(size_t)q * 33 + i];
            if ((w >> lane) & 1ull) list[base + __popcll(w & ((1ull << lane) - 1ull))] = 64 * i + lane;
            base += __popcll(w);
        }
        const int nk = base;
        const float* qp = PROJ + (size_t)q * CIN + QOFF + hq * 128;
        ql[lane] = qp[lane]; ql[64 + lane] = qp[64 + lane];
        __builtin_amdgcn_s_waitcnt(0); __builtin_amdgcn_wave_barrier();
        float lg[4]; float mx = -INFINITY;
#pragma unroll
        for (int j = 0; j < 4; ++j) {
            const int kk = lane + 64 * j; lg[j] = -INFINITY;
            if (kk < nk) {
                const float* kp = PROJ + (size_t)row_of(b, list[kk]) * CIN + KOFF + kvh * 128;
                float dot = 0.f;
#pragma unroll 4
                for (int d = 0; d < 128; d += 4) { const float4 kv = ld4(kp + d); dot += kv.x * ql[d] + kv.y * ql[d + 1] + kv.z * ql[d + 2] + kv.w * ql[d + 3]; }
                lg[j] = dot * 0.08838834764831845f;
            }
            mx = fmaxf(mx, lg[j]);
        }
        mx = wave_max(mx);
        float sm = 0.f;
#pragma unroll
        for (int j = 0; j < 4; ++j) { const int kk = lane + 64 * j; const float e = (kk < nk) ? expf(lg[j] - mx) : 0.f; sm += e; pl[kk] = e; }
        sm = wave_sum(sm);
        __builtin_amdgcn_s_waitcnt(0); __builtin_amdgcn_wave_barrier();
        float o0 = 0.f, o1 = 0.f;
#pragma unroll 2
        for (int kk = 0; kk < nk; ++kk) {
            const float* vp = PROJ + (size_t)row_of(b, list[kk]) * CIN + VOFF + kvh * 128;
            const float pw = pl[kk];
            o0 = fmaf(pw, vp[lane], o0); o1 = fmaf(pw, vp[64 + lane], o1);
        }
        const float inv = 1.f / sm;
        O[(size_t)q * D + hq * 128 + lane] = (f16)(o0 * inv); O[(size_t)q * D + hq * 128 + 64 + lane] = (f16)(o1 * inv);
        __builtin_amdgcn_s_waitcnt(0); __builtin_amdgcn_wave_barrier();
    }
}

template <class F>
__device__ __forceinline__ void gemm(LAS unsigned char* lds, const f16* A, int lda, const f16* Bt, int ldb, int M, int N, int K, int cu, F f) {
    pg8::Gemm g{A, Bt, M, N, K, lda, ldb};
    pg8::StaticOrder S; S.init(M, N, (int)gridDim.x, cu);
    pg8::EpiRow8<F> E{f};
    pg8::gemm_phase<pg8::EpiRow8<F>, pg8::StaticOrder, true, true>(lds, g, S, E);
}

__global__ void __launch_bounds__(NTHREADS, 2) fwd(Params p) {
    cg::grid_group grid = cg::this_grid();
    extern __shared__ __attribute__((aligned(16))) unsigned char smem[];
    LAS unsigned char* lds = (LAS unsigned char*)smem;
    float* ldsf = (float*)smem;
    unsigned char* ws = p.ws;
    float* H = (float*)(ws + OFF_H); f16* A16 = (f16*)(ws + OFF_A16); f16* U16 = (f16*)(ws + OFF_U16);
    f16* DY16 = (f16*)(ws + OFF_DY16); f16* CAT16 = (f16*)(ws + OFF_CAT16);
    f16* HID16 = (f16*)(ws + OFF_BIG); float* PROJ = (float*)(ws + OFF_BIG);
    float* SCORE = (float*)(ws + OFF_SCORE); unsigned long long* MASK = (unsigned long long*)(ws + OFF_MASK); f16* O16 = (f16*)(ws + OFF_O16);
    const float* ng = p.in[I_NORMG];
    const int bid = (int)blockIdx.x, G = (int)gridDim.x;

    convert_weights(p, ldsf);
    init_rows(p, H, A16);
    grid.sync();
    gemm(lds, A16, D, (const f16*)(ws + W_IN), D, MP, D, D, bid, [=](int r, int c, f32x4 v0, f32x4 v1) { st8h(U16 + (size_t)r * D + c, v0, v1); });
    grid.sync();
    pool_diff(U16, DY16);
    ssm_naive(p, U16, DY16);
    grid.sync();
    for (int g = 0; g < 4; ++g) {
        const float* ps = p.in[I_POOLS] + g * 256;
        gemm(lds, DY16 + g * 256, D, (const f16*)(ws + W_POOL) + (size_t)g * 65536, 256, MP, 256, 256, (bid + G - 33 * g) % G,
             [=](int r, int c, f32x4 v0, f32x4 v1) { const f32x4 s0 = *(const f32x4*)(ps + c), s1 = *(const f32x4*)(ps + c + 4); st8h(CAT16 + (size_t)r * D + g * 256 + c, v0 * s0, v1 * s1); });
    }
    gemm(lds, DY16 + 1024, D, (const f16*)(ws + W_GLU), 1024, MP, 1024, 1024, (bid + G - 132) % G,
         [=](int r, int c, f32x4 v0, f32x4 v1) {
             const f16* yp = DY16 + (size_t)r * D + 1024 + c; const float4 y0 = ld4(yp), y1 = ld4(yp + 4);
             f32x4 o0, o1;
             o0[0] = y0.x / (1.f + __expf(-v0[0])); o0[1] = y0.y / (1.f + __expf(-v0[1])); o0[2] = y0.z / (1.f + __expf(-v0[2])); o0[3] = y0.w / (1.f + __expf(-v0[3]));
             o1[0] = y1.x / (1.f + __expf(-v1[0])); o1[1] = y1.y / (1.f + __expf(-v1[1])); o1[2] = y1.z / (1.f + __expf(-v1[2])); o1[3] = y1.w / (1.f + __expf(-v1[3]));
             st8h(CAT16 + (size_t)r * D + 1024 + c, o0, o1); });
    grid.sync();
    gemm(lds, CAT16, D, (const f16*)(ws + W_OUT), D, MP, D, D, bid, [=](int r, int c, f32x4 v0, f32x4 v1) { st8h(U16 + (size_t)r * D + c, v0, v1); });
    grid.sync();
    rowpass(U16, ng + 1 * D, ng + 2 * D, H, A16, nullptr, MP);
    grid.sync();
    gemm(lds, A16, D, (const f16*)(ws + W_1), D, MP, DFF, D, bid, [=](int r, int c, f32x4 v0, f32x4 v1) {
        f32x4 z0 = __builtin_elementwise_max(v0, (f32x4){0.f, 0.f, 0.f, 0.f}), z1 = __builtin_elementwise_max(v1, (f32x4){0.f, 0.f, 0.f, 0.f}); st8h(HID16 + (size_t)r * DFF + c, z0 * z0, z1 * z1); });
    grid.sync();
    gemm(lds, HID16, DFF, (const f16*)(ws + W_2), DFF, MP, D, DFF, bid, [=](int r, int c, f32x4 v0, f32x4 v1) { st8h(U16 + (size_t)r * D + c, v0, v1); });
    grid.sync();
    rowpass(U16, ng + 3 * D, ng + 4 * D, H, A16, nullptr, MP);
    grid.sync();
    gemm(lds, A16, D, (const f16*)(ws + W_CIN), D, MP, CINP, D, bid, [=](int r, int c, f32x4 v0, f32x4 v1) {
        if (c < CIN) { float* o = PROJ + (size_t)r * CIN + c; *(f32x4*)o = v0; *(f32x4*)(o + 4) = v1; } });
    grid.sync();
    rope_naive(PROJ);
    grid.sync();
    idx_scores(PROJ, SCORE);
    grid.sync();
    select_topk(SCORE, MASK);
    grid.sync();
    attn_naive(ldsf, PROJ, MASK, O16);
    grid.sync();
    gemm(lds, O16, D, (const f16*)(ws + W_COUT), D, MMAIN, D, D, bid, [=](int r, int c, f32x4 v0, f32x4 v1) { st8h(U16 + (size_t)r * D + c, v0, v1); });
    grid.sync();
    rowpass(U16, ng + 5 * D, ng + 6 * D, H, A16, nullptr, MMAIN);
    grid.sync();
    gemm(lds, A16, D, (const f16*)(ws + W_1) + (size_t)D * DFF, D, MMAIN, DFF, D, bid, [=](int r, int c, f32x4 v0, f32x4 v1) {
        f32x4 z0 = __builtin_elementwise_max(v0, (f32x4){0.f, 0.f, 0.f, 0.f}), z1 = __builtin_elementwise_max(v1, (f32x4){0.f, 0.f, 0.f, 0.f}); st8h(HID16 + (size_t)r * DFF + c, z0 * z0, z1 * z1); });
    grid.sync();
    gemm(lds, HID16, DFF, (const f16*)(ws + W_2) + (size_t)D * DFF, DFF, MMAIN, D, DFF, bid, [=](int r, int c, f32x4 v0, f32x4 v1) { st8h(U16 + (size_t)r * D + c, v0, v1); });
    grid.sync();
    rowpass(U16, ng + 7 * D, nullptr, H, nullptr, p.out, MMAIN);
}

extern "C" void kernel_launch(void* const* d_in, const int* in_sizes, int n_in, void* d_out, int out_size, void* d_ws, size_t ws_size, hipStream_t stream) {
    static int grid_blocks = 0;
    if (!grid_blocks) {
        if (n_in != 20 || out_size != MMAIN * D || ws_size < WS_NEED) { fprintf(stderr, "kernel_launch: unexpected shapes n_in %d out %d ws %zu (need %zu)\n", n_in, out_size, ws_size, (size_t)WS_NEED); grid_blocks = -1; return; }
        int dev = 0, cus = 0, per_cu = 0;
        (void)hipGetDevice(&dev);
        (void)hipDeviceGetAttribute(&cus, hipDeviceAttributeMultiprocessorCount, dev);
        if (hipFuncSetAttribute((const void*)fwd, hipFuncAttributeMaxDynamicSharedMemorySize, LDS_BYTES) != hipSuccess) { fprintf(stderr, "kernel_launch: hipFuncSetAttribute failed\n"); grid_blocks = -1; return; }
        (void)hipOccupancyMaxActiveBlocksPerMultiprocessor(&per_cu, fwd, NTHREADS, LDS_BYTES);
        if (per_cu < 1) { fprintf(stderr, "kernel_launch: occupancy query says %d blocks per CU\n", per_cu); per_cu = 1; }
        grid_blocks = cus;
    }
    if (grid_blocks < 0) return;
    Params p{};
    for (int i = 0; i < 20; ++i) p.in[i] = (const float*)d_in[i];
    p.out = (float*)d_out; p.ws = (unsigned char*)d_ws;
    void* args[] = {&p};
    hipError_t e = hipLaunchCooperativeKernel((void*)fwd, dim3(grid_blocks), dim3(NTHREADS), args, LDS_BYTES, stream);
    if (e != hipSuccess) fprintf(stderr, "cooperative launch failed: %s (grid %d)\n", hipGetErrorString(e), grid_blocks);
}
```

```cpp
#include <hip/hip_runtime.h>
#include <hip/hip_fp16.h>
#include <hip/hip_cooperative_groups.h>
#include <cstdio>
#include <cstdint>
#include <cmath>
namespace cg = cooperative_groups;
__device__ __forceinline__ int otid() { int t = threadIdx.x; asm volatile("" : "+v"(t)); return t; }
__device__ __forceinline__ int obid() { int t = blockIdx.x; asm volatile("" : "+s"(t)); return t; }

namespace pg8 {
#define PG8_LAS __attribute__((address_space(3)))
typedef _Float16 f16_t;
typedef _Float16 f16x8 __attribute__((ext_vector_type(8)));
typedef float f32x4 __attribute__((ext_vector_type(4)));
typedef unsigned u32x4 __attribute__((ext_vector_type(4)));
constexpr int BM = 256, BK = 64, HALF = 128, HTB = HALF * BK * 2  , STAGE_BYTES = 8 * HTB, NXCD = 8, WGM = 8;

__host__ __device__ __forceinline__ int lds_byte(int r, int c) { const int st = (r >> 4) * 2 + (c >> 5), rr = r & 15, cc = c & 31, ob = rr * 64 + cc * 2; return st * 1024 + (ob ^ (((ob >> 9) & 1) << 5)); }
__host__ __device__ __forceinline__ void stage_rc(int b, int& R, int& C) { const int st = b / 1024, sb = b % 1024, swz = sb ^ (((sb >> 9) & 1) << 5); R = (st >> 1) * 16 + swz / 64; C = (st & 1) * 32 + (swz % 64) / 2; }
__host__ __device__ __forceinline__ int perm32(int rho) { const int n = rho >> 4, i = rho & 15; return 8 * (i >> 2) + 4 * n + (i & 3); }

struct Unit { int pm, pn; };
struct Gemm { const f16_t* A; const f16_t* Bt; int M, N, K, lda, ldb; };

struct StaticOrder {
    int nM, nN, nwg, G, c;
    __host__ __device__ void init(int M, int N, int G_, int c_) { nM = M / BM; nN = N / BM; nwg = nM * nN; G = G_; c = c_; }
    __host__ __device__ bool next(int i, Unit& u) const {
        const long L = (long)i * G + c; if (L >= nwg) return false;
        int wgid = (int)L; { const int q = nwg / NXCD, r = nwg % NXCD, xcd = wgid % NXCD, off = wgid / NXCD; wgid = (xcd < r ? xcd * (q + 1) : r * (q + 1) + (xcd - r) * q) + off; }
        const int nig = WGM * nN, gid = wgid / nig, fm = gid * WGM, gsz = (nM - fm) < WGM ? (nM - fm) : WGM;
        u.pm = fm + ((wgid % nig) % gsz); u.pn = (wgid % nig) / gsz; return true;
    }
    __device__ __forceinline__ void a_ready(const Unit&) const {}
    __device__ __forceinline__ void done(const Unit&) const {}
};


template <class Epi, class Sched, bool ALIGN_EPI = false, bool SP2 = false>
__device__ __forceinline__ void gemm_phase(PG8_LAS unsigned char* lds, const Gemm g, const Sched& S, const Epi& E) {
    const int tid = otid(), wid = __builtin_amdgcn_readfirstlane(tid >> 6), lane = tid & 63, wr = wid >> 2, wc = wid & 3, fr = lane & 15, fq = lane >> 4;
    const int K = g.K, nt = K / BK;
    unsigned voffA[2], voffB[2];
#pragma unroll
    for (int i = 0; i < 2; ++i) { int R, C; stage_rc(tid * 16 + i * 8192, R, C); const int Rb = Epi::PERM ? ((R & ~31) + perm32(R & 31)) : R;
        voffA[i] = (unsigned)(R * g.lda + C) * 2u; voffB[i] = (unsigned)(Rb * g.ldb + C) * 2u; }
    const size_t kstep = (size_t)(BK * 2);
    const size_t hstepA = (size_t)HALF * g.lda * 2, hstepB = (size_t)HALF * g.ldb * 2;
    const size_t tstepA = 2 * hstepA, tstepB = 2 * hstepB;
    const unsigned ldsw = (unsigned)wid * 1024u;
    const int aoff = lds_byte(wr * 64 + fr, fq * 8), boff = lds_byte(wc * 32 + fr, fq * 8);
#define PG8_SA(b, h) (((b) * 2 + (h)) * HTB)
#define PG8_SB(b, h) ((4 + (b) * 2 + (h)) * HTB)
#define PG8_STAGE(bufoff, gbase, voff) do { _Pragma("unroll") for (int _i = 0; _i < 2; ++_i) \
        __builtin_amdgcn_global_load_lds((const unsigned*)((const char*)(gbase) + (voff)[_i]), (PG8_LAS unsigned*)(lds + (bufoff) + ldsw + _i * 8192), 16, 0, 0); } while (0)
#define PG8_LDA(dst, b, h) do { _Pragma("unroll") for (int m = 0; m < 4; ++m) _Pragma("unroll") for (int k = 0; k < 2; ++k) dst[m][k] = *(const PG8_LAS f16x8*)(lds + PG8_SA(b, h) + aoff + m * 2048 + k * 1024); } while (0)
#define PG8_LDB(dst, b, h) do { _Pragma("unroll") for (int n = 0; n < 2; ++n) _Pragma("unroll") for (int k = 0; k < 2; ++k) dst[n][k] = *(const PG8_LAS f16x8*)(lds + PG8_SB(b, h) + boff + n * 2048 + k * 1024); } while (0)
#define PG8_MMA(ai, bj, At, Bt) do { __builtin_amdgcn_s_setprio(1); _Pragma("unroll") for (int m = 0; m < 4; ++m) _Pragma("unroll") for (int n = 0; n < 2; ++n) _Pragma("unroll") for (int k = 0; k < 2; ++k) \
        acc[ai][bj][m][n] = __builtin_amdgcn_mfma_f32_16x16x32_f16(Bt[n][k], At[m][k], acc[ai][bj][m][n], 0, 0, 0); __builtin_amdgcn_s_setprio(0); } while (0)
#define PG8_WAIT_V(n) asm volatile("s_waitcnt vmcnt(" #n ")" ::: "memory")
#define PG8_WAIT_L(n) asm volatile("s_waitcnt lgkmcnt(" #n ")" ::: "memory")
#define PG8_BAR __builtin_amdgcn_s_barrier()
#define PG8_SCHED __builtin_amdgcn_sched_barrier(0)
    Unit cur, nxt; int ui = 0;
    if (!S.next(0, cur)) return;
    f32x4 acc[2][2][4][2];
#pragma unroll
    for (int a = 0; a < 2; ++a)
#pragma unroll
        for (int b = 0; b < 2; ++b)
#pragma unroll
            for (int m = 0; m < 4; ++m)
#pragma unroll
                for (int n = 0; n < 2; ++n) acc[a][b][m][n] = (f32x4){0.f, 0.f, 0.f, 0.f};
    f16x8 At[4][2], B0[2][2], B1[2][2];
    const char* cA = (const char*)g.A + (size_t)cur.pm * tstepA; const char* cB = (const char*)g.Bt + (size_t)cur.pn * tstepB;
    S.a_ready(cur);
    if constexpr (SP2) {
        PG8_STAGE(PG8_SB(0, 0), cB, voffB); PG8_STAGE(PG8_SB(0, 1), cB + hstepB, voffB); PG8_STAGE(PG8_SA(0, 0), cA, voffA); PG8_STAGE(PG8_SA(0, 1), cA + hstepA, voffA);
        if (wr == 1) PG8_BAR;
        PG8_WAIT_V(2); PG8_BAR;
        PG8_STAGE(PG8_SB(1, 0), cB + kstep, voffB); PG8_STAGE(PG8_SA(1, 0), cA + kstep, voffA); PG8_STAGE(PG8_SB(1, 1), cB + hstepB + kstep, voffB);
        PG8_WAIT_V(6); PG8_BAR;
    } else {
        PG8_STAGE(PG8_SB(0, 0), cB, voffB); PG8_STAGE(PG8_SA(0, 0), cA, voffA); PG8_STAGE(PG8_SB(0, 1), cB + hstepB, voffB); PG8_STAGE(PG8_SA(0, 1), cA + hstepA, voffA);
        if (wr == 1) PG8_BAR;
        PG8_WAIT_V(4); PG8_BAR;
        PG8_STAGE(PG8_SB(1, 0), cB + kstep, voffB); PG8_STAGE(PG8_SA(1, 0), cA + kstep, voffA); PG8_STAGE(PG8_SB(1, 1), cB + hstepB + kstep, voffB);
        PG8_WAIT_V(6); PG8_BAR;
    }
    for (;;) {
        const bool has_next = S.next(ui + 1, nxt);
        const char* nA = has_next ? (const char*)g.A + (size_t)nxt.pm * tstepA : cA; const char* nB = has_next ? (const char*)g.Bt + (size_t)nxt.pn * tstepB : cB;
        for (int t = 0; t < nt; t += 2) {
            const bool last = (t == nt - 2);
            const char* a1 = cA + (size_t)(t + 1) * kstep;
            const char* a2 = last ? nA : cA + (size_t)(t + 2) * kstep; const char* b2 = last ? nB : cB + (size_t)(t + 2) * kstep;
            const char* a3 = a2 + kstep; const char* b3 = b2 + kstep;
            if (last && has_next) S.a_ready(nxt);
            if constexpr (SP2) {
            PG8_LDB(B0, 0, 0); PG8_LDB(B1, 0, 1); PG8_SCHED; PG8_LDA(At, 0, 0); PG8_STAGE(PG8_SA(1, 1), a1 + hstepA, voffA);
            PG8_WAIT_V(8); PG8_WAIT_L(0); PG8_BAR; PG8_MMA(0, 0, At, B0); PG8_MMA(0, 1, At, B1); PG8_BAR; PG8_SCHED;
            PG8_LDA(At, 0, 1); PG8_STAGE(PG8_SB(0, 0), b2, voffB); PG8_STAGE(PG8_SB(0, 1), b2 + hstepB, voffB); PG8_STAGE(PG8_SA(0, 0), a2, voffA);
            PG8_WAIT_V(8); PG8_WAIT_L(0); PG8_BAR; PG8_MMA(1, 0, At, B0); PG8_MMA(1, 1, At, B1); PG8_BAR; PG8_SCHED;
            PG8_LDB(B0, 1, 0); PG8_LDB(B1, 1, 1); PG8_SCHED; PG8_LDA(At, 1, 0); PG8_STAGE(PG8_SA(0, 1), a2 + hstepA, voffA);
            PG8_WAIT_V(8); PG8_WAIT_L(0); PG8_BAR; PG8_MMA(0, 0, At, B0); PG8_MMA(0, 1, At, B1); PG8_BAR; PG8_SCHED;
            PG8_LDA(At, 1, 1); PG8_STAGE(PG8_SB(1, 0), b3, voffB); PG8_STAGE(PG8_SB(1, 1), b3 + hstepB, voffB); PG8_STAGE(PG8_SA(1, 0), a3, voffA);
            PG8_WAIT_V(8); PG8_WAIT_L(0); PG8_BAR; PG8_MMA(1, 0, At, B0); PG8_MMA(1, 1, At, B1); PG8_BAR; PG8_SCHED;
            } else {
            PG8_LDB(B0, 0, 0); PG8_SCHED; PG8_LDA(At, 0, 0); PG8_STAGE(PG8_SA(1, 1), a1 + hstepA, voffA);
            PG8_WAIT_L(8); PG8_BAR; PG8_WAIT_L(0); PG8_MMA(0, 0, At, B0); PG8_BAR; PG8_SCHED;
            PG8_LDB(B1, 0, 1); PG8_STAGE(PG8_SB(0, 0), b2, voffB);
            PG8_BAR; PG8_WAIT_L(0); PG8_MMA(0, 1, At, B1); PG8_BAR;
            PG8_LDA(At, 0, 1); PG8_STAGE(PG8_SA(0, 0), a2, voffA);
            PG8_BAR; PG8_WAIT_L(0); PG8_MMA(1, 0, At, B0); PG8_BAR; PG8_SCHED;
            PG8_STAGE(PG8_SB(0, 1), b2 + hstepB, voffB);
            PG8_WAIT_V(6); PG8_BAR; PG8_MMA(1, 1, At, B1); PG8_BAR;
            PG8_LDB(B0, 1, 0); PG8_SCHED; PG8_LDA(At, 1, 0); PG8_STAGE(PG8_SA(0, 1), a2 + hstepA, voffA);
            PG8_WAIT_L(8); PG8_BAR; PG8_WAIT_L(0); PG8_MMA(0, 0, At, B0); PG8_BAR; PG8_SCHED;
            PG8_LDB(B1, 1, 1); PG8_STAGE(PG8_SB(1, 0), b3, voffB);
            PG8_BAR; PG8_WAIT_L(0); PG8_MMA(0, 1, At, B1); PG8_BAR;
            PG8_LDA(At, 1, 1); PG8_STAGE(PG8_SA(1, 0), a3, voffA);
            PG8_BAR; PG8_WAIT_L(0); PG8_MMA(1, 0, At, B0); PG8_BAR; PG8_SCHED;
            PG8_STAGE(PG8_SB(1, 1), b3 + hstepB, voffB);
            PG8_WAIT_V(6); PG8_BAR; PG8_MMA(1, 1, At, B1); PG8_BAR;
            }
        }
        if constexpr (ALIGN_EPI) { if (wr == 0) PG8_BAR; }
        if constexpr (!Epi::AFTER_DRAIN) { E(acc, cur, wr, wc, fr, fq); S.done(cur); }
        if (!has_next) break;
#pragma unroll
        for (int a = 0; a < 2; ++a)
#pragma unroll
            for (int b = 0; b < 2; ++b)
#pragma unroll
                for (int m = 0; m < 4; ++m)
#pragma unroll
                    for (int n = 0; n < 2; ++n) acc[a][b][m][n] = (f32x4){0.f, 0.f, 0.f, 0.f};
        cur = nxt; cA = nA; cB = nB; ++ui;
        if constexpr (ALIGN_EPI) { if (wr == 1) PG8_BAR; }
    }
    PG8_WAIT_V(0);
    if constexpr (!ALIGN_EPI) { if (wr == 0) PG8_BAR; }
    PG8_BAR;
    if constexpr (Epi::AFTER_DRAIN) { E.fused(acc, cur, wr, wc, fr, fq, lds, wid, lane); S.done(cur); }
#undef PG8_SA
#undef PG8_SB
#undef PG8_STAGE
#undef PG8_LDA
#undef PG8_LDB
#undef PG8_MMA
#undef PG8_WAIT_V
#undef PG8_WAIT_L
#undef PG8_BAR
#undef PG8_SCHED
}

template <class F> struct EpiRow8 {
    static constexpr bool PERM = true, AFTER_DRAIN = false;
    F f;
    __device__ __forceinline__ void operator()(const f32x4 (&acc)[2][2][4][2], const Unit& u, int wr, int wc, int fr, int fq) const {
        const int row0 = u.pm * BM + wr * 64 + fr, col0 = u.pn * BM + wc * 32 + 8 * fq;
#pragma unroll
        for (int ai = 0; ai < 2; ++ai)
#pragma unroll
            for (int m = 0; m < 4; ++m)
#pragma unroll
                for (int bj = 0; bj < 2; ++bj) f(row0 + ai * HALF + m * 16, col0 + bj * HALF, acc[ai][bj][m][0], acc[ai][bj][m][1]);
    }
};
}

#define LAS __attribute__((address_space(3)))
typedef _Float16 f16;
typedef float f32x4 __attribute__((ext_vector_type(4)));
typedef unsigned u32x4 __attribute__((ext_vector_type(4)));
typedef _Float16 h2v __attribute__((ext_vector_type(2)));

constexpr int D = 2048, NMETA = 16, SEQ = 2048, T = 2064, DFF = 8192;
constexpr int MMAIN = 8192;
constexpr int MREAL = 8208;
constexpr int MP = 8448;
constexpr int CIN = 4176, CINP = 4352;
constexpr int QOFF = 0, KOFF = 2048, VOFF = 2560, QIOFF = 3072, KIOFF = 4096, WIOFF = 4160;
constexpr int SROW = 2112;
constexpr float EPS = 1e-6f;
constexpr int NTHREADS = 512;
constexpr int LDS_BYTES = 147456;

struct Params { const float* in[20]; float* out; unsigned char* ws; };
enum { I_X = 0, I_META, I_NORMG, I_ABWIN, I_POOLW, I_POOLS, I_LRE, I_LIM, I_LOGDT, I_BRE, I_BIM, I_CRE, I_CIM, I_S5D, I_WGLU, I_ABWOUT, I_CWIN, I_CWOUT, I_W1, I_W2 };

constexpr size_t SZ4 = (size_t)MP * D * 4, SZ2 = (size_t)MP * D * 2;
constexpr size_t OFF_H = 0, OFF_A16 = OFF_H + SZ4, OFF_U16 = OFF_A16 + SZ2, OFF_DY16 = OFF_U16 + SZ2, OFF_CAT16 = OFF_DY16 + SZ2, OFF_BIG = OFF_CAT16 + SZ2;
constexpr size_t SZ_BIG = (size_t)MP * CIN * 4;
constexpr size_t OFF_MASK = OFF_BIG + SZ_BIG, SZ_MASK = (size_t)MMAIN * 33 * 8;
constexpr size_t OFF_W = OFF_MASK + SZ_MASK;
constexpr size_t OFF_SCORE = OFF_DY16, OFF_O16 = OFF_A16;
constexpr size_t W_IN = OFF_W, W_POOL = W_IN + (size_t)D * D * 2, W_GLU = W_POOL + (size_t)4 * 256 * 256 * 2, W_OUT = W_GLU + (size_t)1024 * 1024 * 2,
                 W_CIN = W_OUT + (size_t)D * D * 2, W_COUT = W_CIN + (size_t)CINP * D * 2, W_1 = W_COUT + (size_t)D * D * 2, W_2 = W_1 + (size_t)2 * D * DFF * 2,
                 WS_NEED = W_2 + (size_t)2 * D * DFF * 2;
static_assert(SZ_BIG >= (size_t)MP * DFF * 2, "BIG region holds HID16");
static_assert((size_t)MMAIN * SROW * 4 <= 2 * SZ2, "SCORE fits DY16+CAT16");

__device__ __forceinline__ int row_of(int b, int t) { return t < NMETA ? MMAIN + t : b * SEQ + (t - NMETA); }
__device__ __forceinline__ float wave_sum(float v) {
#pragma unroll
    for (int o = 1; o < 64; o <<= 1) v += __shfl_xor(v, o);
    return v;
}
__device__ __forceinline__ float wave_max(float v) {
#pragma unroll
    for (int o = 1; o < 64; o <<= 1) v = fmaxf(v, __shfl_xor(v, o));
    return v;
}
__device__ __forceinline__ float4 ld4(const float* p) { return *(const float4*)p; }
__device__ __forceinline__ unsigned pk2h(float a, float b) { h2v r; r.x = (_Float16)a; r.y = (_Float16)b; return __builtin_bit_cast(unsigned, r); }
__device__ __forceinline__ float2 up2h(unsigned u) { const h2v r = __builtin_bit_cast(h2v, u); return make_float2((float)r.x, (float)r.y); }
__device__ __forceinline__ float4 ld4(const f16* p) { const uint2 r = *(const uint2*)p; const float2 a = up2h(r.x), b = up2h(r.y); return make_float4(a.x, a.y, b.x, b.y); }
__device__ __forceinline__ void st4h(f16* p, float4 v) { uint2 r; r.x = pk2h(v.x, v.y); r.y = pk2h(v.z, v.w); *(uint2*)p = r; }
__device__ __forceinline__ void st8h(f16* p, f32x4 a, f32x4 b) { u32x4 w; w.x = pk2h(a[0], a[1]); w.y = pk2h(a[2], a[3]); w.z = pk2h(b[0], b[1]); w.w = pk2h(b[2], b[3]); *(u32x4*)p = w; }

__device__ __forceinline__ void sincos_d(double x, double& sn, double& cs) {
    const double q = rint(x * 0.6366197723675814);
    double r = fma(-q, 1.5707963267948966, x); r = fma(-q, 6.123233995736766e-17, r);
    const double r2 = r * r;
    double sp = -1.0 / 6227020800.0; sp = fma(sp, r2, 1.0 / 39916800.0); sp = fma(sp, r2, -1.0 / 362880.0); sp = fma(sp, r2, 1.0 / 5040.0); sp = fma(sp, r2, -1.0 / 120.0); sp = fma(sp, r2, 1.0 / 6.0); sp = fma(sp, r2, -1.0); sp = -sp * r;
    double cp = 1.0 / 87178291200.0; cp = fma(cp, r2, -1.0 / 479001600.0); cp = fma(cp, r2, 1.0 / 3628800.0); cp = fma(cp, r2, -1.0 / 40320.0); cp = fma(cp, r2, 1.0 / 720.0); cp = fma(cp, r2, -1.0 / 24.0); cp = fma(cp, r2, 0.5); cp = fma(-cp, r2, 1.0);
    const int n = ((int)q) & 3;
    sn = (n == 0) ? sp : (n == 1) ? cp : (n == 2) ? -sp : -cp;
    cs = (n == 0) ? cp : (n == 1) ? -sp : (n == 2) ? -cp : sp;
}
__device__ __forceinline__ float rope_inv16(int idx) {
    const double r = 1.0 / sqrt(sqrt(sqrt(sqrt(500000.0))));
    double v = 1.0;
    for (int i = 0; i < idx; ++i) v *= r;
    return (float)v;
}

__device__ __forceinline__ void cvt_item(const float* W, int K, int N, int NPAD, f16* WT, float* scr, int item, int lane) {
    const int nblk = NPAD / 32, kb = item / nblk, nb = item % nblk, k0 = 64 * kb, n0 = 32 * nb;
    const int n = n0 + (lane & 31);
#pragma unroll 8
    for (int i = 0; i < 32; ++i) { const int kk = 2 * i + (lane >> 5); scr[kk * 33 + (lane & 31)] = (n < N) ? W[(size_t)(k0 + kk) * N + n] : 0.f; }
    const int c = lane & 7;
#pragma unroll
    for (int j = 0; j < 4; ++j) { const int nn = (lane >> 3) + 8 * j; const float* s = scr + (8 * c) * 33 + nn;
        u32x4 o; o.x = pk2h(s[0 * 33], s[1 * 33]); o.y = pk2h(s[2 * 33], s[3 * 33]); o.z = pk2h(s[4 * 33], s[5 * 33]); o.w = pk2h(s[6 * 33], s[7 * 33]);
        *(u32x4*)(WT + (size_t)(n0 + nn) * K + k0 + 8 * c) = o; }
}
__device__ __forceinline__ void convert_weights(const Params& p, float* ldsf) {
    const int tid_ = otid(), lane = tid_ & 63, wv = tid_ >> 6, gw = obid() * (NTHREADS / 64) + wv, ngw = gridDim.x * (NTHREADS / 64);
    float* scr = ldsf + wv * (64 * 33);
    unsigned char* ws = p.ws;
    constexpr int I_IN = 32 * 64, I_PG = 4 * 8, I_GLU = 16 * 32, I_OUT = 32 * 64, I_CI = 32 * (CINP / 32), I_CO = 32 * 64, I_M1 = 32 * 256, I_M2 = 128 * 64;
    constexpr int NITEMS = I_IN + 4 * I_PG + I_GLU + I_OUT + I_CI + I_CO + 2 * I_M1 + 2 * I_M2;
    for (int it = gw; it < NITEMS; it += ngw) {
        int r = it;
        if (r < I_IN) { cvt_item(p.in[I_ABWIN], D, D, D, (f16*)(ws + W_IN), scr, r, lane); continue; } r -= I_IN;
        if (r < 4 * I_PG) { const int g = r / I_PG; cvt_item(p.in[I_POOLW] + (size_t)g * 65536, 256, 256, 256, (f16*)(ws + W_POOL) + (size_t)g * 65536, scr, r % I_PG, lane); continue; } r -= 4 * I_PG;
        if (r < I_GLU) { cvt_item(p.in[I_WGLU], 1024, 1024, 1024, (f16*)(ws + W_GLU), scr, r, lane); continue; } r -= I_GLU;
        if (r < I_OUT) { cvt_item(p.in[I_ABWOUT], D, D, D, (f16*)(ws + W_OUT), scr, r, lane); continue; } r -= I_OUT;
        if (r < I_CI) { cvt_item(p.in[I_CWIN], D, CIN, CINP, (f16*)(ws + W_CIN), scr, r, lane); continue; } r -= I_CI;
        if (r < I_CO) { cvt_item(p.in[I_CWOUT], D, D, D, (f16*)(ws + W_COUT), scr, r, lane); continue; } r -= I_CO;
        if (r < 2 * I_M1) { const int l = r / I_M1; cvt_item(p.in[I_W1] + (size_t)l * D * DFF, D, DFF, DFF, (f16*)(ws + W_1) + (size_t)l * D * DFF, scr, r % I_M1, lane); continue; } r -= 2 * I_M1;
        { const int l = r / I_M2; cvt_item(p.in[I_W2] + (size_t)l * D * DFF, DFF, D, D, (f16*)(ws + W_2) + (size_t)l * D * DFF, scr, r % I_M2, lane); }
    }
}

__device__ __forceinline__ void init_rows(const Params& p, float* H, f16* A) {
    const int tid_ = otid(), lane = tid_ & 63, gw = obid() * (NTHREADS / 64) + (tid_ >> 6), ngw = gridDim.x * (NTHREADS / 64);
    const float* g = p.in[I_NORMG];
    for (int row = gw; row < MP; row += ngw) {
        float4 h[8]; float ss = 0.f;
#pragma unroll
        for (int j = 0; j < 8; ++j) {
            const int c = 4 * lane + 256 * j;
            if (row < MMAIN) h[j] = ld4(p.in[I_X] + (size_t)row * D + c);
            else if (row < MREAL) h[j] = ld4(p.in[I_META] + (size_t)(row - MMAIN) * D + c);
            else h[j] = make_float4(0.f, 0.f, 0.f, 0.f);
            ss += h[j].x * h[j].x + h[j].y * h[j].y + h[j].z * h[j].z + h[j].w * h[j].w;
        }
        const float r = rsqrtf(wave_sum(ss) * (1.f / D) + EPS);
#pragma unroll
        for (int j = 0; j < 8; ++j) {
            const int c = 4 * lane + 256 * j; const float4 gg = ld4(g + c);
            *(float4*)(H + (size_t)row * D + c) = h[j];
            st4h(A + (size_t)row * D + c, make_float4(h[j].x * r * gg.x, h[j].y * r * gg.y, h[j].z * r * gg.z, h[j].w * r * gg.w));
        }
    }
}
__device__ __forceinline__ void rowpass(const f16* MIX, const float* ga, const float* gb, float* H, f16* A, float* OUT, int nrows) {
    const int tid_ = otid(), lane = tid_ & 63, gw = obid() * (NTHREADS / 64) + (tid_ >> 6), ngw = gridDim.x * (NTHREADS / 64);
    for (int row = gw; row < nrows; row += ngw) {
        float4 m[8], h[8]; float ss = 0.f;
#pragma unroll
        for (int j = 0; j < 8; ++j) {
            const int c = 4 * lane + 256 * j;
            m[j] = ld4(MIX + (size_t)row * D + c); h[j] = ld4(H + (size_t)row * D + c);
            ss += m[j].x * m[j].x + m[j].y * m[j].y + m[j].z * m[j].z + m[j].w * m[j].w;
        }
        const float r = rsqrtf(wave_sum(ss) * (1.f / D) + EPS);
        float s2 = 0.f;
#pragma unroll
        for (int j = 0; j < 8; ++j) {
            const int c = 4 * lane + 256 * j; const float4 gg = ld4(ga + c);
            h[j].x += m[j].x * r * gg.x; h[j].y += m[j].y * r * gg.y; h[j].z += m[j].z * r * gg.z; h[j].w += m[j].w * r * gg.w;
            s2 += h[j].x * h[j].x + h[j].y * h[j].y + h[j].z * h[j].z + h[j].w * h[j].w;
        }
        if (OUT) {
#pragma unroll
            for (int j = 0; j < 8; ++j) *(float4*)(OUT + (size_t)row * D + 4 * lane + 256 * j) = h[j];
        } else {
            const float r2 = rsqrtf(wave_sum(s2) * (1.f / D) + EPS);
#pragma unroll
            for (int j = 0; j < 8; ++j) {
                const int c = 4 * lane + 256 * j; const float4 gg = ld4(gb + c);
                *(float4*)(H + (size_t)row * D + c) = h[j];
                st4h(A + (size_t)row * D + c, make_float4(h[j].x * r2 * gg.x, h[j].y * r2 * gg.y, h[j].z * r2 * gg.z, h[j].w * r2 * gg.w));
            }
        }
    }
}

__device__ __forceinline__ void pool_diff(const f16* U, f16* DY) {
    const int total = MREAL * 128, stride = (int)gridDim.x * NTHREADS;
    for (int i = obid() * NTHREADS + otid(); i < total; i += stride) {
        const int row = i >> 7, c = (i & 127) * 8;
        const int b = row < MMAIN ? row >> 11 : 0, t = row < MMAIN ? (row & 2047) + NMETA : row - MMAIN;
        const int win = 2 << (c >> 8);
        const int cnt = (t + 1) < win ? (t + 1) : win;
        const float4 ua = ld4(U + (size_t)row * D + c), ub = ld4(U + (size_t)row * D + c + 4);
        float4 sa = ua, sb = ub;
        for (int j = 1; j < cnt; ++j) {
            const f16* up = U + (size_t)row_of(b, t - j) * D + c; const float4 a = ld4(up), bb = ld4(up + 4);
            sa.x += a.x; sa.y += a.y; sa.z += a.z; sa.w += a.w; sb.x += bb.x; sb.y += bb.y; sb.z += bb.z; sb.w += bb.w;
        }
        const float ic = 1.f / (float)cnt;
        f32x4 o0 = {sa.x * ic - ua.x, sa.y * ic - ua.y, sa.z * ic - ua.z, sa.w * ic - ua.w}, o1 = {sb.x * ic - ub.x, sb.y * ic - ub.y, sb.z * ic - ub.z, sb.w * ic - ub.w};
        st8h(DY + (size_t)row * D + c, o0, o1);
    }
}

__device__ __forceinline__ void pool_diff_old(const f16* U, f16* DY) {
    const size_t total = (size_t)MREAL * 1024, stride = (size_t)gridDim.x * NTHREADS;
    for (size_t i = (size_t)obid() * NTHREADS + otid(); i < total; i += stride) {
        const int row = (int)(i >> 10), c = (int)(i & 1023);
        const int b = row < MMAIN ? row >> 11 : 0, t = row < MMAIN ? (row & 2047) + NMETA : row - MMAIN;
        const int win = 2 << (c >> 8);
        const int cnt = (t + 1) < win ? (t + 1) : win;
        float s = 0.f;
        for (int j = 0; j < cnt; ++j) s += (float)U[(size_t)row_of(b, t - j) * D + c];
        DY[(size_t)row * D + c] = (f16)(s / (float)cnt - (float)U[(size_t)row * D + c]);
    }
}

__device__ __forceinline__ float gelu_tanh(float x) {
    const float k0 = 0.7978845608028654f, k1 = 0.044715f;
    return 0.5f * x * (1.f + tanhf(k0 * (x + k1 * x * x * x)));
}

typedef _Float16 f16x8 __attribute__((ext_vector_type(8)));
constexpr int SSM_WAVE_LDS = 128 * 20 * 4 + 16 * 136 * 2;
constexpr int SSM_CARRY_OFF = 8 * SSM_WAVE_LDS;
__device__ __forceinline__ void ssm_phase(const Params& p, const f16* U, f16* DY, LAS unsigned char* lds) {
    const int tid_ = otid(), lane = tid_ & 63, wv = __builtin_amdgcn_readfirstlane(tid_ >> 6), l15 = lane & 15, g2 = lane >> 4;
    LAS float* BUT = (LAS float*)(lds + wv * SSM_WAVE_LDS);
    LAS f16* HT = (LAS f16*)(lds + wv * SSM_WAVE_LDS + 128 * 20 * 4);
    typedef float f32x2_t __attribute__((ext_vector_type(2)));
    LAS f32x2_t* CARRY = (LAS f32x2_t*)(lds + SSM_CARRY_OFF);
    for (int item = obid(); item < 256; item += gridDim.x) {
        const int b = item >> 6, g = item & 63, n = lane;
        const float dt = expf(p.in[I_LOGDT][g]);
        const float ar = p.in[I_LRE][g * 64 + n], ai = p.in[I_LIM][g * 64 + n];
        float are, aim, pw0r, pw0i, pw1r, pw1i;
        { const float mag = expf(dt * ar); double sd, cd; sincos_d((double)(dt * ai), sd, cd); are = mag * (float)cd; aim = mag * (float)sd; }
        { const float mag = expf(272.f * dt * ar); double sd, cd; sincos_d(272.0 * (double)(dt * ai), sd, cd); pw0r = mag * (float)cd; pw0i = mag * (float)sd; }
        { const float mag = expf(256.f * dt * ar); double sd, cd; sincos_d(256.0 * (double)(dt * ai), sd, cd); pw1r = mag * (float)cd; pw1i = mag * (float)sd; }
        {
            const float den = ar * ar + ai * ai, zr = are - 1.f, zi = aim;
            const float fre = (zr * ar + zi * ai) / (den * dt), fim = (zi * ar - zr * ai) / (den * dt);
            LAS f16* TB = (LAS f16*)BUT;
#pragma unroll
            for (int c = 0; c < 16; ++c) {
                const float br = p.in[I_BRE][(g * 64 + n) * 16 + c], bi = p.in[I_BIM][(g * 64 + n) * 16 + c];
                TB[n * 16 + c] = (f16)(fre * br - fim * bi); TB[(64 + n) * 16 + c] = (f16)(fre * bi + fim * br);
            }
        }
        asm volatile("" ::: "memory");
        f16x8 bbf[8];
#pragma unroll
        for (int nt = 0; nt < 8; ++nt) {
            const f16x8 z = {0, 0, 0, 0, 0, 0, 0, 0};
            bbf[nt] = (g2 < 2) ? *(const LAS f16x8*)((const LAS f16*)BUT + (16 * nt + l15) * 16 + 8 * g2) : z;
        }
        asm volatile("" ::: "memory");
        f16x8 cf[4];
#pragma unroll
        for (int ks = 0; ks < 4; ++ks) {
            const int k = 32 * ks + 8 * g2;
            const float* src = (k < 64) ? (p.in[I_CRE] + (g * 16 + l15) * 64 + k) : (p.in[I_CIM] + (g * 16 + l15) * 64 + (k - 64));
            const float sg = (k < 64) ? 1.f : -1.f;
            const float4 x0 = ld4(src), x1 = ld4(src + 4);
            f16x8 v; v[0] = (f16)(sg * x0.x); v[1] = (f16)(sg * x0.y); v[2] = (f16)(sg * x0.z); v[3] = (f16)(sg * x0.w); v[4] = (f16)(sg * x1.x); v[5] = (f16)(sg * x1.y); v[6] = (f16)(sg * x1.z); v[7] = (f16)(sg * x1.w);
            cf[ks] = v;
        }
        float dd[4];
#pragma unroll
        for (int j = 0; j < 4; ++j) dd[j] = p.in[I_S5D][g * 16 + 4 * g2 + j];
        const int blk0 = (wv == 0) ? 0 : 17 + 16 * (wv - 1), nblk = (wv == 0) ? 17 : 16;
        float hr = 0.f, hi = 0.f;
#pragma unroll 1
        for (int pass = 0; pass < 2; ++pass) {
            if (pass == 1) {
                CARRY[wv * 64 + n] = (f32x2_t){hr, hi};
                __syncthreads();
                float cr = 0.f, ci = 0.f;
                for (int j = 0; j < wv; ++j) {
                    const f32x2_t e = CARRY[j * 64 + n]; const float pr = (j == 0) ? pw0r : pw1r, pi = (j == 0) ? pw0i : pw1i;
                    const float nr = pr * cr - pi * ci + e.x, ni = pr * ci + pi * cr + e.y; cr = nr; ci = ni;
                }
                hr = cr; hi = ci;
                __syncthreads();
            }
#pragma unroll 1
            for (int kb = 0; kb < nblk; ++kb) {
                const int t0 = (blk0 + kb) * 16;
                const int rowa = row_of(b, t0 + l15);
                f16x8 ua = {0, 0, 0, 0, 0, 0, 0, 0};
                if (g2 < 2) ua = *(const f16x8*)(U + (size_t)rowa * D + 1024 + g * 16 + 8 * g2);
                f32x4 bacc[8];
#pragma unroll
                for (int nt = 0; nt < 8; ++nt) bacc[nt] = __builtin_amdgcn_mfma_f32_16x16x32_f16(ua, bbf[nt], (f32x4){0.f, 0.f, 0.f, 0.f}, 0, 0, 0);
                __builtin_amdgcn_sched_barrier(0);
                asm volatile("s_nop 15\n\ts_nop 15" ::: "memory");
                __builtin_amdgcn_sched_barrier(0);
#pragma unroll
                for (int nt = 0; nt < 8; ++nt) *(LAS f32x4*)(BUT + (16 * nt + l15) * 20 + 4 * g2) = bacc[nt];
                asm volatile("" ::: "memory");
                float bre[16], bim[16];
#pragma unroll
                for (int q4 = 0; q4 < 4; ++q4) {
                    const f32x4 x = *(const LAS f32x4*)(BUT + n * 20 + 4 * q4), y = *(const LAS f32x4*)(BUT + (64 + n) * 20 + 4 * q4);
                    bre[4 * q4] = x[0]; bre[4 * q4 + 1] = x[1]; bre[4 * q4 + 2] = x[2]; bre[4 * q4 + 3] = x[3];
                    bim[4 * q4] = y[0]; bim[4 * q4 + 1] = y[1]; bim[4 * q4 + 2] = y[2]; bim[4 * q4 + 3] = y[3];
                }
#pragma unroll
                for (int tt = 0; tt < 16; ++tt) {
                    const float nr = fmaf(are, hr, fmaf(-aim, hi, bre[tt])), ni = fmaf(are, hi, fmaf(aim, hr, bim[tt]));
                    hr = nr; hi = ni;
                    if (pass == 1) { HT[tt * 136 + n] = (f16)hr; HT[tt * 136 + 64 + n] = (f16)hi; }
                }
                asm volatile("" ::: "memory");
                if (pass == 1) {
                    f32x4 ya = {0.f, 0.f, 0.f, 0.f};
#pragma unroll
                    for (int ks = 0; ks < 4; ++ks) {
                        const f16x8 hb = *(const LAS f16x8*)(HT + l15 * 136 + 32 * ks + 8 * g2);
                        ya = __builtin_amdgcn_mfma_f32_16x16x32_f16(cf[ks], hb, ya, 0, 0, 0);
                    }
                    __builtin_amdgcn_sched_barrier(0);
                    asm volatile("s_nop 15\n\ts_nop 15" ::: "memory");
                    __builtin_amdgcn_sched_barrier(0);
                    if (t0 >= NMETA || b == 0) {
                        const float4 uu = ld4(U + (size_t)rowa * D + 1024 + g * 16 + 4 * g2);
                        const float4 o = make_float4(gelu_tanh(dt * ya[0] + dd[0] * uu.x), gelu_tanh(dt * ya[1] + dd[1] * uu.y), gelu_tanh(dt * ya[2] + dd[2] * uu.z), gelu_tanh(dt * ya[3] + dd[3] * uu.w));
                        st4h(DY + (size_t)rowa * D + 1024 + g * 16 + 4 * g2, o);
                    }
                }
            }
        }
        __syncthreads();
    }
}

__device__ __forceinline__ void ssm_naive(const Params& p, const f16* U, f16* DY) {
    const int tid_ = otid(), lane = tid_ & 63, gw = obid() * (NTHREADS / 64) + (tid_ >> 6), ngw = gridDim.x * (NTHREADS / 64);
    for (int item = gw; item < 256; item += ngw) {
        const int b = item >> 6, g = item & 63, n = lane;
        const float dt = expf(p.in[I_LOGDT][g]);
        const float ar = p.in[I_LRE][g * 64 + n], ai = p.in[I_LIM][g * 64 + n];
        const float mag = expf(dt * ar); double sd, cd; sincos_d((double)(dt * ai), sd, cd); const float sn = (float)sd, cs = (float)cd;
        const float are = mag * cs, aim = mag * sn;
        const float den = ar * ar + ai * ai, zr = are - 1.f, zi = aim;
        const float fre = (zr * ar + zi * ai) / den, fim = (zi * ar - zr * ai) / den;
        float bbr[16], bbi[16], cr[16], ci[16];
#pragma unroll
        for (int c = 0; c < 16; ++c) {
            const float br = p.in[I_BRE][(g * 64 + n) * 16 + c], bi = p.in[I_BIM][(g * 64 + n) * 16 + c];
            bbr[c] = fre * br - fim * bi; bbi[c] = fre * bi + fim * br;
            cr[c] = p.in[I_CRE][(g * 16 + c) * 64 + n]; ci[c] = p.in[I_CIM][(g * 16 + c) * 64 + n];
        }
        const float dd = p.in[I_S5D][g * 16 + (lane & 15)];
        float hr = 0.f, hi = 0.f;
#pragma unroll 1
        for (int t = 0; t < T; ++t) {
            const int row = row_of(b, t);
            const f16* ur = U + (size_t)row * D + 1024 + g * 16;
            const float4 u0 = ld4(ur), u1 = ld4(ur + 4), u2 = ld4(ur + 8), u3 = ld4(ur + 12);
            const float uu[16] = {u0.x, u0.y, u0.z, u0.w, u1.x, u1.y, u1.z, u1.w, u2.x, u2.y, u2.z, u2.w, u3.x, u3.y, u3.z, u3.w};
            float bur = 0.f, bui = 0.f;
#pragma unroll
            for (int c = 0; c < 16; ++c) { bur = fmaf(bbr[c], uu[c], bur); bui = fmaf(bbi[c], uu[c], bui); }
            const float nhr = are * hr - aim * hi + bur, nhi = are * hi + aim * hr + bui;
            hr = nhr; hi = nhi;
            float myy = 0.f;
#pragma unroll
            for (int c = 0; c < 16; ++c) { const float v = wave_sum(cr[c] * hr - ci[c] * hi); if (lane == c) myy = v; }
            if (lane < 16 && (t >= NMETA || b == 0)) {
                const float y = myy + dd * (float)ur[lane];
                DY[(size_t)row * D + 1024 + g * 16 + lane] = (f16)gelu_tanh(y);
            }
        }
    }
}

__device__ __forceinline__ void rope_naive(float* PROJ) {
    const size_t total = (size_t)MREAL * 456, stride = (size_t)gridDim.x * NTHREADS;
    for (size_t i = (size_t)obid() * NTHREADS + otid(); i < total; i += stride) {
        const int row = (int)(i / 456); int r = (int)(i % 456);
        const int t = row < MMAIN ? (row & 2047) + NMETA : row - MMAIN;
        int col, half, idx;
        if (r < 256) { col = QOFF + (r >> 4) * 128; half = 16; idx = r & 15; }
        else if (r < 320) { r -= 256; col = KOFF + (r >> 4) * 128; half = 16; idx = r & 15; }
        else if (r < 448) { r -= 320; col = QIOFF + (r >> 3) * 64; half = 8; idx = r & 7; }
        else { r -= 448; col = KIOFF; half = 8; idx = r; }
        const float inv = rope_inv16(half == 16 ? idx : 2 * idx);
        const float ang = (float)t * inv;
        double sd, cd; sincos_d((double)ang, sd, cd);
        const float cs = (float)cd, sn = (float)sd;
        float* px = PROJ + (size_t)row * CIN + col;
        const float x1 = px[idx], x2 = px[half + idx];
        px[idx] = x1 * cs - x2 * sn; px[half + idx] = x2 * cs + x1 * sn;
    }
}

__device__ __forceinline__ void idx_scores(const float* PROJ, float* SCORE) {
    const int tid_ = otid(), lane = tid_ & 63, gw = obid() * (NTHREADS / 64) + (tid_ >> 6), ngw = gridDim.x * (NTHREADS / 64);
    for (int q = gw; q < MMAIN; q += ngw) {
        const int b = q >> 11, s = q & 2047, nall = 80 + 64 * (s >> 6);
        const float* qi = PROJ + (size_t)q * CIN + QIOFF;
        const float* wi = PROJ + (size_t)q * CIN + WIOFF;
        for (int t = lane; t < nall; t += 64) {
            const float* kp = PROJ + (size_t)row_of(b, t) * CIN + KIOFF;
            float4 kv[16];
#pragma unroll
            for (int j = 0; j < 16; ++j) kv[j] = ld4(kp + 4 * j);
            float score = 0.f;
#pragma unroll 1
            for (int h = 0; h < 16; ++h) {
                float dot = 0.f;
#pragma unroll
                for (int j = 0; j < 16; ++j) { const float4 qv = ld4(qi + h * 64 + 4 * j); dot += qv.x * kv[j].x + qv.y * kv[j].y + qv.z * kv[j].z + qv.w * kv[j].w; }
                score += (wi[h] * 0.03125f) * fmaxf(dot, 0.f);
            }
            SCORE[(size_t)q * SROW + t] = score;
        }
    }
}

__device__ __forceinline__ unsigned okey(float f) { const unsigned u = __float_as_uint(f); return (u & 0x80000000u) ? ~u : (u | 0x80000000u); }
__device__ __forceinline__ void select_topk(const float* SCORE, unsigned long long* MASK) {
    const int tid_ = otid(), lane = tid_ & 63, gw = obid() * (NTHREADS / 64) + (tid_ >> 6), ngw = gridDim.x * (NTHREADS / 64);
    for (int q = gw; q < MMAIN; q += ngw) {
        const int s = q & 2047, nall = 80 + 64 * (s >> 6);
        unsigned key[33];
#pragma unroll
        for (int i = 0; i < 33; ++i) { const int t = 64 * i + lane; key[i] = (t < nall) ? okey(SCORE[(size_t)q * SROW + t]) : 0u; }
        unsigned long long mymask = 0ull;
        if (nall <= 256) {
#pragma unroll
            for (int i = 0; i < 33; ++i) { const unsigned long long m = __ballot(64 * i + lane < nall); if (lane == i) mymask = m; }
        } else {
            unsigned tau = 0u;
#pragma unroll 1
            for (int bit = 31; bit >= 0; --bit) {
                const unsigned cand = tau | (1u << bit); int cnt = 0;
#pragma unroll
                for (int i = 0; i < 33; ++i) cnt += __popcll(__ballot(key[i] >= cand));
                if (cnt >= 256) tau = cand;
            }
            int ngt = 0;
#pragma unroll
            for (int i = 0; i < 33; ++i) ngt += __popcll(__ballot(key[i] > tau));
            const int need = 256 - ngt; int eqb = 0;
            const unsigned long long lt = (1ull << lane) - 1ull;
#pragma unroll
            for (int i = 0; i < 33; ++i) {
                const unsigned long long gm = __ballot(key[i] > tau), em = __ballot(key[i] == tau);
                const int rank = eqb + __popcll(em & lt);
                const unsigned long long sm = __ballot(key[i] == tau && rank < need);
                if (lane == i) mymask = gm | sm;
                eqb += __popcll(em);
            }
        }
        if (lane < 33) MASK[(size_t)q * 33 + lane] = mymask;
    }
}

__device__ __forceinline__ void attn_naive(float* lds, const float* PROJ, const unsigned long long* MASK, f16* O) {
    const int tid_ = otid(), lane = tid_ & 63, wv = tid_ >> 6, gw = obid() * (NTHREADS / 64) + wv, ngw = gridDim.x * (NTHREADS / 64);
    int* list = (int*)(lds + wv * 640);
    float* pl = lds + wv * 640 + 256;
    float* ql = lds + wv * 640 + 512;
    for (int item = gw; item < MMAIN * 16; item += ngw) {
        const int q = item >> 4, hq = item & 15, b = q >> 11, kvh = hq >> 2;
        int base = 0;
        for (int i = 0; i < 33; ++i) {
            const unsigned long long w = MASK[(size_t)q * 33 + i];
            if ((w >> lane) & 1ull) list[base + __popcll(w & ((1ull << lane) - 1ull))] = 64 * i + lane;
            base += __popcll(w);
        }
        const int nk = base;
        const float* qp = PROJ + (size_t)q * CIN + QOFF + hq * 128;
        ql[lane] = qp[lane]; ql[64 + lane] = qp[64 + lane];
        __builtin_amdgcn_s_waitcnt(0); __builtin_amdgcn_wave_barrier();
        float lg[4]; float mx = -INFINITY;
#pragma unroll
        for (int j = 0; j < 4; ++j) {
            const int kk = lane + 64 * j; lg[j] = -INFINITY;
            if (kk < nk) {
                const float* kp = PROJ + (size_t)row_of(b, list[kk]) * CIN + KOFF + kvh * 128;
                float dot = 0.f;
#pragma unroll 4
                for (int d = 0; d < 128; d += 4) { const float4 kv = ld4(kp + d); dot += kv.x * ql[d] + kv.y * ql[d + 1] + kv.z * ql[d + 2] + kv.w * ql[d + 3]; }
                lg[j] = dot * 0.08838834764831845f;
            }
            mx = fmaxf(mx, lg[j]);
        }
        mx = wave_max(mx);
        float sm = 0.f;
#pragma unroll
        for (int j = 0; j < 4; ++j) { const int kk = lane + 64 * j; const float e = (kk < nk) ? expf(lg[j] - mx) : 0.f; sm += e; pl[kk] = e; }
        sm = wave_sum(sm);
        __builtin_amdgcn_s_waitcnt(0); __builtin_amdgcn_wave_barrier();
        float o0 = 0.f, o1 = 0.f;
#pragma unroll 2
        for (int kk = 0; kk < nk; ++kk) {
            const float* vp = PROJ + (size_t)row_of(b, list[kk]) * CIN + VOFF + kvh * 128;
            const float pw = pl[kk];
            o0 = fmaf(pw, vp[lane], o0); o1 = fmaf(pw, vp[64 + lane], o1);
        }
        const float inv = 1.f / sm;
        O[(size_t)q * D + hq * 128 + lane] = (f16)(o0 * inv); O[(size_t)q * D + hq * 128 + 64 + lane] = (f16)(o1 * inv);
        __builtin_amdgcn_s_waitcnt(0); __builtin_amdgcn_wave_barrier();
    }
}

template <class F>
__device__ __forceinline__ void gemm(LAS unsigned char* lds, const f16* A, int lda, const f16* Bt, int ldb, int M, int N, int K, int cu, F f) {
    pg8::Gemm g{A, Bt, M, N, K, lda, ldb};
    pg8::StaticOrder S; S.init(M, N, (int)gridDim.x, cu);
    pg8::EpiRow8<F> E{f};
    pg8::gemm_phase<pg8::EpiRow8<F>, pg8::StaticOrder, true, true>(lds, g, S, E);
}

__global__ void __launch_bounds__(NTHREADS, 2) fwd(Params p) {
    cg::grid_group grid = cg::this_grid();
    extern __shared__ __attribute__((aligned(16))) unsigned char smem[];
    LAS unsigned char* lds = (LAS unsigned char*)smem;
    float* ldsf = (float*)smem;
    unsigned char* ws = p.ws;
    float* H = (float*)(ws + OFF_H); f16* A16 = (f16*)(ws + OFF_A16); f16* U16 = (f16*)(ws + OFF_U16);
    f16* DY16 = (f16*)(ws + OFF_DY16); f16* CAT16 = (f16*)(ws + OFF_CAT16);
    f16* HID16 = (f16*)(ws + OFF_BIG); float* PROJ = (float*)(ws + OFF_BIG);
    float* SCORE = (float*)(ws + OFF_SCORE); unsigned long long* MASK = (unsigned long long*)(ws + OFF_MASK); f16* O16 = (f16*)(ws + OFF_O16);
    const float* ng = p.in[I_NORMG];
    const int bid = (int)blockIdx.x, G = (int)gridDim.x;

    convert_weights(p, ldsf);
    init_rows(p, H, A16);
    grid.sync();
    gemm(lds, A16, D, (const f16*)(ws + W_IN), D, MP, D, D, bid, [=](int r, int c, f32x4 v0, f32x4 v1) { st8h(U16 + (size_t)r * D + c, v0, v1); });
    grid.sync();
    pool_diff(U16, DY16);
    ssm_phase(p, U16, DY16, lds);
    grid.sync();
    for (int g = 0; g < 4; ++g) {
        const float* ps = p.in[I_POOLS] + g * 256;
        gemm(lds, DY16 + g * 256, D, (const f16*)(ws + W_POOL) + (size_t)g * 65536, 256, MP, 256, 256, (bid + G - 33 * g) % G,
             [=](int r, int c, f32x4 v0, f32x4 v1) { const f32x4 s0 = *(const f32x4*)(ps + c), s1 = *(const f32x4*)(ps + c + 4); st8h(CAT16 + (size_t)r * D + g * 256 + c, v0 * s0, v1 * s1); });
    }
    gemm(lds, DY16 + 1024, D, (const f16*)(ws + W_GLU), 1024, MP, 1024, 1024, (bid + G - 132) % G,
         [=](int r, int c, f32x4 v0, f32x4 v1) {
             const f16* yp = DY16 + (size_t)r * D + 1024 + c; const float4 y0 = ld4(yp), y1 = ld4(yp + 4);
             f32x4 o0, o1;
             o0[0] = y0.x / (1.f + __expf(-v0[0])); o0[1] = y0.y / (1.f + __expf(-v0[1])); o0[2] = y0.z / (1.f + __expf(-v0[2])); o0[3] = y0.w / (1.f + __expf(-v0[3]));
             o1[0] = y1.x / (1.f + __expf(-v1[0])); o1[1] = y1.y / (1.f + __expf(-v1[1])); o1[2] = y1.z / (1.f + __expf(-v1[2])); o1[3] = y1.w / (1.f + __expf(-v1[3]));
             st8h(CAT16 + (size_t)r * D + 1024 + c, o0, o1); });
    grid.sync();
    gemm(lds, CAT16, D, (const f16*)(ws + W_OUT), D, MP, D, D, bid, [=](int r, int c, f32x4 v0, f32x4 v1) { st8h(U16 + (size_t)r * D + c, v0, v1); });
    grid.sync();
    rowpass(U16, ng + 1 * D, ng + 2 * D, H, A16, nullptr, MP);
    grid.sync();
    gemm(lds, A16, D, (const f16*)(ws + W_1), D, MP, DFF, D, bid, [=](int r, int c, f32x4 v0, f32x4 v1) {
        f32x4 z0 = __builtin_elementwise_max(v0, (f32x4){0.f, 0.f, 0.f, 0.f}), z1 = __builtin_elementwise_max(v1, (f32x4){0.f, 0.f, 0.f, 0.f}); st8h(HID16 + (size_t)r * DFF + c, z0 * z0, z1 * z1); });
    grid.sync();
    gemm(lds, HID16, DFF, (const f16*)(ws + W_2), DFF, MP, D, DFF, bid, [=](int r, int c, f32x4 v0, f32x4 v1) { st8h(U16 + (size_t)r * D + c, v0, v1); });
    grid.sync();
    rowpass(U16, ng + 3 * D, ng + 4 * D, H, A16, nullptr, MP);
    grid.sync();
    gemm(lds, A16, D, (const f16*)(ws + W_CIN), D, MP, CINP, D, bid, [=](int r, int c, f32x4 v0, f32x4 v1) {
        if (c < CIN) { float* o = PROJ + (size_t)r * CIN + c; *(f32x4*)o = v0; *(f32x4*)(o + 4) = v1; } });
    grid.sync();
    rope_naive(PROJ);
    grid.sync();
    idx_scores(PROJ, SCORE);
    grid.sync();
    select_topk(SCORE, MASK);
    grid.sync();
    attn_naive(ldsf, PROJ, MASK, O16);
    grid.sync();
    gemm(lds, O16, D, (const f16*)(ws + W_COUT), D, MMAIN, D, D, bid, [=](int r, int c, f32x4 v0, f32x4 v1) { st8h(U16 + (size_t)r * D + c, v0, v1); });
    grid.sync();
    rowpass(U16, ng + 5 * D, ng + 6 * D, H, A16, nullptr, MMAIN);
    grid.sync();
    gemm(lds, A16, D, (const f16*)(ws + W_1) + (size_t)D * DFF, D, MMAIN, DFF, D, bid, [=](int r, int c, f32x4 v0, f32x4 v1) {
        f32x4 z0 = __builtin_elementwise_max(v0, (f32x4){0.f, 0.f, 0.f, 0.f}), z1 = __builtin_elementwise_max(v1, (f32x4){0.f, 0.f, 0.f, 0.f}); st8h(HID16 + (size_t)r * DFF + c, z0 * z0, z1 * z1); });
    grid.sync();
    gemm(lds, HID16, DFF, (const f16*)(ws + W_2) + (size_t)D * DFF, DFF, MMAIN, D, DFF, bid, [=](int r, int c, f32x4 v0, f32x4 v1) { st8h(U16 + (size_t)r * D + c, v0, v1); });
    grid.sync();
    rowpass(U16, ng + 7 * D, nullptr, H, nullptr, p.out, MMAIN);
}

extern "C" void kernel_launch(void* const* d_in, const int* in_sizes, int n_in, void* d_out, int out_size, void* d_ws, size_t ws_size, hipStream_t stream) {
    static int grid_blocks = 0;
    if (!grid_blocks) {
        if (n_in != 20 || out_size != MMAIN * D || ws_size < WS_NEED) { fprintf(stderr, "kernel_launch: unexpected shapes n_in %d out %d ws %zu (need %zu)\n", n_in, out_size, ws_size, (size_t)WS_NEED); grid_blocks = -1; return; }
        int dev = 0, cus = 0, per_cu = 0;
        (void)hipGetDevice(&dev);
        (void)hipDeviceGetAttribute(&cus, hipDeviceAttributeMultiprocessorCount, dev);
        if (hipFuncSetAttribute((const void*)fwd, hipFuncAttributeMaxDynamicSharedMemorySize, LDS_BYTES) != hipSuccess) { fprintf(stderr, "kernel_launch: hipFuncSetAttribute failed\n"); grid_blocks = -1; return; }
        (void)hipOccupancyMaxActiveBlocksPerMultiprocessor(&per_cu, fwd, NTHREADS, LDS_BYTES);
        if (per_cu < 1) { fprintf(stderr, "kernel_launch: occupancy query says %d blocks per CU\n", per_cu); per_cu = 1; }
        grid_blocks = cus;
    }
    if (grid_blocks < 0) return;
    Params p{};
    for (int i = 0; i < 20; ++i) p.in[i] = (const float*)d_in[i];
    p.out = (float*)d_out; p.ws = (unsigned char*)d_ws;
    void* args[] = {&p};
    hipError_t e = hipLaunchCooperativeKernel((void*)fwd, dim3(grid_blocks), dim3(NTHREADS), args, LDS_BYTES, stream);
    if (e != hipSuccess) fprintf(stderr, "cooperative launch failed: %s (grid %d)\n", hipGetErrorString(e), grid_blocks);
}
```

```cpp
#include <hip/hip_runtime.h>
#include <hip/hip_fp16.h>
#include <hip/hip_cooperative_groups.h>
#include <cstdio>
#include <cstdint>
#include <cmath>
namespace cg = cooperative_groups;
__device__ __forceinline__ int otid() { int t = threadIdx.x; asm volatile("" : "+v"(t)); return t; }
__device__ __forceinline__ int obid() { int t = blockIdx.x; asm volatile("" : "+s"(t)); return t; }

namespace pg8 {
#define PG8_LAS __attribute__((address_space(3)))
typedef _Float16 f16_t;
typedef _Float16 f16x8 __attribute__((ext_vector_type(8)));
typedef float f32x4 __attribute__((ext_vector_type(4)));
typedef unsigned u32x4 __attribute__((ext_vector_type(4)));
constexpr int BM = 256, BK = 64, HALF = 128, HTB = HALF * BK * 2  , STAGE_BYTES = 8 * HTB, NXCD = 8, WGM = 8;

__host__ __device__ __forceinline__ int lds_byte(int r, int c) { const int st = (r >> 4) * 2 + (c >> 5), rr = r & 15, cc = c & 31, ob = rr * 64 + cc * 2; return st * 1024 + (ob ^ (((ob >> 9) & 1) << 5)); }
__host__ __device__ __forceinline__ void stage_rc(int b, int& R, int& C) { const int st = b / 1024, sb = b % 1024, swz = sb ^ (((sb >> 9) & 1) << 5); R = (st >> 1) * 16 + swz / 64; C = (st & 1) * 32 + (swz % 64) / 2; }
__host__ __device__ __forceinline__ int perm32(int rho) { const int n = rho >> 4, i = rho & 15; return 8 * (i >> 2) + 4 * n + (i & 3); }

struct Unit { int pm, pn; };
struct Gemm { const f16_t* A; const f16_t* Bt; int M, N, K, lda, ldb; };

struct StaticOrder {
    int nM, nN, nwg, G, c;
    __host__ __device__ void init(int M, int N, int G_, int c_) { nM = M / BM; nN = N / BM; nwg = nM * nN; G = G_; c = c_; }
    __host__ __device__ bool next(int i, Unit& u) const {
        const long L = (long)i * G + c; if (L >= nwg) return false;
        int wgid = (int)L; { const int q = nwg / NXCD, r = nwg % NXCD, xcd = wgid % NXCD, off = wgid / NXCD; wgid = (xcd < r ? xcd * (q + 1) : r * (q + 1) + (xcd - r) * q) + off; }
        const int nig = WGM * nN, gid = wgid / nig, fm = gid * WGM, gsz = (nM - fm) < WGM ? (nM - fm) : WGM;
        u.pm = fm + ((wgid % nig) % gsz); u.pn = (wgid % nig) / gsz; return true;
    }
    __device__ __forceinline__ void a_ready(const Unit&) const {}
    __device__ __forceinline__ void done(const Unit&) const {}
};


template <class Epi, class Sched, bool ALIGN_EPI = false, bool SP2 = false>
__device__ __forceinline__ void gemm_phase(PG8_LAS unsigned char* lds, const Gemm g, const Sched& S, const Epi& E) {
    const int tid = otid(), wid = __builtin_amdgcn_readfirstlane(tid >> 6), lane = tid & 63, wr = wid >> 2, wc = wid & 3, fr = lane & 15, fq = lane >> 4;
    const int K = g.K, nt = K / BK;
    unsigned voffA[2], voffB[2];
#pragma unroll
    for (int i = 0; i < 2; ++i) { int R, C; stage_rc(tid * 16 + i * 8192, R, C); const int Rb = Epi::PERM ? ((R & ~31) + perm32(R & 31)) : R;
        voffA[i] = (unsigned)(R * g.lda + C) * 2u; voffB[i] = (unsigned)(Rb * g.ldb + C) * 2u; }
    const size_t kstep = (size_t)(BK * 2);
    const size_t hstepA = (size_t)HALF * g.lda * 2, hstepB = (size_t)HALF * g.ldb * 2;
    const size_t tstepA = 2 * hstepA, tstepB = 2 * hstepB;
    const unsigned ldsw = (unsigned)wid * 1024u;
    const int aoff = lds_byte(wr * 64 + fr, fq * 8), boff = lds_byte(wc * 32 + fr, fq * 8);
#define PG8_SA(b, h) (((b) * 2 + (h)) * HTB)
#define PG8_SB(b, h) ((4 + (b) * 2 + (h)) * HTB)
#define PG8_STAGE(bufoff, gbase, voff) do { _Pragma("unroll") for (int _i = 0; _i < 2; ++_i) \
        __builtin_amdgcn_global_load_lds((const unsigned*)((const char*)(gbase) + (voff)[_i]), (PG8_LAS unsigned*)(lds + (bufoff) + ldsw + _i * 8192), 16, 0, 0); } while (0)
#define PG8_LDA(dst, b, h) do { _Pragma("unroll") for (int m = 0; m < 4; ++m) _Pragma("unroll") for (int k = 0; k < 2; ++k) dst[m][k] = *(const PG8_LAS f16x8*)(lds + PG8_SA(b, h) + aoff + m * 2048 + k * 1024); } while (0)
#define PG8_LDB(dst, b, h) do { _Pragma("unroll") for (int n = 0; n < 2; ++n) _Pragma("unroll") for (int k = 0; k < 2; ++k) dst[n][k] = *(const PG8_LAS f16x8*)(lds + PG8_SB(b, h) + boff + n * 2048 + k * 1024); } while (0)
#define PG8_MMA(ai, bj, At, Bt) do { __builtin_amdgcn_s_setprio(1); _Pragma("unroll") for (int m = 0; m < 4; ++m) _Pragma("unroll") for (int n = 0; n < 2; ++n) _Pragma("unroll") for (int k = 0; k < 2; ++k) \
        acc[ai][bj][m][n] = __builtin_amdgcn_mfma_f32_16x16x32_f16(Bt[n][k], At[m][k], acc[ai][bj][m][n], 0, 0, 0); __builtin_amdgcn_s_setprio(0); } while (0)
#define PG8_WAIT_V(n) asm volatile("s_waitcnt vmcnt(" #n ")" ::: "memory")
#define PG8_WAIT_L(n) asm volatile("s_waitcnt lgkmcnt(" #n ")" ::: "memory")
#define PG8_BAR __builtin_amdgcn_s_barrier()
#define PG8_SCHED __builtin_amdgcn_sched_barrier(0)
    Unit cur, nxt; int ui = 0;
    if (!S.next(0, cur)) return;
    f32x4 acc[2][2][4][2];
#pragma unroll
    for (int a = 0; a < 2; ++a)
#pragma unroll
        for (int b = 0; b < 2; ++b)
#pragma unroll
            for (int m = 0; m < 4; ++m)
#pragma unroll
                for (int n = 0; n < 2; ++n) acc[a][b][m][n] = (f32x4){0.f, 0.f, 0.f, 0.f};
    f16x8 At[4][2], B0[2][2], B1[2][2];
    const char* cA = (const char*)g.A + (size_t)cur.pm * tstepA; const char* cB = (const char*)g.Bt + (size_t)cur.pn * tstepB;
    S.a_ready(cur);
    if constexpr (SP2) {
        PG8_STAGE(PG8_SB(0, 0), cB, voffB); PG8_STAGE(PG8_SB(0, 1), cB + hstepB, voffB); PG8_STAGE(PG8_SA(0, 0), cA, voffA); PG8_STAGE(PG8_SA(0, 1), cA + hstepA, voffA);
        if (wr == 1) PG8_BAR;
        PG8_WAIT_V(2); PG8_BAR;
        PG8_STAGE(PG8_SB(1, 0), cB + kstep, voffB); PG8_STAGE(PG8_SA(1, 0), cA + kstep, voffA); PG8_STAGE(PG8_SB(1, 1), cB + hstepB + kstep, voffB);
        PG8_WAIT_V(6); PG8_BAR;
    } else {
        PG8_STAGE(PG8_SB(0, 0), cB, voffB); PG8_STAGE(PG8_SA(0, 0), cA, voffA); PG8_STAGE(PG8_SB(0, 1), cB + hstepB, voffB); PG8_STAGE(PG8_SA(0, 1), cA + hstepA, voffA);
        if (wr == 1) PG8_BAR;
        PG8_WAIT_V(4); PG8_BAR;
        PG8_STAGE(PG8_SB(1, 0), cB + kstep, voffB); PG8_STAGE(PG8_SA(1, 0), cA + kstep, voffA); PG8_STAGE(PG8_SB(1, 1), cB + hstepB + kstep, voffB);
        PG8_WAIT_V(6); PG8_BAR;
    }
    for (;;) {
        const bool has_next = S.next(ui + 1, nxt);
        const char* nA = has_next ? (const char*)g.A + (size_t)nxt.pm * tstepA : cA; const char* nB = has_next ? (const char*)g.Bt + (size_t)nxt.pn * tstepB : cB;
        for (int t = 0; t < nt; t += 2) {
            const bool last = (t == nt - 2);
            const char* a1 = cA + (size_t)(t + 1) * kstep;
            const char* a2 = last ? nA : cA + (size_t)(t + 2) * kstep; const char* b2 = last ? nB : cB + (size_t)(t + 2) * kstep;
            const char* a3 = a2 + kstep; const char* b3 = b2 + kstep;
            if (last && has_next) S.a_ready(nxt);
            if constexpr (SP2) {
            PG8_LDB(B0, 0, 0); PG8_LDB(B1, 0, 1); PG8_SCHED; PG8_LDA(At, 0, 0); PG8_STAGE(PG8_SA(1, 1), a1 + hstepA, voffA);
            PG8_WAIT_V(8); PG8_WAIT_L(0); PG8_BAR; PG8_MMA(0, 0, At, B0); PG8_MMA(0, 1, At, B1); PG8_BAR; PG8_SCHED;
            PG8_LDA(At, 0, 1); PG8_STAGE(PG8_SB(0, 0), b2, voffB); PG8_STAGE(PG8_SB(0, 1), b2 + hstepB, voffB); PG8_STAGE(PG8_SA(0, 0), a2, voffA);
            PG8_WAIT_V(8); PG8_WAIT_L(0); PG8_BAR; PG8_MMA(1, 0, At, B0); PG8_MMA(1, 1, At, B1); PG8_BAR; PG8_SCHED;
            PG8_LDB(B0, 1, 0); PG8_LDB(B1, 1, 1); PG8_SCHED; PG8_LDA(At, 1, 0); PG8_STAGE(PG8_SA(0, 1), a2 + hstepA, voffA);
            PG8_WAIT_V(8); PG8_WAIT_L(0); PG8_BAR; PG8_MMA(0, 0, At, B0); PG8_MMA(0, 1, At, B1); PG8_BAR; PG8_SCHED;
            PG8_LDA(At, 1, 1); PG8_STAGE(PG8_SB(1, 0), b3, voffB); PG8_STAGE(PG8_SB(1, 1), b3 + hstepB, voffB); PG8_STAGE(PG8_SA(1, 0), a3, voffA);
            PG8_WAIT_V(8); PG8_WAIT_L(0); PG8_BAR; PG8_MMA(1, 0, At, B0); PG8_MMA(1, 1, At, B1); PG8_BAR; PG8_SCHED;
            } else {
            PG8_LDB(B0, 0, 0); PG8_SCHED; PG8_LDA(At, 0, 0); PG8_STAGE(PG8_SA(1, 1), a1 + hstepA, voffA);
            PG8_WAIT_L(8); PG8_BAR; PG8_WAIT_L(0); PG8_MMA(0, 0, At, B0); PG8_BAR; PG8_SCHED;
            PG8_LDB(B1, 0, 1); PG8_STAGE(PG8_SB(0, 0), b2, voffB);
            PG8_BAR; PG8_WAIT_L(0); PG8_MMA(0, 1, At, B1); PG8_BAR;
            PG8_LDA(At, 0, 1); PG8_STAGE(PG8_SA(0, 0), a2, voffA);
            PG8_BAR; PG8_WAIT_L(0); PG8_MMA(1, 0, At, B0); PG8_BAR; PG8_SCHED;
            PG8_STAGE(PG8_SB(0, 1), b2 + hstepB, voffB);
            PG8_WAIT_V(6); PG8_BAR; PG8_MMA(1, 1, At, B1); PG8_BAR;
            PG8_LDB(B0, 1, 0); PG8_SCHED; PG8_LDA(At, 1, 0); PG8_STAGE(PG8_SA(0, 1), a2 + hstepA, voffA);
            PG8_WAIT_L(8); PG8_BAR; PG8_WAIT_L(0); PG8_MMA(0, 0, At, B0); PG8_BAR; PG8_SCHED;
            PG8_LDB(B1, 1, 1); PG8_STAGE(PG8_SB(1, 0), b3, voffB);
            PG8_BAR; PG8_WAIT_L(0); PG8_MMA(0, 1, At, B1); PG8_BAR;
            PG8_LDA(At, 1, 1); PG8_STAGE(PG8_SA(1, 0), a3, voffA);
            PG8_BAR; PG8_WAIT_L(0); PG8_MMA(1, 0, At, B0); PG8_BAR; PG8_SCHED;
            PG8_STAGE(PG8_SB(1, 1), b3 + hstepB, voffB);
            PG8_WAIT_V(6); PG8_BAR; PG8_MMA(1, 1, At, B1); PG8_BAR;
            }
        }
        if constexpr (ALIGN_EPI) { if (wr == 0) PG8_BAR; }
        if constexpr (!Epi::AFTER_DRAIN) { E(acc, cur, wr, wc, fr, fq); S.done(cur); }
        if (!has_next) break;
#pragma unroll
        for (int a = 0; a < 2; ++a)
#pragma unroll
            for (int b = 0; b < 2; ++b)
#pragma unroll
                for (int m = 0; m < 4; ++m)
#pragma unroll
                    for (int n = 0; n < 2; ++n) acc[a][b][m][n] = (f32x4){0.f, 0.f, 0.f, 0.f};
        cur = nxt; cA = nA; cB = nB; ++ui;
        if constexpr (ALIGN_EPI) { if (wr == 1) PG8_BAR; }
    }
    PG8_WAIT_V(0);
    if constexpr (!ALIGN_EPI) { if (wr == 0) PG8_BAR; }
    PG8_BAR;
    if constexpr (Epi::AFTER_DRAIN) { E.fused(acc, cur, wr, wc, fr, fq, lds, wid, lane); S.done(cur); }
#undef PG8_SA
#undef PG8_SB
#undef PG8_STAGE
#undef PG8_LDA
#undef PG8_LDB
#undef PG8_MMA
#undef PG8_WAIT_V
#undef PG8_WAIT_L
#undef PG8_BAR
#undef PG8_SCHED
}

template <class F> struct EpiRow8 {
    static constexpr bool PERM = true, AFTER_DRAIN = false;
    F f;
    __device__ __forceinline__ void operator()(const f32x4 (&acc)[2][2][4][2], const Unit& u, int wr, int wc, int fr, int fq) const {
        const int row0 = u.pm * BM + wr * 64 + fr, col0 = u.pn * BM + wc * 32 + 8 * fq;
#pragma unroll
        for (int ai = 0; ai < 2; ++ai)
#pragma unroll
            for (int m = 0; m < 4; ++m)
#pragma unroll
                for (int bj = 0; bj < 2; ++bj) f(row0 + ai * HALF + m * 16, col0 + bj * HALF, acc[ai][bj][m][0], acc[ai][bj][m][1]);
    }
};
}

#define LAS __attribute__((address_space(3)))
typedef _Float16 f16;
typedef float f32x4 __attribute__((ext_vector_type(4)));
typedef unsigned u32x4 __attribute__((ext_vector_type(4)));
typedef _Float16 h2v __attribute__((ext_vector_type(2)));

constexpr int D = 2048, NMETA = 16, SEQ = 2048, T = 2064, DFF = 8192;
constexpr int MMAIN = 8192;
constexpr int MREAL = 8208;
constexpr int MP = 8448;
constexpr int CIN = 4176, CINP = 4352;
constexpr int QOFF = 0, KOFF = 2048, VOFF = 2560, QIOFF = 3072, KIOFF = 4096, WIOFF = 4160;
constexpr int SROW = 2112;
constexpr float EPS = 1e-6f;
constexpr int NTHREADS = 512;
constexpr int LDS_BYTES = 147456;

struct Params { const float* in[20]; float* out; unsigned char* ws; };
enum { I_X = 0, I_META, I_NORMG, I_ABWIN, I_POOLW, I_POOLS, I_LRE, I_LIM, I_LOGDT, I_BRE, I_BIM, I_CRE, I_CIM, I_S5D, I_WGLU, I_ABWOUT, I_CWIN, I_CWOUT, I_W1, I_W2 };

constexpr int TP = 2112;
constexpr size_t SZ4 = (size_t)MP * D * 4, SZ2 = (size_t)MP * D * 2;
constexpr size_t OFF_H = 0, OFF_A16 = OFF_H + SZ4, OFF_U16 = OFF_A16 + SZ2, OFF_DY16 = OFF_U16 + SZ2, OFF_CAT16 = OFF_DY16 + SZ2, OFF_BIG = OFF_CAT16 + SZ2;
constexpr size_t SZ_BIG = (size_t)MP * DFF * 2;
constexpr size_t OFF_Q16 = OFF_BIG, OFF_K16 = OFF_Q16 + (size_t)MMAIN * D * 2, OFF_V16 = OFF_K16 + (size_t)4 * TP * 512 * 2, OFF_QI16 = OFF_V16 + (size_t)4 * TP * 512 * 2,
                 OFF_KI16 = OFF_QI16 + (size_t)MMAIN * 1024 * 2, OFF_WI = OFF_KI16 + (size_t)4 * TP * 64 * 2, OFF_ATT_END = OFF_WI + (size_t)MMAIN * 16 * 4;
static_assert(OFF_ATT_END <= OFF_BIG + SZ_BIG, "attention buffers fit the BIG region");
constexpr size_t OFF_MASK = OFF_BIG + SZ_BIG, SZ_MASK = (size_t)MMAIN * 33 * 8;
constexpr size_t OFF_ROPE16 = OFF_MASK + SZ_MASK, OFF_ROPE8 = OFF_ROPE16 + (size_t)T * 16 * 8;
constexpr size_t OFF_W = OFF_ROPE8 + (size_t)T * 8 * 8;
constexpr size_t OFF_SCORE = OFF_DY16, OFF_O16 = OFF_A16;
constexpr size_t W_IN = OFF_W, W_POOL = W_IN + (size_t)D * D * 2, W_GLU = W_POOL + (size_t)4 * 256 * 256 * 2, W_OUT = W_GLU + (size_t)1024 * 1024 * 2,
                 W_CIN = W_OUT + (size_t)D * D * 2, W_COUT = W_CIN + (size_t)CINP * D * 2, W_1 = W_COUT + (size_t)D * D * 2, W_2 = W_1 + (size_t)2 * D * DFF * 2,
                 WS_NEED = W_2 + (size_t)2 * D * DFF * 2;
static_assert((size_t)MMAIN * SROW * 4 <= 2 * SZ2, "SCORE fits DY16+CAT16");
static_assert(OFF_W % 256 == 0, "alignment");

__device__ __forceinline__ int row_of(int b, int t) { return t < NMETA ? MMAIN + t : b * SEQ + (t - NMETA); }
__device__ __forceinline__ float wave_sum(float v) {
#pragma unroll
    for (int o = 1; o < 64; o <<= 1) v += __shfl_xor(v, o);
    return v;
}
__device__ __forceinline__ float wave_max(float v) {
#pragma unroll
    for (int o = 1; o < 64; o <<= 1) v = fmaxf(v, __shfl_xor(v, o));
    return v;
}
__device__ __forceinline__ float4 ld4(const float* p) { return *(const float4*)p; }
__device__ __forceinline__ unsigned pk2h(float a, float b) { h2v r; r.x = (_Float16)a; r.y = (_Float16)b; return __builtin_bit_cast(unsigned, r); }
__device__ __forceinline__ float2 up2h(unsigned u) { const h2v r = __builtin_bit_cast(h2v, u); return make_float2((float)r.x, (float)r.y); }
__device__ __forceinline__ float4 ld4(const f16* p) { const uint2 r = *(const uint2*)p; const float2 a = up2h(r.x), b = up2h(r.y); return make_float4(a.x, a.y, b.x, b.y); }
__device__ __forceinline__ void st4h(f16* p, float4 v) { uint2 r; r.x = pk2h(v.x, v.y); r.y = pk2h(v.z, v.w); *(uint2*)p = r; }
__device__ __forceinline__ void st8h(f16* p, f32x4 a, f32x4 b) { u32x4 w; w.x = pk2h(a[0], a[1]); w.y = pk2h(a[2], a[3]); w.z = pk2h(b[0], b[1]); w.w = pk2h(b[2], b[3]); *(u32x4*)p = w; }

__device__ __forceinline__ void sincos_d(double x, double& sn, double& cs) {
    const double q = rint(x * 0.6366197723675814);
    double r = fma(-q, 1.5707963267948966, x); r = fma(-q, 6.123233995736766e-17, r);
    const double r2 = r * r;
    double sp = -1.0 / 6227020800.0; sp = fma(sp, r2, 1.0 / 39916800.0); sp = fma(sp, r2, -1.0 / 362880.0); sp = fma(sp, r2, 1.0 / 5040.0); sp = fma(sp, r2, -1.0 / 120.0); sp = fma(sp, r2, 1.0 / 6.0); sp = fma(sp, r2, -1.0); sp = -sp * r;
    double cp = 1.0 / 87178291200.0; cp = fma(cp, r2, -1.0 / 479001600.0); cp = fma(cp, r2, 1.0 / 3628800.0); cp = fma(cp, r2, -1.0 / 40320.0); cp = fma(cp, r2, 1.0 / 720.0); cp = fma(cp, r2, -1.0 / 24.0); cp = fma(cp, r2, 0.5); cp = fma(-cp, r2, 1.0);
    const int n = ((int)q) & 3;
    sn = (n == 0) ? sp : (n == 1) ? cp : (n == 2) ? -sp : -cp;
    cs = (n == 0) ? cp : (n == 1) ? -sp : (n == 2) ? -cp : sp;
}
__device__ __forceinline__ float rope_inv16(int idx) {
    const double r = 1.0 / sqrt(sqrt(sqrt(sqrt(500000.0))));
    double v = 1.0;
    for (int i = 0; i < idx; ++i) v *= r;
    return (float)v;
}

__device__ __forceinline__ void cvt_item(const float* W, int K, int N, int NPAD, f16* WT, float* scr, int item, int lane) {
    const int nblk = NPAD / 32, kb = item / nblk, nb = item % nblk, k0 = 64 * kb, n0 = 32 * nb;
    const int n = n0 + (lane & 31);
#pragma unroll 8
    for (int i = 0; i < 32; ++i) { const int kk = 2 * i + (lane >> 5); scr[kk * 33 + (lane & 31)] = (n < N) ? W[(size_t)(k0 + kk) * N + n] : 0.f; }
    const int c = lane & 7;
#pragma unroll
    for (int j = 0; j < 4; ++j) { const int nn = (lane >> 3) + 8 * j; const float* s = scr + (8 * c) * 33 + nn;
        u32x4 o; o.x = pk2h(s[0 * 33], s[1 * 33]); o.y = pk2h(s[2 * 33], s[3 * 33]); o.z = pk2h(s[4 * 33], s[5 * 33]); o.w = pk2h(s[6 * 33], s[7 * 33]);
        *(u32x4*)(WT + (size_t)(n0 + nn) * K + k0 + 8 * c) = o; }
}
__device__ __forceinline__ void convert_weights(const Params& p, float* ldsf) {
    const int tid_ = otid(), lane = tid_ & 63, wv = tid_ >> 6, gw = obid() * (NTHREADS / 64) + wv, ngw = gridDim.x * (NTHREADS / 64);
    float* scr = ldsf + wv * (64 * 33);
    unsigned char* ws = p.ws;
    constexpr int I_IN = 32 * 64, I_PG = 4 * 8, I_GLU = 16 * 32, I_OUT = 32 * 64, I_CI = 32 * (CINP / 32), I_CO = 32 * 64, I_M1 = 32 * 256, I_M2 = 128 * 64;
    constexpr int NITEMS = I_IN + 4 * I_PG + I_GLU + I_OUT + I_CI + I_CO + 2 * I_M1 + 2 * I_M2;
    for (int it = gw; it < NITEMS; it += ngw) {
        int r = it;
        if (r < I_IN) { cvt_item(p.in[I_ABWIN], D, D, D, (f16*)(ws + W_IN), scr, r, lane); continue; } r -= I_IN;
        if (r < 4 * I_PG) { const int g = r / I_PG; cvt_item(p.in[I_POOLW] + (size_t)g * 65536, 256, 256, 256, (f16*)(ws + W_POOL) + (size_t)g * 65536, scr, r % I_PG, lane); continue; } r -= 4 * I_PG;
        if (r < I_GLU) { cvt_item(p.in[I_WGLU], 1024, 1024, 1024, (f16*)(ws + W_GLU), scr, r, lane); continue; } r -= I_GLU;
        if (r < I_OUT) { cvt_item(p.in[I_ABWOUT], D, D, D, (f16*)(ws + W_OUT), scr, r, lane); continue; } r -= I_OUT;
        if (r < I_CI) { cvt_item(p.in[I_CWIN], D, CIN, CINP, (f16*)(ws + W_CIN), scr, r, lane); continue; } r -= I_CI;
        if (r < I_CO) { cvt_item(p.in[I_CWOUT], D, D, D, (f16*)(ws + W_COUT), scr, r, lane); continue; } r -= I_CO;
        if (r < 2 * I_M1) { const int l = r / I_M1; cvt_item(p.in[I_W1] + (size_t)l * D * DFF, D, DFF, DFF, (f16*)(ws + W_1) + (size_t)l * D * DFF, scr, r % I_M1, lane); continue; } r -= 2 * I_M1;
        { const int l = r / I_M2; cvt_item(p.in[I_W2] + (size_t)l * D * DFF, DFF, D, D, (f16*)(ws + W_2) + (size_t)l * D * DFF, scr, r % I_M2, lane); }
    }
}

__device__ __forceinline__ void init_rows(const Params& p, float* H, f16* A) {
    const int tid_ = otid(), lane = tid_ & 63, gw = obid() * (NTHREADS / 64) + (tid_ >> 6), ngw = gridDim.x * (NTHREADS / 64);
    const float* g = p.in[I_NORMG];
    for (int row = gw; row < MP; row += ngw) {
        float4 h[8]; float ss = 0.f;
#pragma unroll
        for (int j = 0; j < 8; ++j) {
            const int c = 4 * lane + 256 * j;
            if (row < MMAIN) h[j] = ld4(p.in[I_X] + (size_t)row * D + c);
            else if (row < MREAL) h[j] = ld4(p.in[I_META] + (size_t)(row - MMAIN) * D + c);
            else h[j] = make_float4(0.f, 0.f, 0.f, 0.f);
            ss += h[j].x * h[j].x + h[j].y * h[j].y + h[j].z * h[j].z + h[j].w * h[j].w;
        }
        const float r = rsqrtf(wave_sum(ss) * (1.f / D) + EPS);
#pragma unroll
        for (int j = 0; j < 8; ++j) {
            const int c = 4 * lane + 256 * j; const float4 gg = ld4(g + c);
            *(float4*)(H + (size_t)row * D + c) = h[j];
            st4h(A + (size_t)row * D + c, make_float4(h[j].x * r * gg.x, h[j].y * r * gg.y, h[j].z * r * gg.z, h[j].w * r * gg.w));
        }
    }
}
__device__ __forceinline__ void rowpass(const f16* MIX, const float* ga, const float* gb, float* H, f16* A, float* OUT, int nrows) {
    const int tid_ = otid(), lane = tid_ & 63, gw = obid() * (NTHREADS / 64) + (tid_ >> 6), ngw = gridDim.x * (NTHREADS / 64);
    for (int row = gw; row < nrows; row += ngw) {
        float4 m[8], h[8]; float ss = 0.f;
#pragma unroll
        for (int j = 0; j < 8; ++j) {
            const int c = 4 * lane + 256 * j;
            m[j] = ld4(MIX + (size_t)row * D + c); h[j] = ld4(H + (size_t)row * D + c);
            ss += m[j].x * m[j].x + m[j].y * m[j].y + m[j].z * m[j].z + m[j].w * m[j].w;
        }
        const float r = rsqrtf(wave_sum(ss) * (1.f / D) + EPS);
        float s2 = 0.f;
#pragma unroll
        for (int j = 0; j < 8; ++j) {
            const int c = 4 * lane + 256 * j; const float4 gg = ld4(ga + c);
            h[j].x += m[j].x * r * gg.x; h[j].y += m[j].y * r * gg.y; h[j].z += m[j].z * r * gg.z; h[j].w += m[j].w * r * gg.w;
            s2 += h[j].x * h[j].x + h[j].y * h[j].y + h[j].z * h[j].z + h[j].w * h[j].w;
        }
        if (OUT) {
#pragma unroll
            for (int j = 0; j < 8; ++j) *(float4*)(OUT + (size_t)row * D + 4 * lane + 256 * j) = h[j];
        } else {
            const float r2 = rsqrtf(wave_sum(s2) * (1.f / D) + EPS);
#pragma unroll
            for (int j = 0; j < 8; ++j) {
                const int c = 4 * lane + 256 * j; const float4 gg = ld4(gb + c);
                *(float4*)(H + (size_t)row * D + c) = h[j];
                st4h(A + (size_t)row * D + c, make_float4(h[j].x * r2 * gg.x, h[j].y * r2 * gg.y, h[j].z * r2 * gg.z, h[j].w * r2 * gg.w));
            }
        }
    }
}

__device__ __forceinline__ void pool_diff(const f16* U, f16* DY) {
    const int total = MREAL * 128, stride = (int)gridDim.x * NTHREADS;
    for (int i = obid() * NTHREADS + otid(); i < total; i += stride) {
        const int row = i >> 7, c = (i & 127) * 8;
        const int b = row < MMAIN ? row >> 11 : 0, t = row < MMAIN ? (row & 2047) + NMETA : row - MMAIN;
        const int win = 2 << (c >> 8);
        const int cnt = (t + 1) < win ? (t + 1) : win;
        const float4 ua = ld4(U + (size_t)row * D + c), ub = ld4(U + (size_t)row * D + c + 4);
        float4 sa = ua, sb = ub;
        for (int j = 1; j < cnt; ++j) {
            const f16* up = U + (size_t)row_of(b, t - j) * D + c; const float4 a = ld4(up), bb = ld4(up + 4);
            sa.x += a.x; sa.y += a.y; sa.z += a.z; sa.w += a.w; sb.x += bb.x; sb.y += bb.y; sb.z += bb.z; sb.w += bb.w;
        }
        const float ic = 1.f / (float)cnt;
        f32x4 o0 = {sa.x * ic - ua.x, sa.y * ic - ua.y, sa.z * ic - ua.z, sa.w * ic - ua.w}, o1 = {sb.x * ic - ub.x, sb.y * ic - ub.y, sb.z * ic - ub.z, sb.w * ic - ub.w};
        st8h(DY + (size_t)row * D + c, o0, o1);
    }
}

__device__ __forceinline__ void pool_diff_old(const f16* U, f16* DY) {
    const size_t total = (size_t)MREAL * 1024, stride = (size_t)gridDim.x * NTHREADS;
    for (size_t i = (size_t)obid() * NTHREADS + otid(); i < total; i += stride) {
        const int row = (int)(i >> 10), c = (int)(i & 1023);
        const int b = row < MMAIN ? row >> 11 : 0, t = row < MMAIN ? (row & 2047) + NMETA : row - MMAIN;
        const int win = 2 << (c >> 8);
        const int cnt = (t + 1) < win ? (t + 1) : win;
        float s = 0.f;
        for (int j = 0; j < cnt; ++j) s += (float)U[(size_t)row_of(b, t - j) * D + c];
        DY[(size_t)row * D + c] = (f16)(s / (float)cnt - (float)U[(size_t)row * D + c]);
    }
}

__device__ __forceinline__ float gelu_tanh(float x) {
    const float k0 = 0.7978845608028654f, k1 = 0.044715f;
    return 0.5f * x * (1.f + tanhf(k0 * (x + k1 * x * x * x)));
}

typedef _Float16 f16x8 __attribute__((ext_vector_type(8)));
constexpr int SSM_WAVE_LDS = 128 * 20 * 4 + 16 * 136 * 2;
constexpr int SSM_CARRY_OFF = 8 * SSM_WAVE_LDS;
__device__ __forceinline__ void ssm_phase(const Params& p, const f16* U, f16* DY, LAS unsigned char* lds) {
    const int tid_ = otid(), lane = tid_ & 63, wv = __builtin_amdgcn_readfirstlane(tid_ >> 6), l15 = lane & 15, g2 = lane >> 4;
    LAS float* BUT = (LAS float*)(lds + wv * SSM_WAVE_LDS);
    LAS f16* HT = (LAS f16*)(lds + wv * SSM_WAVE_LDS + 128 * 20 * 4);
    typedef float f32x2_t __attribute__((ext_vector_type(2)));
    LAS f32x2_t* CARRY = (LAS f32x2_t*)(lds + SSM_CARRY_OFF);
    for (int item = obid(); item < 256; item += gridDim.x) {
        const int b = item >> 6, g = item & 63, n = lane;
        const float dt = expf(p.in[I_LOGDT][g]);
        const float ar = p.in[I_LRE][g * 64 + n], ai = p.in[I_LIM][g * 64 + n];
        float are, aim, pw0r, pw0i, pw1r, pw1i;
        { const float mag = expf(dt * ar); double sd, cd; sincos_d((double)(dt * ai), sd, cd); are = mag * (float)cd; aim = mag * (float)sd; }
        { const float mag = expf(272.f * dt * ar); double sd, cd; sincos_d(272.0 * (double)(dt * ai), sd, cd); pw0r = mag * (float)cd; pw0i = mag * (float)sd; }
        { const float mag = expf(256.f * dt * ar); double sd, cd; sincos_d(256.0 * (double)(dt * ai), sd, cd); pw1r = mag * (float)cd; pw1i = mag * (float)sd; }
        {
            const float den = ar * ar + ai * ai, zr = are - 1.f, zi = aim;
            const float fre = (zr * ar + zi * ai) / (den * dt), fim = (zi * ar - zr * ai) / (den * dt);
            LAS f16* TB = (LAS f16*)BUT;
#pragma unroll
            for (int c = 0; c < 16; ++c) {
                const float br = p.in[I_BRE][(g * 64 + n) * 16 + c], bi = p.in[I_BIM][(g * 64 + n) * 16 + c];
                TB[n * 16 + c] = (f16)(fre * br - fim * bi); TB[(64 + n) * 16 + c] = (f16)(fre * bi + fim * br);
            }
        }
        asm volatile("" ::: "memory");
        f16x8 bbf[8];
#pragma unroll
        for (int nt = 0; nt < 8; ++nt) {
            const f16x8 z = {0, 0, 0, 0, 0, 0, 0, 0};
            bbf[nt] = (g2 < 2) ? *(const LAS f16x8*)((const LAS f16*)BUT + (16 * nt + l15) * 16 + 8 * g2) : z;
        }
        asm volatile("" ::: "memory");
        f16x8 cf[4];
#pragma unroll
        for (int ks = 0; ks < 4; ++ks) {
            const int k = 32 * ks + 8 * g2;
            const float* src = (k < 64) ? (p.in[I_CRE] + (g * 16 + l15) * 64 + k) : (p.in[I_CIM] + (g * 16 + l15) * 64 + (k - 64));
            const float sg = (k < 64) ? 1.f : -1.f;
            const float4 x0 = ld4(src), x1 = ld4(src + 4);
            f16x8 v; v[0] = (f16)(sg * x0.x); v[1] = (f16)(sg * x0.y); v[2] = (f16)(sg * x0.z); v[3] = (f16)(sg * x0.w); v[4] = (f16)(sg * x1.x); v[5] = (f16)(sg * x1.y); v[6] = (f16)(sg * x1.z); v[7] = (f16)(sg * x1.w);
            cf[ks] = v;
        }
        float dd[4];
#pragma unroll
        for (int j = 0; j < 4; ++j) dd[j] = p.in[I_S5D][g * 16 + 4 * g2 + j];
        const int blk0 = (wv == 0) ? 0 : 17 + 16 * (wv - 1), nblk = (wv == 0) ? 17 : 16;
        float hr = 0.f, hi = 0.f;
#pragma unroll 1
        for (int pass = 0; pass < 2; ++pass) {
            if (pass == 1) {
                CARRY[wv * 64 + n] = (f32x2_t){hr, hi};
                __syncthreads();
                float cr = 0.f, ci = 0.f;
                for (int j = 0; j < wv; ++j) {
                    const f32x2_t e = CARRY[j * 64 + n]; const float pr = (j == 0) ? pw0r : pw1r, pi = (j == 0) ? pw0i : pw1i;
                    const float nr = pr * cr - pi * ci + e.x, ni = pr * ci + pi * cr + e.y; cr = nr; ci = ni;
                }
                hr = cr; hi = ci;
                __syncthreads();
            }
#pragma unroll 1
            for (int kb = 0; kb < nblk; ++kb) {
                const int t0 = (blk0 + kb) * 16;
                const int rowa = row_of(b, t0 + l15);
                f16x8 ua = {0, 0, 0, 0, 0, 0, 0, 0};
                if (g2 < 2) ua = *(const f16x8*)(U + (size_t)rowa * D + 1024 + g * 16 + 8 * g2);
                f32x4 bacc[8];
#pragma unroll
                for (int nt = 0; nt < 8; ++nt) bacc[nt] = __builtin_amdgcn_mfma_f32_16x16x32_f16(ua, bbf[nt], (f32x4){0.f, 0.f, 0.f, 0.f}, 0, 0, 0);
                __builtin_amdgcn_sched_barrier(0);
                asm volatile("s_nop 15\n\ts_nop 15" ::: "memory");
                __builtin_amdgcn_sched_barrier(0);
#pragma unroll
                for (int nt = 0; nt < 8; ++nt) *(LAS f32x4*)(BUT + (16 * nt + l15) * 20 + 4 * g2) = bacc[nt];
                asm volatile("" ::: "memory");
                float bre[16], bim[16];
#pragma unroll
                for (int q4 = 0; q4 < 4; ++q4) {
                    const f32x4 x = *(const LAS f32x4*)(BUT + n * 20 + 4 * q4), y = *(const LAS f32x4*)(BUT + (64 + n) * 20 + 4 * q4);
                    bre[4 * q4] = x[0]; bre[4 * q4 + 1] = x[1]; bre[4 * q4 + 2] = x[2]; bre[4 * q4 + 3] = x[3];
                    bim[4 * q4] = y[0]; bim[4 * q4 + 1] = y[1]; bim[4 * q4 + 2] = y[2]; bim[4 * q4 + 3] = y[3];
                }
#pragma unroll
                for (int tt = 0; tt < 16; ++tt) {
                    const float nr = fmaf(are, hr, fmaf(-aim, hi, bre[tt])), ni = fmaf(are, hi, fmaf(aim, hr, bim[tt]));
                    hr = nr; hi = ni;
                    if (pass == 1) { HT[tt * 136 + n] = (f16)hr; HT[tt * 136 + 64 + n] = (f16)hi; }
                }
                asm volatile("" ::: "memory");
                if (pass == 1) {
                    f32x4 ya = {0.f, 0.f, 0.f, 0.f};
#pragma unroll
                    for (int ks = 0; ks < 4; ++ks) {
                        const f16x8 hb = *(const LAS f16x8*)(HT + l15 * 136 + 32 * ks + 8 * g2);
                        ya = __builtin_amdgcn_mfma_f32_16x16x32_f16(cf[ks], hb, ya, 0, 0, 0);
                    }
                    __builtin_amdgcn_sched_barrier(0);
                    asm volatile("s_nop 15\n\ts_nop 15" ::: "memory");
                    __builtin_amdgcn_sched_barrier(0);
                    if (t0 >= NMETA || b == 0) {
                        const float4 uu = ld4(U + (size_t)rowa * D + 1024 + g * 16 + 4 * g2);
                        const float4 o = make_float4(gelu_tanh(dt * ya[0] + dd[0] * uu.x), gelu_tanh(dt * ya[1] + dd[1] * uu.y), gelu_tanh(dt * ya[2] + dd[2] * uu.z), gelu_tanh(dt * ya[3] + dd[3] * uu.w));
                        st4h(DY + (size_t)rowa * D + 1024 + g * 16 + 4 * g2, o);
                    }
                }
            }
        }
        __syncthreads();
    }
}

__device__ __forceinline__ void ssm_naive(const Params& p, const f16* U, f16* DY) {
    const int tid_ = otid(), lane = tid_ & 63, gw = obid() * (NTHREADS / 64) + (tid_ >> 6), ngw = gridDim.x * (NTHREADS / 64);
    for (int item = gw; item < 256; item += ngw) {
        const int b = item >> 6, g = item & 63, n = lane;
        const float dt = expf(p.in[I_LOGDT][g]);
        const float ar = p.in[I_LRE][g * 64 + n], ai = p.in[I_LIM][g * 64 + n];
        const float mag = expf(dt * ar); double sd, cd; sincos_d((double)(dt * ai), sd, cd); const float sn = (float)sd, cs = (float)cd;
        const float are = mag * cs, aim = mag * sn;
        const float den = ar * ar + ai * ai, zr = are - 1.f, zi = aim;
        const float fre = (zr * ar + zi * ai) / den, fim = (zi * ar - zr * ai) / den;
        float bbr[16], bbi[16], cr[16], ci[16];
#pragma unroll
        for (int c = 0; c < 16; ++c) {
            const float br = p.in[I_BRE][(g * 64 + n) * 16 + c], bi = p.in[I_BIM][(g * 64 + n) * 16 + c];
            bbr[c] = fre * br - fim * bi; bbi[c] = fre * bi + fim * br;
            cr[c] = p.in[I_CRE][(g * 16 + c) * 64 + n]; ci[c] = p.in[I_CIM][(g * 16 + c) * 64 + n];
        }
        const float dd = p.in[I_S5D][g * 16 + (lane & 15)];
        float hr = 0.f, hi = 0.f;
#pragma unroll 1
        for (int t = 0; t < T; ++t) {
            const int row = row_of(b, t);
            const f16* ur = U + (size_t)row * D + 1024 + g * 16;
            const float4 u0 = ld4(ur), u1 = ld4(ur + 4), u2 = ld4(ur + 8), u3 = ld4(ur + 12);
            const float uu[16] = {u0.x, u0.y, u0.z, u0.w, u1.x, u1.y, u1.z, u1.w, u2.x, u2.y, u2.z, u2.w, u3.x, u3.y, u3.z, u3.w};
            float bur = 0.f, bui = 0.f;
#pragma unroll
            for (int c = 0; c < 16; ++c) { bur = fmaf(bbr[c], uu[c], bur); bui = fmaf(bbi[c], uu[c], bui); }
            const float nhr = are * hr - aim * hi + bur, nhi = are * hi + aim * hr + bui;
            hr = nhr; hi = nhi;
            float myy = 0.f;
#pragma unroll
            for (int c = 0; c < 16; ++c) { const float v = wave_sum(cr[c] * hr - ci[c] * hi); if (lane == c) myy = v; }
            if (lane < 16 && (t >= NMETA || b == 0)) {
                const float y = myy + dd * (float)ur[lane];
                DY[(size_t)row * D + 1024 + g * 16 + lane] = (f16)gelu_tanh(y);
            }
        }
    }
}

__device__ __forceinline__ void build_rope(float2* R16, float2* R8) {
    const int total = T * 16, stride = (int)gridDim.x * NTHREADS;
    for (int i = obid() * NTHREADS + otid(); i < total; i += stride) {
        const int t = i >> 4, idx = i & 15;
        const float ang = (float)t * rope_inv16(idx);
        double sd, cd; sincos_d((double)ang, sd, cd);
        const float2 v = make_float2((float)cd, (float)sd);
        R16[i] = v; if ((idx & 1) == 0) R8[t * 8 + (idx >> 1)] = v;
    }
}
__device__ __forceinline__ void zero_kv_pads(f16* K16, f16* V16, f16* KI16) {
    const int per_b = (TP - T) * (512 + 512 + 64) / 8, total = 4 * per_b, stride = (int)gridDim.x * NTHREADS;
    for (int i = obid() * NTHREADS + otid(); i < total; i += stride) {
        const int b = i / per_b, r = i % per_b; const u32x4 z = {0u, 0u, 0u, 0u};
        if (r < (TP - T) * 64) *(u32x4*)(K16 + ((size_t)b * TP + T) * 512 + (size_t)r * 8) = z;
        else if (r < (TP - T) * 128) *(u32x4*)(V16 + ((size_t)b * TP + T) * 512 + (size_t)(r - (TP - T) * 64) * 8) = z;
        else *(u32x4*)(KI16 + ((size_t)b * TP + T) * 64 + (size_t)(r - (TP - T) * 128) * 8) = z;
    }
}
struct CinOut { f16* Q16; f16* K16; f16* V16; f16* QI16; f16* KI16; float* WI; const float2* R16; const float2* R8; };
__device__ __forceinline__ void rope_lanes(f32x4& v0, f32x4& v1, const float2* tab, int xr, bool active, bool second) {
    const float4 t0 = *(const float4*)(tab), t1 = *(const float4*)(tab + 2), t2 = *(const float4*)(tab + 4), t3 = *(const float4*)(tab + 6);
    const float cs[8] = {t0.x, t0.z, t1.x, t1.z, t2.x, t2.z, t3.x, t3.z}, sn[8] = {t0.y, t0.w, t1.y, t1.w, t2.y, t2.w, t3.y, t3.w};
    const float sg = second ? 1.f : -1.f;
#pragma unroll
    for (int e = 0; e < 4; ++e) {
        const float o0 = __shfl_xor(v0[e], xr), o1 = __shfl_xor(v1[e], xr);
        if (active) { v0[e] = v0[e] * cs[e] + sg * o0 * sn[e]; v1[e] = v1[e] * cs[4 + e] + sg * o1 * sn[4 + e]; }
    }
}
__device__ __forceinline__ void cin_epilogue(const CinOut& o, int r, int c, f32x4 v0, f32x4 v1) {
    const int fq = (threadIdx.x & 63) >> 4, cb = c & ~31;
    const bool valid = r < MREAL, mainrow = r < MMAIN;
    const int t = mainrow ? (r & 2047) + NMETA : (valid ? r - MMAIN : 0), b = r >> 11;
    if (cb < 2560) {
        if ((cb & 127) == 0) rope_lanes(v0, v1, o.R16 + t * 16 + 8 * (fq & 1), 32, true, fq >= 2);
        if (cb < 2048) { if (mainrow) st8h(o.Q16 + (size_t)r * D + c, v0, v1); }
        else if (mainrow) st8h(o.K16 + ((size_t)b * TP + t) * 512 + (c - 2048), v0, v1);
        else if (valid) { for (int bb = 0; bb < 4; ++bb) st8h(o.K16 + ((size_t)bb * TP + t) * 512 + (c - 2048), v0, v1); }
    } else if (cb < 3072) {
        if (mainrow) st8h(o.V16 + ((size_t)b * TP + t) * 512 + (c - 2560), v0, v1);
        else if (valid) { for (int bb = 0; bb < 4; ++bb) st8h(o.V16 + ((size_t)bb * TP + t) * 512 + (c - 2560), v0, v1); }
    } else if (cb < 4096) {
        if ((cb & 63) == 0) rope_lanes(v0, v1, o.R8 + t * 8, 16, fq < 2, fq == 1);
        if (mainrow) st8h(o.QI16 + (size_t)r * 1024 + (c - 3072), v0, v1);
    } else if (cb < 4160) {
        if (cb == 4096) rope_lanes(v0, v1, o.R8 + t * 8, 16, fq < 2, fq == 1);
        if (mainrow) st8h(o.KI16 + ((size_t)b * TP + t) * 64 + (c - 4096), v0, v1);
        else if (valid) { for (int bb = 0; bb < 4; ++bb) st8h(o.KI16 + ((size_t)bb * TP + t) * 64 + (c - 4096), v0, v1); }
    } else if (c < CIN) {
        if (mainrow) { float* w = o.WI + (size_t)r * 16 + (c - 4160); *(f32x4*)w = v0 * 0.03125f; *(f32x4*)(w + 4) = v1 * 0.03125f; }
    }
}

__device__ __forceinline__ void idx_scores(const f16* QI16, const f16* KI16, const float* WI, float* SCORE) {
    const int tid_ = otid(), lane = tid_ & 63, gw = obid() * (NTHREADS / 64) + (tid_ >> 6), ngw = gridDim.x * (NTHREADS / 64);
    for (int q = gw; q < MMAIN; q += ngw) {
        const int b = q >> 11, s = q & 2047, nall = 80 + 64 * (s >> 6);
        const f16* qi = QI16 + (size_t)q * 1024;
        const float* wi = WI + (size_t)q * 16;
        for (int t = lane; t < nall; t += 64) {
            const f16* kp = KI16 + ((size_t)b * TP + t) * 64;
            float4 kv[16];
#pragma unroll
            for (int j = 0; j < 16; ++j) kv[j] = ld4(kp + 4 * j);
            float score = 0.f;
#pragma unroll 1
            for (int h = 0; h < 16; ++h) {
                float dot = 0.f;
#pragma unroll
                for (int j = 0; j < 16; ++j) { const float4 qv = ld4(qi + h * 64 + 4 * j); dot += qv.x * kv[j].x + qv.y * kv[j].y + qv.z * kv[j].z + qv.w * kv[j].w; }
                score += wi[h] * fmaxf(dot, 0.f);
            }
            SCORE[(size_t)q * SROW + t] = score;
        }
    }
}

__device__ __forceinline__ unsigned okey(float f) { const unsigned u = __float_as_uint(f); return (u & 0x80000000u) ? ~u : (u | 0x80000000u); }
__device__ __forceinline__ void select_topk(const float* SCORE, unsigned long long* MASK) {
    const int tid_ = otid(), lane = tid_ & 63, gw = obid() * (NTHREADS / 64) + (tid_ >> 6), ngw = gridDim.x * (NTHREADS / 64);
    for (int q = gw; q < MMAIN; q += ngw) {
        const int s = q & 2047, nall = 80 + 64 * (s >> 6);
        unsigned key[33];
#pragma unroll
        for (int i = 0; i < 33; ++i) { const int t = 64 * i + lane; key[i] = (t < nall) ? okey(SCORE[(size_t)q * SROW + t]) : 0u; }
        unsigned long long mymask = 0ull;
        if (nall <= 256) {
#pragma unroll
            for (int i = 0; i < 33; ++i) { const unsigned long long m = __ballot(64 * i + lane < nall); if (lane == i) mymask = m; }
        } else {
            unsigned tau = 0u;
#pragma unroll 1
            for (int bit = 31; bit >= 0; --bit) {
                const unsigned cand = tau | (1u << bit); int cnt = 0;
#pragma unroll
                for (int i = 0; i < 33; ++i) cnt += __popcll(__ballot(key[i] >= cand));
                if (cnt >= 256) tau = cand;
            }
            int ngt = 0;
#pragma unroll
            for (int i = 0; i < 33; ++i) ngt += __popcll(__ballot(key[i] > tau));
            const int need = 256 - ngt; int eqb = 0;
            const unsigned long long lt = (1ull << lane) - 1ull;
#pragma unroll
            for (int i = 0; i < 33; ++i) {
                const unsigned long long gm = __ballot(key[i] > tau), em = __ballot(key[i] == tau);
                const int rank = eqb + __popcll(em & lt);
                const unsigned long long sm = __ballot(key[i] == tau && rank < need);
                if (lane == i) mymask = gm | sm;
                eqb += __popcll(em);
            }
        }
        if (lane < 33) MASK[(size_t)q * 33 + lane] = mymask;
    }
}

__device__ __forceinline__ void attn_naive(float* lds, const f16* Q16, const f16* K16, const f16* V16, const unsigned long long* MASK, f16* O) {
    const int tid_ = otid(), lane = tid_ & 63, wv = tid_ >> 6, gw = obid() * (NTHREADS / 64) + wv, ngw = gridDim.x * (NTHREADS / 64);
    int* list = (int*)(lds + wv * 640);
    float* pl = lds + wv * 640 + 256;
    float* ql = lds + wv * 640 + 512;
    for (int item = gw; item < MMAIN * 16; item += ngw) {
        const int q = item >> 4, hq = item & 15, b = q >> 11, kvh = hq >> 2;
        int base = 0;
        for (int i = 0; i < 33; ++i) {
            const unsigned long long w = MASK[(size_t)q * 33 + i];
            if ((w >> lane) & 1ull) list[base + __popcll(w & ((1ull << lane) - 1ull))] = 64 * i + lane;
            base += __popcll(w);
        }
        const int nk = base;
        const f16* qp = Q16 + (size_t)q * D + hq * 128;
        ql[lane] = (float)qp[lane]; ql[64 + lane] = (float)qp[64 + lane];
        __builtin_amdgcn_s_waitcnt(0); __builtin_amdgcn_wave_barrier();
        float lg[4]; float mx = -INFINITY;
#pragma unroll
        for (int j = 0; j < 4; ++j) {
            const int kk = lane + 64 * j; lg[j] = -INFINITY;
            if (kk < nk) {
                const f16* kp = K16 + ((size_t)b * TP + list[kk]) * 512 + kvh * 128;
                float dot = 0.f;
#pragma unroll 4
                for (int d = 0; d < 128; d += 4) { const float4 kv = ld4(kp + d); dot += kv.x * ql[d] + kv.y * ql[d + 1] + kv.z * ql[d + 2] + kv.w * ql[d + 3]; }
                lg[j] = dot * 0.08838834764831845f;
            }
            mx = fmaxf(mx, lg[j]);
        }
        mx = wave_max(mx);
        float sm = 0.f;
#pragma unroll
        for (int j = 0; j < 4; ++j) { const int kk = lane + 64 * j; const float e = (kk < nk) ? expf(lg[j] - mx) : 0.f; sm += e; pl[kk] = e; }
        sm = wave_sum(sm);
        __builtin_amdgcn_s_waitcnt(0); __builtin_amdgcn_wave_barrier();
        float o0 = 0.f, o1 = 0.f;
#pragma unroll 2
        for (int kk = 0; kk < nk; ++kk) {
            const f16* vp = V16 + ((size_t)b * TP + list[kk]) * 512 + kvh * 128;
            const float pw = pl[kk];
            o0 = fmaf(pw, (float)vp[lane], o0); o1 = fmaf(pw, (float)vp[64 + lane], o1);
        }
        const float inv = 1.f / sm;
        O[(size_t)q * D + hq * 128 + lane] = (f16)(o0 * inv); O[(size_t)q * D + hq * 128 + 64 + lane] = (f16)(o1 * inv);
        __builtin_amdgcn_s_waitcnt(0); __builtin_amdgcn_wave_barrier();
    }
}

template <class F>
__device__ __forceinline__ void gemm(LAS unsigned char* lds, const f16* A, int lda, const f16* Bt, int ldb, int M, int N, int K, int cu, F f) {
    pg8::Gemm g{A, Bt, M, N, K, lda, ldb};
    pg8::StaticOrder S; S.init(M, N, (int)gridDim.x, cu);
    pg8::EpiRow8<F> E{f};
    pg8::gemm_phase<pg8::EpiRow8<F>, pg8::StaticOrder, true, true>(lds, g, S, E);
}

__global__ void __launch_bounds__(NTHREADS, 2) fwd(Params p) {
    cg::grid_group grid = cg::this_grid();
    extern __shared__ __attribute__((aligned(16))) unsigned char smem[];
    LAS unsigned char* lds = (LAS unsigned char*)smem;
    float* ldsf = (float*)smem;
    unsigned char* ws = p.ws;
    float* H = (float*)(ws + OFF_H); f16* A16 = (f16*)(ws + OFF_A16); f16* U16 = (f16*)(ws + OFF_U16);
    f16* DY16 = (f16*)(ws + OFF_DY16); f16* CAT16 = (f16*)(ws + OFF_CAT16);
    f16* HID16 = (f16*)(ws + OFF_BIG);
    CinOut co{(f16*)(ws + OFF_Q16), (f16*)(ws + OFF_K16), (f16*)(ws + OFF_V16), (f16*)(ws + OFF_QI16), (f16*)(ws + OFF_KI16), (float*)(ws + OFF_WI), (const float2*)(ws + OFF_ROPE16), (const float2*)(ws + OFF_ROPE8)};
    float* SCORE = (float*)(ws + OFF_SCORE); unsigned long long* MASK = (unsigned long long*)(ws + OFF_MASK); f16* O16 = (f16*)(ws + OFF_O16);
    const float* ng = p.in[I_NORMG];
    const int bid = (int)blockIdx.x, G = (int)gridDim.x;

    convert_weights(p, ldsf);
    init_rows(p, H, A16);
    build_rope((float2*)(ws + OFF_ROPE16), (float2*)(ws + OFF_ROPE8));
    grid.sync();
    gemm(lds, A16, D, (const f16*)(ws + W_IN), D, MP, D, D, bid, [=](int r, int c, f32x4 v0, f32x4 v1) { st8h(U16 + (size_t)r * D + c, v0, v1); });
    grid.sync();
    pool_diff(U16, DY16);
    ssm_phase(p, U16, DY16, lds);
    grid.sync();
    for (int g = 0; g < 4; ++g) {
        const float* ps = p.in[I_POOLS] + g * 256;
        gemm(lds, DY16 + g * 256, D, (const f16*)(ws + W_POOL) + (size_t)g * 65536, 256, MP, 256, 256, (bid + G - 33 * g) % G,
             [=](int r, int c, f32x4 v0, f32x4 v1) { const f32x4 s0 = *(const f32x4*)(ps + c), s1 = *(const f32x4*)(ps + c + 4); st8h(CAT16 + (size_t)r * D + g * 256 + c, v0 * s0, v1 * s1); });
    }
    gemm(lds, DY16 + 1024, D, (const f16*)(ws + W_GLU), 1024, MP, 1024, 1024, (bid + G - 132) % G,
         [=](int r, int c, f32x4 v0, f32x4 v1) {
             const f16* yp = DY16 + (size_t)r * D + 1024 + c; const float4 y0 = ld4(yp), y1 = ld4(yp + 4);
             f32x4 o0, o1;
             o0[0] = y0.x / (1.f + __expf(-v0[0])); o0[1] = y0.y / (1.f + __expf(-v0[1])); o0[2] = y0.z / (1.f + __expf(-v0[2])); o0[3] = y0.w / (1.f + __expf(-v0[3]));
             o1[0] = y1.x / (1.f + __expf(-v1[0])); o1[1] = y1.y / (1.f + __expf(-v1[1])); o1[2] = y1.z / (1.f + __expf(-v1[2])); o1[3] = y1.w / (1.f + __expf(-v1[3]));
             st8h(CAT16 + (size_t)r * D + 1024 + c, o0, o1); });
    grid.sync();
    gemm(lds, CAT16, D, (const f16*)(ws + W_OUT), D, MP, D, D, bid, [=](int r, int c, f32x4 v0, f32x4 v1) { st8h(U16 + (size_t)r * D + c, v0, v1); });
    grid.sync();
    rowpass(U16, ng + 1 * D, ng + 2 * D, H, A16, nullptr, MP);
    grid.sync();
    gemm(lds, A16, D, (const f16*)(ws + W_1), D, MP, DFF, D, bid, [=](int r, int c, f32x4 v0, f32x4 v1) {
        f32x4 z0 = __builtin_elementwise_max(v0, (f32x4){0.f, 0.f, 0.f, 0.f}), z1 = __builtin_elementwise_max(v1, (f32x4){0.f, 0.f, 0.f, 0.f}); st8h(HID16 + (size_t)r * DFF + c, z0 * z0, z1 * z1); });
    grid.sync();
    gemm(lds, HID16, DFF, (const f16*)(ws + W_2), DFF, MP, D, DFF, bid, [=](int r, int c, f32x4 v0, f32x4 v1) { st8h(U16 + (size_t)r * D + c, v0, v1); });
    grid.sync();
    rowpass(U16, ng + 3 * D, ng + 4 * D, H, A16, nullptr, MP);
    zero_kv_pads(co.K16, co.V16, co.KI16);
    grid.sync();
    gemm(lds, A16, D, (const f16*)(ws + W_CIN), D, MP, CINP, D, bid, [=](int r, int c, f32x4 v0, f32x4 v1) { cin_epilogue(co, r, c, v0, v1); });
    grid.sync();
    idx_scores(co.QI16, co.KI16, co.WI, SCORE);
    grid.sync();
    select_topk(SCORE, MASK);
    grid.sync();
    attn_naive(ldsf, co.Q16, co.K16, co.V16, MASK, O16);
    grid.sync();
    gemm(lds, O16, D, (const f16*)(ws + W_COUT), D, MMAIN, D, D, bid, [=](int r, int c, f32x4 v0, f32x4 v1) { st8h(U16 + (size_t)r * D + c, v0, v1); });
    grid.sync();
    rowpass(U16, ng + 5 * D, ng + 6 * D, H, A16, nullptr, MMAIN);
    grid.sync();
    gemm(lds, A16, D, (const f16*)(ws + W_1) + (size_t)D * DFF, D, MMAIN, DFF, D, bid, [=](int r, int c, f32x4 v0, f32x4 v1) {
        f32x4 z0 = __builtin_elementwise_max(v0, (f32x4){0.f, 0.f, 0.f, 0.f}), z1 = __builtin_elementwise_max(v1, (f32x4){0.f, 0.f, 0.f, 0.f}); st8h(HID16 + (size_t)r * DFF + c, z0 * z0, z1 * z1); });
    grid.sync();
    gemm(lds, HID16, DFF, (const f16*)(ws + W_2) + (size_t)D * DFF, DFF, MMAIN, D, DFF, bid, [=](int r, int c, f32x4 v0, f32x4 v1) { st8h(U16 + (size_t)r * D + c, v0, v1); });
    grid.sync();
    rowpass(U16, ng + 7 * D, nullptr, H, nullptr, p.out, MMAIN);
}

extern "C" void kernel_launch(void* const* d_in, const int* in_sizes, int n_in, void* d_out, int out_size, void* d_ws, size_t ws_size, hipStream_t stream) {
    static int grid_blocks = 0;
    if (!grid_blocks) {
        if (n_in != 20 || out_size != MMAIN * D || ws_size < WS_NEED) { fprintf(stderr, "kernel_launch: unexpected shapes n_in %d out %d ws %zu (need %zu)\n", n_in, out_size, ws_size, (size_t)WS_NEED); grid_blocks = -1; return; }
        int dev = 0, cus = 0, per_cu = 0;
        (void)hipGetDevice(&dev);
        (void)hipDeviceGetAttribute(&cus, hipDeviceAttributeMultiprocessorCount, dev);
        if (hipFuncSetAttribute((const void*)fwd, hipFuncAttributeMaxDynamicSharedMemorySize, LDS_BYTES) != hipSuccess) { fprintf(stderr, "kernel_launch: hipFuncSetAttribute failed\n"); grid_blocks = -1; return; }
        (void)hipOccupancyMaxActiveBlocksPerMultiprocessor(&per_cu, fwd, NTHREADS, LDS_BYTES);
        if (per_cu < 1) { fprintf(stderr, "kernel_launch: occupancy query says %d blocks per CU\n", per_cu); per_cu = 1; }
        grid_blocks = cus;
    }
    if (grid_blocks < 0) return;
    Params p{};
    for (int i = 0; i < 20; ++i) p.in[i] = (const float*)d_in[i];
    p.out = (float*)d_out; p.ws = (unsigned char*)d_ws;
    void* args[] = {&p};
    hipError_t e = hipLaunchCooperativeKernel((void*)fwd, dim3(grid_blocks), dim3(NTHREADS), args, LDS_BYTES, stream);
    if (e != hipSuccess) fprintf(stderr, "cooperative launch failed: %s (grid %d)\n", hipGetErrorString(e), grid_blocks);
}
```

```cpp
#include <hip/hip_runtime.h>
#include <hip/hip_fp16.h>
#include <hip/hip_cooperative_groups.h>
#include <cstdio>
#include <cstdint>
#include <cmath>
namespace cg = cooperative_groups;
__device__ __forceinline__ int otid() { int t = threadIdx.x; asm volatile("" : "+v"(t)); return t; }
__device__ __forceinline__ int obid() { int t = blockIdx.x; asm volatile("" : "+s"(t)); return t; }

namespace pg8 {
#define PG8_LAS __attribute__((address_space(3)))
typedef _Float16 f16_t;
typedef _Float16 f16x8 __attribute__((ext_vector_type(8)));
typedef float f32x4 __attribute__((ext_vector_type(4)));
typedef unsigned u32x4 __attribute__((ext_vector_type(4)));
constexpr int BM = 256, BK = 64, HALF = 128, HTB = HALF * BK * 2  , STAGE_BYTES = 8 * HTB, NXCD = 8, WGM = 8;

__host__ __device__ __forceinline__ int lds_byte(int r, int c) { const int st = (r >> 4) * 2 + (c >> 5), rr = r & 15, cc = c & 31, ob = rr * 64 + cc * 2; return st * 1024 + (ob ^ (((ob >> 9) & 1) << 5)); }
__host__ __device__ __forceinline__ void stage_rc(int b, int& R, int& C) { const int st = b / 1024, sb = b % 1024, swz = sb ^ (((sb >> 9) & 1) << 5); R = (st >> 1) * 16 + swz / 64; C = (st & 1) * 32 + (swz % 64) / 2; }
__host__ __device__ __forceinline__ int perm32(int rho) { const int n = rho >> 4, i = rho & 15; return 8 * (i >> 2) + 4 * n + (i & 3); }

struct Unit { int pm, pn; };
struct Gemm { const f16_t* A; const f16_t* Bt; int M, N, K, lda, ldb; };

struct StaticOrder {
    int nM, nN, nwg, G, c;
    __host__ __device__ void init(int M, int N, int G_, int c_) { nM = M / BM; nN = N / BM; nwg = nM * nN; G = G_; c = c_; }
    __host__ __device__ bool next(int i, Unit& u) const {
        const long L = (long)i * G + c; if (L >= nwg) return false;
        int wgid = (int)L; { const int q = nwg / NXCD, r = nwg % NXCD, xcd = wgid % NXCD, off = wgid / NXCD; wgid = (xcd < r ? xcd * (q + 1) : r * (q + 1) + (xcd - r) * q) + off; }
        const int nig = WGM * nN, gid = wgid / nig, fm = gid * WGM, gsz = (nM - fm) < WGM ? (nM - fm) : WGM;
        u.pm = fm + ((wgid % nig) % gsz); u.pn = (wgid % nig) / gsz; return true;
    }
    __device__ __forceinline__ void a_ready(const Unit&) const {}
    __device__ __forceinline__ void done(const Unit&) const {}
};


template <class Epi, class Sched, bool ALIGN_EPI = false, bool SP2 = false>
__device__ __forceinline__ void gemm_phase(PG8_LAS unsigned char* lds, const Gemm g, const Sched& S, const Epi& E) {
    const int tid = otid(), wid = __builtin_amdgcn_readfirstlane(tid >> 6), lane = tid & 63, wr = wid >> 2, wc = wid & 3, fr = lane & 15, fq = lane >> 4;
    const int K = g.K, nt = K / BK;
    unsigned voffA[2], voffB[2];
#pragma unroll
    for (int i = 0; i < 2; ++i) { int R, C; stage_rc(tid * 16 + i * 8192, R, C); const int Rb = Epi::PERM ? ((R & ~31) + perm32(R & 31)) : R;
        voffA[i] = (unsigned)(R * g.lda + C) * 2u; voffB[i] = (unsigned)(Rb * g.ldb + C) * 2u; }
    const size_t kstep = (size_t)(BK * 2);
    const size_t hstepA = (size_t)HALF * g.lda * 2, hstepB = (size_t)HALF * g.ldb * 2;
    const size_t tstepA = 2 * hstepA, tstepB = 2 * hstepB;
    const unsigned ldsw = (unsigned)wid * 1024u;
    const int aoff = lds_byte(wr * 64 + fr, fq * 8), boff = lds_byte(wc * 32 + fr, fq * 8);
#define PG8_SA(b, h) (((b) * 2 + (h)) * HTB)
#define PG8_SB(b, h) ((4 + (b) * 2 + (h)) * HTB)
#define PG8_STAGE(bufoff, gbase, voff) do { _Pragma("unroll") for (int _i = 0; _i < 2; ++_i) \
        __builtin_amdgcn_global_load_lds((const unsigned*)((const char*)(gbase) + (voff)[_i]), (PG8_LAS unsigned*)(lds + (bufoff) + ldsw + _i * 8192), 16, 0, 0); } while (0)
#define PG8_LDA(dst, b, h) do { _Pragma("unroll") for (int m = 0; m < 4; ++m) _Pragma("unroll") for (int k = 0; k < 2; ++k) dst[m][k] = *(const PG8_LAS f16x8*)(lds + PG8_SA(b, h) + aoff + m * 2048 + k * 1024); } while (0)
#define PG8_LDB(dst, b, h) do { _Pragma("unroll") for (int n = 0; n < 2; ++n) _Pragma("unroll") for (int k = 0; k < 2; ++k) dst[n][k] = *(const PG8_LAS f16x8*)(lds + PG8_SB(b, h) + boff + n * 2048 + k * 1024); } while (0)
#define PG8_MMA(ai, bj, At, Bt) do { __builtin_amdgcn_s_setprio(1); _Pragma("unroll") for (int m = 0; m < 4; ++m) _Pragma("unroll") for (int n = 0; n < 2; ++n) _Pragma("unroll") for (int k = 0; k < 2; ++k) \
        acc[ai][bj][m][n] = __builtin_amdgcn_mfma_f32_16x16x32_f16(Bt[n][k], At[m][k], acc[ai][bj][m][n], 0, 0, 0); __builtin_amdgcn_s_setprio(0); } while (0)
#define PG8_WAIT_V(n) asm volatile("s_waitcnt vmcnt(" #n ")" ::: "memory")
#define PG8_WAIT_L(n) asm volatile("s_waitcnt lgkmcnt(" #n ")" ::: "memory")
#define PG8_BAR __builtin_amdgcn_s_barrier()
#define PG8_SCHED __builtin_amdgcn_sched_barrier(0)
    Unit cur, nxt; int ui = 0;
    if (!S.next(0, cur)) return;
    f32x4 acc[2][2][4][2];
#pragma unroll
    for (int a = 0; a < 2; ++a)
#pragma unroll
        for (int b = 0; b < 2; ++b)
#pragma unroll
            for (int m = 0; m < 4; ++m)
#pragma unroll
                for (int n = 0; n < 2; ++n) acc[a][b][m][n] = (f32x4){0.f, 0.f, 0.f, 0.f};
    f16x8 At[4][2], B0[2][2], B1[2][2];
    const char* cA = (const char*)g.A + (size_t)cur.pm * tstepA; const char* cB = (const char*)g.Bt + (size_t)cur.pn * tstepB;
    S.a_ready(cur);
    if constexpr (SP2) {
        PG8_STAGE(PG8_SB(0, 0), cB, voffB); PG8_STAGE(PG8_SB(0, 1), cB + hstepB, voffB); PG8_STAGE(PG8_SA(0, 0), cA, voffA); PG8_STAGE(PG8_SA(0, 1), cA + hstepA, voffA);
        if (wr == 1) PG8_BAR;
        PG8_WAIT_V(2); PG8_BAR;
        PG8_STAGE(PG8_SB(1, 0), cB + kstep, voffB); PG8_STAGE(PG8_SA(1, 0), cA + kstep, voffA); PG8_STAGE(PG8_SB(1, 1), cB + hstepB + kstep, voffB);
        PG8_WAIT_V(6); PG8_BAR;
    } else {
        PG8_STAGE(PG8_SB(0, 0), cB, voffB); PG8_STAGE(PG8_SA(0, 0), cA, voffA); PG8_STAGE(PG8_SB(0, 1), cB + hstepB, voffB); PG8_STAGE(PG8_SA(0, 1), cA + hstepA, voffA);
        if (wr == 1) PG8_BAR;
        PG8_WAIT_V(4); PG8_BAR;
        PG8_STAGE(PG8_SB(1, 0), cB + kstep, voffB); PG8_STAGE(PG8_SA(1, 0), cA + kstep, voffA); PG8_STAGE(PG8_SB(1, 1), cB + hstepB + kstep, voffB);
        PG8_WAIT_V(6); PG8_BAR;
    }
    for (;;) {
        const bool has_next = S.next(ui + 1, nxt);
        const char* nA = has_next ? (const char*)g.A + (size_t)nxt.pm * tstepA : cA; const char* nB = has_next ? (const char*)g.Bt + (size_t)nxt.pn * tstepB : cB;
        for (int t = 0; t < nt; t += 2) {
            const bool last = (t == nt - 2);
            const char* a1 = cA + (size_t)(t + 1) * kstep;
            const char* a2 = last ? nA : cA + (size_t)(t + 2) * kstep; const char* b2 = last ? nB : cB + (size_t)(t + 2) * kstep;
            const char* a3 = a2 + kstep; const char* b3 = b2 + kstep;
            if (last && has_next) S.a_ready(nxt);
            if constexpr (SP2) {
            PG8_LDB(B0, 0, 0); PG8_LDB(B1, 0, 1); PG8_SCHED; PG8_LDA(At, 0, 0); PG8_STAGE(PG8_SA(1, 1), a1 + hstepA, voffA);
            PG8_WAIT_V(8); PG8_WAIT_L(0); PG8_BAR; PG8_MMA(0, 0, At, B0); PG8_MMA(0, 1, At, B1); PG8_BAR; PG8_SCHED;
            PG8_LDA(At, 0, 1); PG8_STAGE(PG8_SB(0, 0), b2, voffB); PG8_STAGE(PG8_SB(0, 1), b2 + hstepB, voffB); PG8_STAGE(PG8_SA(0, 0), a2, voffA);
            PG8_WAIT_V(8); PG8_WAIT_L(0); PG8_BAR; PG8_MMA(1, 0, At, B0); PG8_MMA(1, 1, At, B1); PG8_BAR; PG8_SCHED;
            PG8_LDB(B0, 1, 0); PG8_LDB(B1, 1, 1); PG8_SCHED; PG8_LDA(At, 1, 0); PG8_STAGE(PG8_SA(0, 1), a2 + hstepA, voffA);
            PG8_WAIT_V(8); PG8_WAIT_L(0); PG8_BAR; PG8_MMA(0, 0, At, B0); PG8_MMA(0, 1, At, B1); PG8_BAR; PG8_SCHED;
            PG8_LDA(At, 1, 1); PG8_STAGE(PG8_SB(1, 0), b3, voffB); PG8_STAGE(PG8_SB(1, 1), b3 + hstepB, voffB); PG8_STAGE(PG8_SA(1, 0), a3, voffA);
            PG8_WAIT_V(8); PG8_WAIT_L(0); PG8_BAR; PG8_MMA(1, 0, At, B0); PG8_MMA(1, 1, At, B1); PG8_BAR; PG8_SCHED;
            } else {
            PG8_LDB(B0, 0, 0); PG8_SCHED; PG8_LDA(At, 0, 0); PG8_STAGE(PG8_SA(1, 1), a1 + hstepA, voffA);
            PG8_WAIT_L(8); PG8_BAR; PG8_WAIT_L(0); PG8_MMA(0, 0, At, B0); PG8_BAR; PG8_SCHED;
            PG8_LDB(B1, 0, 1); PG8_STAGE(PG8_SB(0, 0), b2, voffB);
            PG8_BAR; PG8_WAIT_L(0); PG8_MMA(0, 1, At, B1); PG8_BAR;
            PG8_LDA(At, 0, 1); PG8_STAGE(PG8_SA(0, 0), a2, voffA);
            PG8_BAR; PG8_WAIT_L(0); PG8_MMA(1, 0, At, B0); PG8_BAR; PG8_SCHED;
            PG8_STAGE(PG8_SB(0, 1), b2 + hstepB, voffB);
            PG8_WAIT_V(6); PG8_BAR; PG8_MMA(1, 1, At, B1); PG8_BAR;
            PG8_LDB(B0, 1, 0); PG8_SCHED; PG8_LDA(At, 1, 0); PG8_STAGE(PG8_SA(0, 1), a2 + hstepA, voffA);
            PG8_WAIT_L(8); PG8_BAR; PG8_WAIT_L(0); PG8_MMA(0, 0, At, B0); PG8_BAR; PG8_SCHED;
            PG8_LDB(B1, 1, 1); PG8_STAGE(PG8_SB(1, 0), b3, voffB);
            PG8_BAR; PG8_WAIT_L(0); PG8_MMA(0, 1, At, B1); PG8_BAR;
            PG8_LDA(At, 1, 1); PG8_STAGE(PG8_SA(1, 0), a3, voffA);
            PG8_BAR; PG8_WAIT_L(0); PG8_MMA(1, 0, At, B0); PG8_BAR; PG8_SCHED;
            PG8_STAGE(PG8_SB(1, 1), b3 + hstepB, voffB);
            PG8_WAIT_V(6); PG8_BAR; PG8_MMA(1, 1, At, B1); PG8_BAR;
            }
        }
        if constexpr (ALIGN_EPI) { if (wr == 0) PG8_BAR; }
        if constexpr (!Epi::AFTER_DRAIN) { E(acc, cur, wr, wc, fr, fq); S.done(cur); }
        if (!has_next) break;
#pragma unroll
        for (int a = 0; a < 2; ++a)
#pragma unroll
            for (int b = 0; b < 2; ++b)
#pragma unroll
                for (int m = 0; m < 4; ++m)
#pragma unroll
                    for (int n = 0; n < 2; ++n) acc[a][b][m][n] = (f32x4){0.f, 0.f, 0.f, 0.f};
        cur = nxt; cA = nA; cB = nB; ++ui;
        if constexpr (ALIGN_EPI) { if (wr == 1) PG8_BAR; }
    }
    PG8_WAIT_V(0);
    if constexpr (!ALIGN_EPI) { if (wr == 0) PG8_BAR; }
    PG8_BAR;
    if constexpr (Epi::AFTER_DRAIN) { E.fused(acc, cur, wr, wc, fr, fq, lds, wid, lane); S.done(cur); }
#undef PG8_SA
#undef PG8_SB
#undef PG8_STAGE
#undef PG8_LDA
#undef PG8_LDB
#undef PG8_MMA
#undef PG8_WAIT_V
#undef PG8_WAIT_L
#undef PG8_BAR
#undef PG8_SCHED
}

template <class F> struct EpiRow8 {
    static constexpr bool PERM = true, AFTER_DRAIN = false;
    F f;
    __device__ __forceinline__ void operator()(const f32x4 (&acc)[2][2][4][2], const Unit& u, int wr, int wc, int fr, int fq) const {
        const int row0 = u.pm * BM + wr * 64 + fr, col0 = u.pn * BM + wc * 32 + 8 * fq;
#pragma unroll
        for (int ai = 0; ai < 2; ++ai)
#pragma unroll
            for (int m = 0; m < 4; ++m)
#pragma unroll
                for (int bj = 0; bj < 2; ++bj) f(row0 + ai * HALF + m * 16, col0 + bj * HALF, acc[ai][bj][m][0], acc[ai][bj][m][1]);
    }
};
}

#define LAS __attribute__((address_space(3)))
typedef _Float16 f16;
typedef float f32x4 __attribute__((ext_vector_type(4)));
typedef unsigned u32x4 __attribute__((ext_vector_type(4)));
typedef _Float16 h2v __attribute__((ext_vector_type(2)));

constexpr int D = 2048, NMETA = 16, SEQ = 2048, T = 2064, DFF = 8192;
constexpr int MMAIN = 8192;
constexpr int MREAL = 8208;
constexpr int MP = 8448;
constexpr int CIN = 4176, CINP = 4352;
constexpr int QOFF = 0, KOFF = 2048, VOFF = 2560, QIOFF = 3072, KIOFF = 4096, WIOFF = 4160;
constexpr int SROW = 2112;
constexpr float EPS = 1e-6f;
constexpr int NTHREADS = 512;
constexpr int LDS_BYTES = 147456;

struct Params { const float* in[20]; float* out; unsigned char* ws; };
enum { I_X = 0, I_META, I_NORMG, I_ABWIN, I_POOLW, I_POOLS, I_LRE, I_LIM, I_LOGDT, I_BRE, I_BIM, I_CRE, I_CIM, I_S5D, I_WGLU, I_ABWOUT, I_CWIN, I_CWOUT, I_W1, I_W2 };

constexpr int TP = 2112;
constexpr size_t SZ4 = (size_t)MP * D * 4, SZ2 = (size_t)MP * D * 2;
constexpr size_t OFF_H = 0, OFF_A16 = OFF_H + SZ4, OFF_U16 = OFF_A16 + SZ2, OFF_DY16 = OFF_U16 + SZ2, OFF_CAT16 = OFF_DY16 + SZ2, OFF_BIG = OFF_CAT16 + SZ2;
constexpr size_t SZ_BIG = (size_t)MP * DFF * 2;
constexpr size_t OFF_Q16 = OFF_BIG, OFF_K16 = OFF_Q16 + (size_t)MMAIN * D * 2, OFF_V16 = OFF_K16 + (size_t)4 * TP * 512 * 2, OFF_QI16 = OFF_V16 + (size_t)4 * TP * 512 * 2,
                 OFF_KI16 = OFF_QI16 + (size_t)MMAIN * 1024 * 2, OFF_WI = OFF_KI16 + (size_t)4 * TP * 64 * 2, OFF_ATT_END = OFF_WI + (size_t)MMAIN * 16 * 4;
static_assert(OFF_ATT_END <= OFF_BIG + SZ_BIG, "attention buffers fit the BIG region");
constexpr size_t OFF_MASK = OFF_BIG + SZ_BIG, SZ_MASK = (size_t)MMAIN * 33 * 8;
constexpr size_t OFF_ROPE16 = OFF_MASK + SZ_MASK, OFF_ROPE8 = OFF_ROPE16 + (size_t)T * 16 * 8;
constexpr size_t OFF_W = OFF_ROPE8 + (size_t)T * 8 * 8;
constexpr size_t OFF_SCORE = OFF_DY16, OFF_O16 = OFF_A16;
constexpr size_t W_IN = OFF_W, W_POOL = W_IN + (size_t)D * D * 2, W_GLU = W_POOL + (size_t)4 * 256 * 256 * 2, W_OUT = W_GLU + (size_t)1024 * 1024 * 2,
                 W_CIN = W_OUT + (size_t)D * D * 2, W_COUT = W_CIN + (size_t)CINP * D * 2, W_1 = W_COUT + (size_t)D * D * 2, W_2 = W_1 + (size_t)2 * D * DFF * 2,
                 WS_NEED = W_2 + (size_t)2 * D * DFF * 2;
static_assert((size_t)MMAIN * SROW * 4 <= 2 * SZ2, "SCORE fits DY16+CAT16");
static_assert(OFF_W % 256 == 0, "alignment");

__device__ __forceinline__ int row_of(int b, int t) { return t < NMETA ? MMAIN + t : b * SEQ + (t - NMETA); }
__device__ __forceinline__ float wave_sum(float v) {
#pragma unroll
    for (int o = 1; o < 64; o <<= 1) v += __shfl_xor(v, o);
    return v;
}
__device__ __forceinline__ float wave_max(float v) {
#pragma unroll
    for (int o = 1; o < 64; o <<= 1) v = fmaxf(v, __shfl_xor(v, o));
    return v;
}
__device__ __forceinline__ float4 ld4(const float* p) { return *(const float4*)p; }
__device__ __forceinline__ unsigned pk2h(float a, float b) { h2v r; r.x = (_Float16)a; r.y = (_Float16)b; return __builtin_bit_cast(unsigned, r); }
__device__ __forceinline__ float2 up2h(unsigned u) { const h2v r = __builtin_bit_cast(h2v, u); return make_float2((float)r.x, (float)r.y); }
__device__ __forceinline__ float4 ld4(const f16* p) { const uint2 r = *(const uint2*)p; const float2 a = up2h(r.x), b = up2h(r.y); return make_float4(a.x, a.y, b.x, b.y); }
__device__ __forceinline__ void st4h(f16* p, float4 v) { uint2 r; r.x = pk2h(v.x, v.y); r.y = pk2h(v.z, v.w); *(uint2*)p = r; }
__device__ __forceinline__ void st8h(f16* p, f32x4 a, f32x4 b) { u32x4 w; w.x = pk2h(a[0], a[1]); w.y = pk2h(a[2], a[3]); w.z = pk2h(b[0], b[1]); w.w = pk2h(b[2], b[3]); *(u32x4*)p = w; }

__device__ __forceinline__ void sincos_d(double x, double& sn, double& cs) {
    const double q = rint(x * 0.6366197723675814);
    double r = fma(-q, 1.5707963267948966, x); r = fma(-q, 6.123233995736766e-17, r);
    const double r2 = r * r;
    double sp = -1.0 / 6227020800.0; sp = fma(sp, r2, 1.0 / 39916800.0); sp = fma(sp, r2, -1.0 / 362880.0); sp = fma(sp, r2, 1.0 / 5040.0); sp = fma(sp, r2, -1.0 / 120.0); sp = fma(sp, r2, 1.0 / 6.0); sp = fma(sp, r2, -1.0); sp = -sp * r;
    double cp = 1.0 / 87178291200.0; cp = fma(cp, r2, -1.0 / 479001600.0); cp = fma(cp, r2, 1.0 / 3628800.0); cp = fma(cp, r2, -1.0 / 40320.0); cp = fma(cp, r2, 1.0 / 720.0); cp = fma(cp, r2, -1.0 / 24.0); cp = fma(cp, r2, 0.5); cp = fma(-cp, r2, 1.0);
    const int n = ((int)q) & 3;
    sn = (n == 0) ? sp : (n == 1) ? cp : (n == 2) ? -sp : -cp;
    cs = (n == 0) ? cp : (n == 1) ? -sp : (n == 2) ? -cp : sp;
}
__device__ __forceinline__ float rope_inv16(int idx) {
    const double r = 1.0 / sqrt(sqrt(sqrt(sqrt(500000.0))));
    double v = 1.0;
    for (int i = 0; i < idx; ++i) v *= r;
    return (float)v;
}

__device__ __forceinline__ void cvt_item(const float* W, int K, int N, int NPAD, f16* WT, float* scr, int item, int lane) {
    const int nblk = NPAD / 32, kb = item / nblk, nb = item % nblk, k0 = 64 * kb, n0 = 32 * nb;
    const int n = n0 + (lane & 31);
#pragma unroll 8
    for (int i = 0; i < 32; ++i) { const int kk = 2 * i + (lane >> 5); scr[kk * 33 + (lane & 31)] = (n < N) ? W[(size_t)(k0 + kk) * N + n] : 0.f; }
    const int c = lane & 7;
#pragma unroll
    for (int j = 0; j < 4; ++j) { const int nn = (lane >> 3) + 8 * j; const float* s = scr + (8 * c) * 33 + nn;
        u32x4 o; o.x = pk2h(s[0 * 33], s[1 * 33]); o.y = pk2h(s[2 * 33], s[3 * 33]); o.z = pk2h(s[4 * 33], s[5 * 33]); o.w = pk2h(s[6 * 33], s[7 * 33]);
        *(u32x4*)(WT + (size_t)(n0 + nn) * K + k0 + 8 * c) = o; }
}
__device__ __forceinline__ void convert_weights(const Params& p, float* ldsf) {
    const int tid_ = otid(), lane = tid_ & 63, wv = tid_ >> 6, gw = obid() * (NTHREADS / 64) + wv, ngw = gridDim.x * (NTHREADS / 64);
    float* scr = ldsf + wv * (64 * 33);
    unsigned char* ws = p.ws;
    constexpr int I_IN = 32 * 64, I_PG = 4 * 8, I_GLU = 16 * 32, I_OUT = 32 * 64, I_CI = 32 * (CINP / 32), I_CO = 32 * 64, I_M1 = 32 * 256, I_M2 = 128 * 64;
    constexpr int NITEMS = I_IN + 4 * I_PG + I_GLU + I_OUT + I_CI + I_CO + 2 * I_M1 + 2 * I_M2;
    for (int it = gw; it < NITEMS; it += ngw) {
        int r = it;
        if (r < I_IN) { cvt_item(p.in[I_ABWIN], D, D, D, (f16*)(ws + W_IN), scr, r, lane); continue; } r -= I_IN;
        if (r < 4 * I_PG) { const int g = r / I_PG; cvt_item(p.in[I_POOLW] + (size_t)g * 65536, 256, 256, 256, (f16*)(ws + W_POOL) + (size_t)g * 65536, scr, r % I_PG, lane); continue; } r -= 4 * I_PG;
        if (r < I_GLU) { cvt_item(p.in[I_WGLU], 1024, 1024, 1024, (f16*)(ws + W_GLU), scr, r, lane); continue; } r -= I_GLU;
        if (r < I_OUT) { cvt_item(p.in[I_ABWOUT], D, D, D, (f16*)(ws + W_OUT), scr, r, lane); continue; } r -= I_OUT;
        if (r < I_CI) { cvt_item(p.in[I_CWIN], D, CIN, CINP, (f16*)(ws + W_CIN), scr, r, lane); continue; } r -= I_CI;
        if (r < I_CO) { cvt_item(p.in[I_CWOUT], D, D, D, (f16*)(ws + W_COUT), scr, r, lane); continue; } r -= I_CO;
        if (r < 2 * I_M1) { const int l = r / I_M1; cvt_item(p.in[I_W1] + (size_t)l * D * DFF, D, DFF, DFF, (f16*)(ws + W_1) + (size_t)l * D * DFF, scr, r % I_M1, lane); continue; } r -= 2 * I_M1;
        { const int l = r / I_M2; cvt_item(p.in[I_W2] + (size_t)l * D * DFF, DFF, D, D, (f16*)(ws + W_2) + (size_t)l * D * DFF, scr, r % I_M2, lane); }
    }
}

__device__ __forceinline__ void init_rows(const Params& p, float* H, f16* A) {
    const int tid_ = otid(), lane = tid_ & 63, gw = obid() * (NTHREADS / 64) + (tid_ >> 6), ngw = gridDim.x * (NTHREADS / 64);
    const float* g = p.in[I_NORMG];
    for (int row = gw; row < MP; row += ngw) {
        float4 h[8]; float ss = 0.f;
#pragma unroll
        for (int j = 0; j < 8; ++j) {
            const int c = 4 * lane + 256 * j;
            if (row < MMAIN) h[j] = ld4(p.in[I_X] + (size_t)row * D + c);
            else if (row < MREAL) h[j] = ld4(p.in[I_META] + (size_t)(row - MMAIN) * D + c);
            else h[j] = make_float4(0.f, 0.f, 0.f, 0.f);
            ss += h[j].x * h[j].x + h[j].y * h[j].y + h[j].z * h[j].z + h[j].w * h[j].w;
        }
        const float r = rsqrtf(wave_sum(ss) * (1.f / D) + EPS);
#pragma unroll
        for (int j = 0; j < 8; ++j) {
            const int c = 4 * lane + 256 * j; const float4 gg = ld4(g + c);
            *(float4*)(H + (size_t)row * D + c) = h[j];
            st4h(A + (size_t)row * D + c, make_float4(h[j].x * r * gg.x, h[j].y * r * gg.y, h[j].z * r * gg.z, h[j].w * r * gg.w));
        }
    }
}
__device__ __forceinline__ void rowpass(const f16* MIX, const float* ga, const float* gb, float* H, f16* A, float* OUT, int nrows) {
    const int tid_ = otid(), lane = tid_ & 63, gw = obid() * (NTHREADS / 64) + (tid_ >> 6), ngw = gridDim.x * (NTHREADS / 64);
    for (int row = gw; row < nrows; row += ngw) {
        float4 m[8], h[8]; float ss = 0.f;
#pragma unroll
        for (int j = 0; j < 8; ++j) {
            const int c = 4 * lane + 256 * j;
            m[j] = ld4(MIX + (size_t)row * D + c); h[j] = ld4(H + (size_t)row * D + c);
            ss += m[j].x * m[j].x + m[j].y * m[j].y + m[j].z * m[j].z + m[j].w * m[j].w;
        }
        const float r = rsqrtf(wave_sum(ss) * (1.f / D) + EPS);
        float s2 = 0.f;
#pragma unroll
        for (int j = 0; j < 8; ++j) {
            const int c = 4 * lane + 256 * j; const float4 gg = ld4(ga + c);
            h[j].x += m[j].x * r * gg.x; h[j].y += m[j].y * r * gg.y; h[j].z += m[j].z * r * gg.z; h[j].w += m[j].w * r * gg.w;
            s2 += h[j].x * h[j].x + h[j].y * h[j].y + h[j].z * h[j].z + h[j].w * h[j].w;
        }
        if (OUT) {
#pragma unroll
            for (int j = 0; j < 8; ++j) *(float4*)(OUT + (size_t)row * D + 4 * lane + 256 * j) = h[j];
        } else {
            const float r2 = rsqrtf(wave_sum(s2) * (1.f / D) + EPS);
#pragma unroll
            for (int j = 0; j < 8; ++j) {
                const int c = 4 * lane + 256 * j; const float4 gg = ld4(gb + c);
                *(float4*)(H + (size_t)row * D + c) = h[j];
                st4h(A + (size_t)row * D + c, make_float4(h[j].x * r2 * gg.x, h[j].y * r2 * gg.y, h[j].z * r2 * gg.z, h[j].w * r2 * gg.w));
            }
        }
    }
}

__device__ __forceinline__ void pool_diff(const f16* U, f16* DY) {
    const int total = MREAL * 128, stride = (int)gridDim.x * NTHREADS;
    for (int i = obid() * NTHREADS + otid(); i < total; i += stride) {
        const int row = i >> 7, c = (i & 127) * 8;
        const int b = row < MMAIN ? row >> 11 : 0, t = row < MMAIN ? (row & 2047) + NMETA : row - MMAIN;
        const int win = 2 << (c >> 8);
        const int cnt = (t + 1) < win ? (t + 1) : win;
        const float4 ua = ld4(U + (size_t)row * D + c), ub = ld4(U + (size_t)row * D + c + 4);
        float4 sa = ua, sb = ub;
        for (int j = 1; j < cnt; ++j) {
            const f16* up = U + (size_t)row_of(b, t - j) * D + c; const float4 a = ld4(up), bb = ld4(up + 4);
            sa.x += a.x; sa.y += a.y; sa.z += a.z; sa.w += a.w; sb.x += bb.x; sb.y += bb.y; sb.z += bb.z; sb.w += bb.w;
        }
        const float ic = 1.f / (float)cnt;
        f32x4 o0 = {sa.x * ic - ua.x, sa.y * ic - ua.y, sa.z * ic - ua.z, sa.w * ic - ua.w}, o1 = {sb.x * ic - ub.x, sb.y * ic - ub.y, sb.z * ic - ub.z, sb.w * ic - ub.w};
        st8h(DY + (size_t)row * D + c, o0, o1);
    }
}

__device__ __forceinline__ void pool_diff_old(const f16* U, f16* DY) {
    const size_t total = (size_t)MREAL * 1024, stride = (size_t)gridDim.x * NTHREADS;
    for (size_t i = (size_t)obid() * NTHREADS + otid(); i < total; i += stride) {
        const int row = (int)(i >> 10), c = (int)(i & 1023);
        const int b = row < MMAIN ? row >> 11 : 0, t = row < MMAIN ? (row & 2047) + NMETA : row - MMAIN;
        const int win = 2 << (c >> 8);
        const int cnt = (t + 1) < win ? (t + 1) : win;
        float s = 0.f;
        for (int j = 0; j < cnt; ++j) s += (float)U[(size_t)row_of(b, t - j) * D + c];
        DY[(size_t)row * D + c] = (f16)(s / (float)cnt - (float)U[(size_t)row * D + c]);
    }
}

__device__ __forceinline__ float gelu_tanh(float x) {
    const float k0 = 0.7978845608028654f, k1 = 0.044715f;
    return 0.5f * x * (1.f + tanhf(k0 * (x + k1 * x * x * x)));
}

typedef _Float16 f16x8 __attribute__((ext_vector_type(8)));
constexpr int SSM_WAVE_LDS = 128 * 20 * 4 + 16 * 136 * 2;
constexpr int SSM_CARRY_OFF = 8 * SSM_WAVE_LDS;
__device__ __forceinline__ void ssm_phase(const Params& p, const f16* U, f16* DY, LAS unsigned char* lds) {
    const int tid_ = otid(), lane = tid_ & 63, wv = __builtin_amdgcn_readfirstlane(tid_ >> 6), l15 = lane & 15, g2 = lane >> 4;
    LAS float* BUT = (LAS float*)(lds + wv * SSM_WAVE_LDS);
    LAS f16* HT = (LAS f16*)(lds + wv * SSM_WAVE_LDS + 128 * 20 * 4);
    typedef float f32x2_t __attribute__((ext_vector_type(2)));
    LAS f32x2_t* CARRY = (LAS f32x2_t*)(lds + SSM_CARRY_OFF);
    for (int item = obid(); item < 256; item += gridDim.x) {
        const int b = item >> 6, g = item & 63, n = lane;
        const float dt = expf(p.in[I_LOGDT][g]);
        const float ar = p.in[I_LRE][g * 64 + n], ai = p.in[I_LIM][g * 64 + n];
        float are, aim, pw0r, pw0i, pw1r, pw1i;
        { const float mag = expf(dt * ar); double sd, cd; sincos_d((double)(dt * ai), sd, cd); are = mag * (float)cd; aim = mag * (float)sd; }
        { const float mag = expf(272.f * dt * ar); double sd, cd; sincos_d(272.0 * (double)(dt * ai), sd, cd); pw0r = mag * (float)cd; pw0i = mag * (float)sd; }
        { const float mag = expf(256.f * dt * ar); double sd, cd; sincos_d(256.0 * (double)(dt * ai), sd, cd); pw1r = mag * (float)cd; pw1i = mag * (float)sd; }
        {
            const float den = ar * ar + ai * ai, zr = are - 1.f, zi = aim;
            const float fre = (zr * ar + zi * ai) / (den * dt), fim = (zi * ar - zr * ai) / (den * dt);
            LAS f16* TB = (LAS f16*)BUT;
#pragma unroll
            for (int c = 0; c < 16; ++c) {
                const float br = p.in[I_BRE][(g * 64 + n) * 16 + c], bi = p.in[I_BIM][(g * 64 + n) * 16 + c];
                TB[n * 16 + c] = (f16)(fre * br - fim * bi); TB[(64 + n) * 16 + c] = (f16)(fre * bi + fim * br);
            }
        }
        asm volatile("" ::: "memory");
        f16x8 bbf[8];
#pragma unroll
        for (int nt = 0; nt < 8; ++nt) {
            const f16x8 z = {0, 0, 0, 0, 0, 0, 0, 0};
            bbf[nt] = (g2 < 2) ? *(const LAS f16x8*)((const LAS f16*)BUT + (16 * nt + l15) * 16 + 8 * g2) : z;
        }
        asm volatile("" ::: "memory");
        f16x8 cf[4];
#pragma unroll
        for (int ks = 0; ks < 4; ++ks) {
            const int k = 32 * ks + 8 * g2;
            const float* src = (k < 64) ? (p.in[I_CRE] + (g * 16 + l15) * 64 + k) : (p.in[I_CIM] + (g * 16 + l15) * 64 + (k - 64));
            const float sg = (k < 64) ? 1.f : -1.f;
            const float4 x0 = ld4(src), x1 = ld4(src + 4);
            f16x8 v; v[0] = (f16)(sg * x0.x); v[1] = (f16)(sg * x0.y); v[2] = (f16)(sg * x0.z); v[3] = (f16)(sg * x0.w); v[4] = (f16)(sg * x1.x); v[5] = (f16)(sg * x1.y); v[6] = (f16)(sg * x1.z); v[7] = (f16)(sg * x1.w);
            cf[ks] = v;
        }
        float dd[4];
#pragma unroll
        for (int j = 0; j < 4; ++j) dd[j] = p.in[I_S5D][g * 16 + 4 * g2 + j];
        const int blk0 = (wv == 0) ? 0 : 17 + 16 * (wv - 1), nblk = (wv == 0) ? 17 : 16;
        float hr = 0.f, hi = 0.f;
#pragma unroll 1
        for (int pass = 0; pass < 2; ++pass) {
            if (pass == 1) {
                CARRY[wv * 64 + n] = (f32x2_t){hr, hi};
                __syncthreads();
                float cr = 0.f, ci = 0.f;
                for (int j = 0; j < wv; ++j) {
                    const f32x2_t e = CARRY[j * 64 + n]; const float pr = (j == 0) ? pw0r : pw1r, pi = (j == 0) ? pw0i : pw1i;
                    const float nr = pr * cr - pi * ci + e.x, ni = pr * ci + pi * cr + e.y; cr = nr; ci = ni;
                }
                hr = cr; hi = ci;
                __syncthreads();
            }
#pragma unroll 1
            for (int kb = 0; kb < nblk; ++kb) {
                const int t0 = (blk0 + kb) * 16;
                const int rowa = row_of(b, t0 + l15);
                f16x8 ua = {0, 0, 0, 0, 0, 0, 0, 0};
                if (g2 < 2) ua = *(const f16x8*)(U + (size_t)rowa * D + 1024 + g * 16 + 8 * g2);
                f32x4 bacc[8];
#pragma unroll
                for (int nt = 0; nt < 8; ++nt) bacc[nt] = __builtin_amdgcn_mfma_f32_16x16x32_f16(ua, bbf[nt], (f32x4){0.f, 0.f, 0.f, 0.f}, 0, 0, 0);
                __builtin_amdgcn_sched_barrier(0);
                asm volatile("s_nop 15\n\ts_nop 15" ::: "memory");
                __builtin_amdgcn_sched_barrier(0);
#pragma unroll
                for (int nt = 0; nt < 8; ++nt) *(LAS f32x4*)(BUT + (16 * nt + l15) * 20 + 4 * g2) = bacc[nt];
                asm volatile("" ::: "memory");
                float bre[16], bim[16];
#pragma unroll
                for (int q4 = 0; q4 < 4; ++q4) {
                    const f32x4 x = *(const LAS f32x4*)(BUT + n * 20 + 4 * q4), y = *(const LAS f32x4*)(BUT + (64 + n) * 20 + 4 * q4);
                    bre[4 * q4] = x[0]; bre[4 * q4 + 1] = x[1]; bre[4 * q4 + 2] = x[2]; bre[4 * q4 + 3] = x[3];
                    bim[4 * q4] = y[0]; bim[4 * q4 + 1] = y[1]; bim[4 * q4 + 2] = y[2]; bim[4 * q4 + 3] = y[3];
                }
#pragma unroll
                for (int tt = 0; tt < 16; ++tt) {
                    const float nr = fmaf(are, hr, fmaf(-aim, hi, bre[tt])), ni = fmaf(are, hi, fmaf(aim, hr, bim[tt]));
                    hr = nr; hi = ni;
                    if (pass == 1) { HT[tt * 136 + n] = (f16)hr; HT[tt * 136 + 64 + n] = (f16)hi; }
                }
                asm volatile("" ::: "memory");
                if (pass == 1) {
                    f32x4 ya = {0.f, 0.f, 0.f, 0.f};
#pragma unroll
                    for (int ks = 0; ks < 4; ++ks) {
                        const f16x8 hb = *(const LAS f16x8*)(HT + l15 * 136 + 32 * ks + 8 * g2);
                        ya = __builtin_amdgcn_mfma_f32_16x16x32_f16(cf[ks], hb, ya, 0, 0, 0);
                    }
                    __builtin_amdgcn_sched_barrier(0);
                    asm volatile("s_nop 15\n\ts_nop 15" ::: "memory");
                    __builtin_amdgcn_sched_barrier(0);
                    if (t0 >= NMETA || b == 0) {
                        const float4 uu = ld4(U + (size_t)rowa * D + 1024 + g * 16 + 4 * g2);
                        const float4 o = make_float4(gelu_tanh(dt * ya[0] + dd[0] * uu.x), gelu_tanh(dt * ya[1] + dd[1] * uu.y), gelu_tanh(dt * ya[2] + dd[2] * uu.z), gelu_tanh(dt * ya[3] + dd[3] * uu.w));
                        st4h(DY + (size_t)rowa * D + 1024 + g * 16 + 4 * g2, o);
                    }
                }
            }
        }
        __syncthreads();
    }
}

__device__ __forceinline__ void ssm_naive(const Params& p, const f16* U, f16* DY) {
    const int tid_ = otid(), lane = tid_ & 63, gw = obid() * (NTHREADS / 64) + (tid_ >> 6), ngw = gridDim.x * (NTHREADS / 64);
    for (int item = gw; item < 256; item += ngw) {
        const int b = item >> 6, g = item & 63, n = lane;
        const float dt = expf(p.in[I_LOGDT][g]);
        const float ar = p.in[I_LRE][g * 64 + n], ai = p.in[I_LIM][g * 64 + n];
        const float mag = expf(dt * ar); double sd, cd; sincos_d((double)(dt * ai), sd, cd); const float sn = (float)sd, cs = (float)cd;
        const float are = mag * cs, aim = mag * sn;
        const float den = ar * ar + ai * ai, zr = are - 1.f, zi = aim;
        const float fre = (zr * ar + zi * ai) / den, fim = (zi * ar - zr * ai) / den;
        float bbr[16], bbi[16], cr[16], ci[16];
#pragma unroll
        for (int c = 0; c < 16; ++c) {
            const float br = p.in[I_BRE][(g * 64 + n) * 16 + c], bi = p.in[I_BIM][(g * 64 + n) * 16 + c];
            bbr[c] = fre * br - fim * bi; bbi[c] = fre * bi + fim * br;
            cr[c] = p.in[I_CRE][(g * 16 + c) * 64 + n]; ci[c] = p.in[I_CIM][(g * 16 + c) * 64 + n];
        }
        const float dd = p.in[I_S5D][g * 16 + (lane & 15)];
        float hr = 0.f, hi = 0.f;
#pragma unroll 1
        for (int t = 0; t < T; ++t) {
            const int row = row_of(b, t);
            const f16* ur = U + (size_t)row * D + 1024 + g * 16;
            const float4 u0 = ld4(ur), u1 = ld4(ur + 4), u2 = ld4(ur + 8), u3 = ld4(ur + 12);
            const float uu[16] = {u0.x, u0.y, u0.z, u0.w, u1.x, u1.y, u1.z, u1.w, u2.x, u2.y, u2.z, u2.w, u3.x, u3.y, u3.z, u3.w};
            float bur = 0.f, bui = 0.f;
#pragma unroll
            for (int c = 0; c < 16; ++c) { bur = fmaf(bbr[c], uu[c], bur); bui = fmaf(bbi[c], uu[c], bui); }
            const float nhr = are * hr - aim * hi + bur, nhi = are * hi + aim * hr + bui;
            hr = nhr; hi = nhi;
            float myy = 0.f;
#pragma unroll
            for (int c = 0; c < 16; ++c) { const float v = wave_sum(cr[c] * hr - ci[c] * hi); if (lane == c) myy = v; }
            if (lane < 16 && (t >= NMETA || b == 0)) {
                const float y = myy + dd * (float)ur[lane];
                DY[(size_t)row * D + 1024 + g * 16 + lane] = (f16)gelu_tanh(y);
            }
        }
    }
}

__device__ __forceinline__ void build_rope(float2* R16, float2* R8) {
    const int total = T * 16, stride = (int)gridDim.x * NTHREADS;
    for (int i = obid() * NTHREADS + otid(); i < total; i += stride) {
        const int t = i >> 4, idx = i & 15;
        const float ang = (float)t * rope_inv16(idx);
        double sd, cd; sincos_d((double)ang, sd, cd);
        const float2 v = make_float2((float)cd, (float)sd);
        R16[i] = v; if ((idx & 1) == 0) R8[t * 8 + (idx >> 1)] = v;
    }
}
__device__ __forceinline__ void zero_kv_pads(f16* K16, f16* V16, f16* KI16) {
    const int per_b = (TP - T) * (512 + 512 + 64) / 8, total = 4 * per_b, stride = (int)gridDim.x * NTHREADS;
    for (int i = obid() * NTHREADS + otid(); i < total; i += stride) {
        const int b = i / per_b, r = i % per_b; const u32x4 z = {0u, 0u, 0u, 0u};
        if (r < (TP - T) * 64) *(u32x4*)(K16 + ((size_t)b * TP + T) * 512 + (size_t)r * 8) = z;
        else if (r < (TP - T) * 128) *(u32x4*)(V16 + ((size_t)b * TP + T) * 512 + (size_t)(r - (TP - T) * 64) * 8) = z;
        else *(u32x4*)(KI16 + ((size_t)b * TP + T) * 64 + (size_t)(r - (TP - T) * 128) * 8) = z;
    }
}
struct CinOut { f16* Q16; f16* K16; f16* V16; f16* QI16; f16* KI16; float* WI; const float2* R16; const float2* R8; };
__device__ __forceinline__ void rope_lanes(f32x4& v0, f32x4& v1, const float2* tab, int xr, bool active, bool second) {
    const float4 t0 = *(const float4*)(tab), t1 = *(const float4*)(tab + 2), t2 = *(const float4*)(tab + 4), t3 = *(const float4*)(tab + 6);
    const float cs[8] = {t0.x, t0.z, t1.x, t1.z, t2.x, t2.z, t3.x, t3.z}, sn[8] = {t0.y, t0.w, t1.y, t1.w, t2.y, t2.w, t3.y, t3.w};
    const float sg = second ? 1.f : -1.f;
#pragma unroll
    for (int e = 0; e < 4; ++e) {
        const float o0 = __shfl_xor(v0[e], xr), o1 = __shfl_xor(v1[e], xr);
        if (active) { v0[e] = v0[e] * cs[e] + sg * o0 * sn[e]; v1[e] = v1[e] * cs[4 + e] + sg * o1 * sn[4 + e]; }
    }
}
__device__ __forceinline__ void cin_epilogue(const CinOut& o, int r, int c, f32x4 v0, f32x4 v1) {
    const int fq = (threadIdx.x & 63) >> 4, cb = c & ~31;
    const bool valid = r < MREAL, mainrow = r < MMAIN;
    const int t = mainrow ? (r & 2047) + NMETA : (valid ? r - MMAIN : 0), b = r >> 11;
    if (cb < 2560) {
        if ((cb & 127) == 0) rope_lanes(v0, v1, o.R16 + t * 16 + 8 * (fq & 1), 32, true, fq >= 2);
        if (cb < 2048) { if (mainrow) st8h(o.Q16 + (size_t)r * D + c, v0, v1); }
        else if (mainrow) st8h(o.K16 + ((size_t)b * TP + t) * 512 + (c - 2048), v0, v1);
        else if (valid) { for (int bb = 0; bb < 4; ++bb) st8h(o.K16 + ((size_t)bb * TP + t) * 512 + (c - 2048), v0, v1); }
    } else if (cb < 3072) {
        if (mainrow) st8h(o.V16 + ((size_t)b * TP + t) * 512 + (c - 2560), v0, v1);
        else if (valid) { for (int bb = 0; bb < 4; ++bb) st8h(o.V16 + ((size_t)bb * TP + t) * 512 + (c - 2560), v0, v1); }
    } else if (cb < 4096) {
        if ((cb & 63) == 0) rope_lanes(v0, v1, o.R8 + t * 8, 16, fq < 2, fq == 1);
        if (mainrow) st8h(o.QI16 + (size_t)r * 1024 + (c - 3072), v0, v1);
    } else if (cb < 4160) {
        if (cb == 4096) rope_lanes(v0, v1, o.R8 + t * 8, 16, fq < 2, fq == 1);
        if (mainrow) st8h(o.KI16 + ((size_t)b * TP + t) * 64 + (c - 4096), v0, v1);
        else if (valid) { for (int bb = 0; bb < 4; ++bb) st8h(o.KI16 + ((size_t)bb * TP + t) * 64 + (c - 4096), v0, v1); }
    } else if (c < CIN) {
        if (mainrow) { float* w = o.WI + (size_t)r * 16 + (c - 4160); *(f32x4*)w = v0 * 0.03125f; *(f32x4*)(w + 4) = v1 * 0.03125f; }
    }
}

__device__ __forceinline__ void idx_scores(const f16* QI16, const f16* KI16, const float* WI, float* SCORE) {
    const int tid_ = otid(), lane = tid_ & 63, gw = obid() * (NTHREADS / 64) + (tid_ >> 6), ngw = gridDim.x * (NTHREADS / 64);
    for (int q = gw; q < MMAIN; q += ngw) {
        const int b = q >> 11, s = q & 2047, nall = 80 + 64 * (s >> 6);
        const f16* qi = QI16 + (size_t)q * 1024;
        const float* wi = WI + (size_t)q * 16;
        for (int t = lane; t < nall; t += 64) {
            const f16* kp = KI16 + ((size_t)b * TP + t) * 64;
            float4 kv[16];
#pragma unroll
            for (int j = 0; j < 16; ++j) kv[j] = ld4(kp + 4 * j);
            float score = 0.f;
#pragma unroll 1
            for (int h = 0; h < 16; ++h) {
                float dot = 0.f;
#pragma unroll
                for (int j = 0; j < 16; ++j) { const float4 qv = ld4(qi + h * 64 + 4 * j); dot += qv.x * kv[j].x + qv.y * kv[j].y + qv.z * kv[j].z + qv.w * kv[j].w; }
                score += wi[h] * fmaxf(dot, 0.f);
            }
            SCORE[(size_t)q * SROW + t] = score;
        }
    }
}

__device__ __forceinline__ unsigned okey(float f) { const unsigned u = __float_as_uint(f); return (u & 0x80000000u) ? ~u : (u | 0x80000000u); }
__device__ __forceinline__ void select_topk(const float* SCORE, unsigned long long* MASK) {
    const int tid_ = otid(), lane = tid_ & 63, gw = obid() * (NTHREADS / 64) + (tid_ >> 6), ngw = gridDim.x * (NTHREADS / 64);
    for (int q = gw; q < MMAIN; q += ngw) {
        const int s = q & 2047, nall = 80 + 64 * (s >> 6);
        unsigned key[33];
#pragma unroll
        for (int i = 0; i < 33; ++i) { const int t = 64 * i + lane; key[i] = (t < nall) ? okey(SCORE[(size_t)q * SROW + t]) : 0u; }
        unsigned long long mymask = 0ull;
        if (nall <= 256) {
#pragma unroll
            for (int i = 0; i < 33; ++i) { const unsigned long long m = __ballot(64 * i + lane < nall); if (lane == i) mymask = m; }
        } else {
            unsigned tau = 0u;
#pragma unroll 1
            for (int bit = 31; bit >= 0; --bit) {
                const unsigned cand = tau | (1u << bit); int cnt = 0;
#pragma unroll
                for (int i = 0; i < 33; ++i) cnt += __popcll(__ballot(key[i] >= cand));
                if (cnt >= 256) tau = cand;
            }
            int ngt = 0;
#pragma unroll
            for (int i = 0; i < 33; ++i) ngt += __popcll(__ballot(key[i] > tau));
            const int need = 256 - ngt; int eqb = 0;
            const unsigned long long lt = (1ull << lane) - 1ull;
#pragma unroll
            for (int i = 0; i < 33; ++i) {
                const unsigned long long gm = __ballot(key[i] > tau), em = __ballot(key[i] == tau);
                const int rank = eqb + __popcll(em & lt);
                const unsigned long long sm = __ballot(key[i] == tau && rank < need);
                if (lane == i) mymask = gm | sm;
                eqb += __popcll(em);
            }
        }
        if (lane < 33) MASK[(size_t)q * 33 + lane] = mymask;
    }
}

constexpr int IDX_WAVE_LDS = 2 * TP * 4;
__device__ __forceinline__ unsigned long long select_row(const LAS float* srow, int nall, int lane) {
    unsigned key[33];
#pragma unroll
    for (int i = 0; i < 33; ++i) { const int t = 64 * i + lane; key[i] = (t < nall) ? okey(srow[t]) : 0u; }
    unsigned long long mymask = 0ull;
    unsigned tau = 0u;
#pragma unroll 1
    for (int bit = 31; bit >= 0; --bit) {
        const unsigned cand = tau | (1u << bit); int cnt = 0;
#pragma unroll
        for (int i = 0; i < 33; ++i) cnt += __popcll(__ballot(key[i] >= cand));
        if (cnt >= 256) tau = cand;
    }
    int ngt = 0;
#pragma unroll
    for (int i = 0; i < 33; ++i) ngt += __popcll(__ballot(key[i] > tau));
    const int need = 256 - ngt; int eqb = 0;
    const unsigned long long lt = (1ull << lane) - 1ull;
#pragma unroll
    for (int i = 0; i < 33; ++i) {
        const unsigned long long gm = __ballot(key[i] > tau), em = __ballot(key[i] == tau);
        const int rank = eqb + __popcll(em & lt);
        const unsigned long long sm = __ballot(key[i] == tau && rank < need);
        if (lane == i) mymask = gm | sm;
        eqb += __popcll(em);
    }
    return mymask;
}
__device__ __forceinline__ void index_select(const f16* QI16, const f16* KI16, const float* WI, unsigned long long* MASK, LAS unsigned char* lds) {
    const int tid_ = otid(), lane = tid_ & 63, wv = __builtin_amdgcn_readfirstlane(tid_ >> 6), l15 = lane & 15, g2 = lane >> 4;
    const int gw = obid() * (NTHREADS / 64) + wv;
    LAS float* SL = (LAS float*)(lds + wv * IDX_WAVE_LDS);
    if (gw >= 2048) return;
    const int b = gw >> 9, wq = gw & 511;
#pragma unroll 1
    for (int it = 0; it < 2; ++it) {
        const int u = (it == 0) ? wq : 1023 - wq, s0 = 2 * u, q0 = b * SEQ + s0, nall = 80 + 64 * (s0 >> 6);
        if (nall <= 256) {
            if (lane < 33) { const int lo = 64 * lane; const unsigned long long m = (nall >= lo + 64) ? ~0ull : (nall > lo ? ((1ull << (nall - lo)) - 1ull) : 0ull);
                MASK[(size_t)q0 * 33 + lane] = m; MASK[(size_t)(q0 + 1) * 33 + lane] = m; }
            continue;
        }
        f16x8 a[2][2]; float w[2][4];
#pragma unroll
        for (int qq = 0; qq < 2; ++qq) {
#pragma unroll
            for (int ks = 0; ks < 2; ++ks) a[qq][ks] = *(const f16x8*)(QI16 + (size_t)(q0 + qq) * 1024 + l15 * 64 + 32 * ks + 8 * g2);
            const float4 ww = ld4(WI + (size_t)(q0 + qq) * 16 + 4 * g2); w[qq][0] = ww.x; w[qq][1] = ww.y; w[qq][2] = ww.z; w[qq][3] = ww.w;
        }
        const int nkb = nall >> 4;
        const f16* kbase = KI16 + (size_t)b * TP * 64 + l15 * 64 + 8 * g2;
#pragma unroll 1
        for (int kb = 0; kb < nkb; kb += 2) {
            f16x8 bf[2][2];
#pragma unroll
            for (int e = 0; e < 2; ++e)
#pragma unroll
                for (int ks = 0; ks < 2; ++ks) bf[e][ks] = *(const f16x8*)(kbase + (size_t)(kb + e) * 16 * 64 + 32 * ks);
            f32x4 acc[2][2];
#pragma unroll
            for (int e = 0; e < 2; ++e)
#pragma unroll
                for (int qq = 0; qq < 2; ++qq) {
                    acc[e][qq] = __builtin_amdgcn_mfma_f32_16x16x32_f16(a[qq][0], bf[e][0], (f32x4){0.f, 0.f, 0.f, 0.f}, 0, 0, 0);
                    acc[e][qq] = __builtin_amdgcn_mfma_f32_16x16x32_f16(a[qq][1], bf[e][1], acc[e][qq], 0, 0, 0);
                }
            __builtin_amdgcn_sched_barrier(0);
            asm volatile("s_nop 15\n\ts_nop 15" ::: "memory");
            __builtin_amdgcn_sched_barrier(0);
#pragma unroll
            for (int e = 0; e < 2; ++e)
#pragma unroll
                for (int qq = 0; qq < 2; ++qq) {
                    const f32x4 c = acc[e][qq];
                    float sc = w[qq][0] * fmaxf(c[0], 0.f) + w[qq][1] * fmaxf(c[1], 0.f) + w[qq][2] * fmaxf(c[2], 0.f) + w[qq][3] * fmaxf(c[3], 0.f);
                    sc += __shfl_xor(sc, 16); sc += __shfl_xor(sc, 32);
                    if (g2 == 0) SL[qq * TP + (kb + e) * 16 + l15] = sc;
                }
        }
        asm volatile("" ::: "memory");
#pragma unroll 1
        for (int qq = 0; qq < 2; ++qq) {
            const unsigned long long m = select_row(SL + qq * TP, nall, lane);
            if (lane < 33) MASK[(size_t)(q0 + qq) * 33 + lane] = m;
        }
        asm volatile("" ::: "memory");
    }
}

__device__ __forceinline__ void attn_naive(float* lds, const f16* Q16, const f16* K16, const f16* V16, const unsigned long long* MASK, f16* O) {
    const int tid_ = otid(), lane = tid_ & 63, wv = tid_ >> 6, gw = obid() * (NTHREADS / 64) + wv, ngw = gridDim.x * (NTHREADS / 64);
    int* list = (int*)(lds + wv * 640);
    float* pl = lds + wv * 640 + 256;
    float* ql = lds + wv * 640 + 512;
    for (int item = gw; item < MMAIN * 16; item += ngw) {
        const int q = item >> 4, hq = item & 15, b = q >> 11, kvh = hq >> 2;
        int base = 0;
        for (int i = 0; i < 33; ++i) {
            const unsigned long long w = MASK[(size_t)q * 33 + i];
            if ((w >> lane) & 1ull) list[base + __popcll(w & ((1ull << lane) - 1ull))] = 64 * i + lane;
            base += __popcll(w);
        }
        const int nk = base;
        const f16* qp = Q16 + (size_t)q * D + hq * 128;
        ql[lane] = (float)qp[lane]; ql[64 + lane] = (float)qp[64 + lane];
        __builtin_amdgcn_s_waitcnt(0); __builtin_amdgcn_wave_barrier();
        float lg[4]; float mx = -INFINITY;
#pragma unroll
        for (int j = 0; j < 4; ++j) {
            const int kk = lane + 64 * j; lg[j] = -INFINITY;
            if (kk < nk) {
                const f16* kp = K16 + ((size_t)b * TP + list[kk]) * 512 + kvh * 128;
                float dot = 0.f;
#pragma unroll 4
                for (int d = 0; d < 128; d += 4) { const float4 kv = ld4(kp + d); dot += kv.x * ql[d] + kv.y * ql[d + 1] + kv.z * ql[d + 2] + kv.w * ql[d + 3]; }
                lg[j] = dot * 0.08838834764831845f;
            }
            mx = fmaxf(mx, lg[j]);
        }
        mx = wave_max(mx);
        float sm = 0.f;
#pragma unroll
        for (int j = 0; j < 4; ++j) { const int kk = lane + 64 * j; const float e = (kk < nk) ? expf(lg[j] - mx) : 0.f; sm += e; pl[kk] = e; }
        sm = wave_sum(sm);
        __builtin_amdgcn_s_waitcnt(0); __builtin_amdgcn_wave_barrier();
        float o0 = 0.f, o1 = 0.f;
#pragma unroll 2
        for (int kk = 0; kk < nk; ++kk) {
            const f16* vp = V16 + ((size_t)b * TP + list[kk]) * 512 + kvh * 128;
            const float pw = pl[kk];
            o0 = fmaf(pw, (float)vp[lane], o0); o1 = fmaf(pw, (float)vp[64 + lane], o1);
        }
        const float inv = 1.f / sm;
        O[(size_t)q * D + hq * 128 + lane] = (f16)(o0 * inv); O[(size_t)q * D + hq * 128 + 64 + lane] = (f16)(o1 * inv);
        __builtin_amdgcn_s_waitcnt(0); __builtin_amdgcn_wave_barrier();
    }
}

namespace att {
typedef short s16x4 __attribute__((ext_vector_type(4)));
typedef short s16x8 __attribute__((ext_vector_type(8)));
typedef float f32x16 __attribute__((ext_vector_type(16)));
typedef unsigned long long u64;
constexpr int NW = 8, QBLK = 32, KVBLK = 64, QS = 2048, KS = 512;
constexpr int SHM_V = KVBLK * 128 * 2, SHM_K = KVBLK * 128 * 2;
constexpr int LDS_BYTES = 2 * SHM_V + 2 * SHM_K + NW * 64 * 4;
constexpr float SCALE = 0.08838834764831845f, THR = 8.f;
#define AT_KSWZ(row, colB) ((row) * 256 + ((colB) ^ (((row) & 7) << 4)))
#define AT_SBAR() __builtin_amdgcn_sched_barrier(0)
__device__ __forceinline__ int v_st(int k, int c) { const int kk = (k & ~0xC) | ((k & 4) << 1) | ((k & 8) >> 1); return ((kk >> 3) * 4 + (c >> 5)) * 512 + ((kk & 7) * 32 + (c & 31)) * 2; }
__device__ __forceinline__ int v_rd_base(int lane) { return ((lane & 3) << 3) | (((lane >> 2) & 3) << 6) | (((lane >> 4) & 1) << 5) | (((lane >> 5) & 1) << 8); }
constexpr int v_rd_off(int d0, int ks, int half) { return d0 * 512 + ks * 4096 + half * 2048; }
__device__ __forceinline__ int crow(int r, int hi) { return (r & 3) + 8 * (r >> 2) + 4 * hi; }
__device__ __forceinline__ f16x8 load8(const f16* p) { return *(const f16x8*)p; }
__device__ __forceinline__ void mask_bits(f32x16& p0, f32x16& p1, u64 w, int hi) {
    const float NEG = -__builtin_inff();
    const unsigned lo = (unsigned)w >> (4 * hi), up = (unsigned)(w >> 32) >> (4 * hi);
#pragma unroll
    for (int r = 0; r < 16; ++r) {
        const int c = (r & 3) + 8 * (r >> 2);
        if (!((lo >> c) & 1u)) p0[r] = NEG;
        if (!((up >> c) & 1u)) p1[r] = NEG;
    }
}
__device__ __forceinline__ void partialSM(f32x16& p0, f32x16& p1, float& m_reg, float& mn, float& alpha) {
    float pmax = p0[0];
#pragma unroll
    for (int r = 1; r < 16; ++r) pmax = fmaxf(pmax, p0[r]);
#pragma unroll
    for (int r = 0; r < 16; ++r) pmax = fmaxf(pmax, p1[r]);
    { auto rr = __builtin_amdgcn_permlane32_swap(__float_as_uint(pmax), __float_as_uint(pmax), false, false);
      pmax = fmaxf(__uint_as_float(rr[0]), __uint_as_float(rr[1])); }
    constexpr float C2 = 1.4426950408889634f * SCALE;
    if (__builtin_expect(__all((pmax - m_reg) * SCALE <= THR), 1)) { mn = m_reg; alpha = 1.f; }
    else { mn = fmaxf(m_reg, pmax); alpha = __builtin_amdgcn_exp2f((m_reg - mn) * C2); m_reg = mn; }
    const float mnL = -mn * C2;
#pragma unroll
    for (int r = 0; r < 16; ++r) p0[r] = fmaf(p0[r], C2, mnL);
#pragma unroll
    for (int r = 0; r < 16; ++r) p1[r] = fmaf(p1[r], C2, mnL);
#pragma unroll
    for (int r = 0; r < 16; ++r) p0[r] = __builtin_amdgcn_exp2f(p0[r]);
}
__device__ __forceinline__ void finishSM(f32x16& p0, f32x16& p1, float alpha, float& l_reg, f16x8& pa0, f16x8& pa1, f16x8& pa2, f16x8& pa3) {
#pragma unroll
    for (int r = 0; r < 16; ++r) p1[r] = __builtin_amdgcn_exp2f(p1[r]);
    float ps = 0;
#pragma unroll
    for (int r = 0; r < 16; ++r) ps += p0[r];
#pragma unroll
    for (int r = 0; r < 16; ++r) ps += p1[r];
    { auto rr = __builtin_amdgcn_permlane32_swap(__float_as_uint(ps), __float_as_uint(ps), false, false);
      ps = __uint_as_float(rr[0]) + __uint_as_float(rr[1]); }
    l_reg = l_reg * alpha + ps;
#define AT_PK4(P, B_, OUT) do { unsigned a0 = pk2h(P[B_+0], P[B_+1]), a1 = pk2h(P[B_+2], P[B_+3]);                          \
        unsigned b0 = pk2h(P[B_+4], P[B_+5]), b1 = pk2h(P[B_+6], P[B_+7]);                                             \
        auto r0 = __builtin_amdgcn_permlane32_swap(a0, b0, false, false); auto r1 = __builtin_amdgcn_permlane32_swap(a1, b1, false, false); \
        u32x4 w_ = {r0[0], r1[0], r0[1], r1[1]}; OUT = __builtin_bit_cast(f16x8, w_); } while (0)
    AT_PK4(p0, 0, pa0); AT_PK4(p0, 8, pa1); AT_PK4(p1, 0, pa2); AT_PK4(p1, 8, pa3);
#undef AT_PK4
}
template <int KB>
__device__ __forceinline__ void qkt(f32x16& p0, f32x16& p1, LAS const unsigned char* K_lds, int r32, int hi, const f16x8* qr) {
    p0 = f32x16{}; p1 = f32x16{};
    LAS const unsigned char* kb[4];
#pragma unroll
    for (int dd = 0; dd < 4; ++dd) kb[dd] = K_lds + KB * SHM_K + AT_KSWZ(r32, (dd * 16 + hi * 8) * 2);
#pragma unroll
    for (int d0 = 0; d0 < 8; ++d0) { LAS const unsigned char* a = kb[d0 & 3] + (d0 >> 2) * 128;
        const f16x8 b0 = *(LAS const f16x8*)a;
        const f16x8 b1 = *(LAS const f16x8*)(a + 32 * 256);
        p0 = __builtin_amdgcn_mfma_f32_32x32x16_f16(b0, qr[d0], p0, 0, 0, 0);
        p1 = __builtin_amdgcn_mfma_f32_32x32x16_f16(b1, qr[d0], p1, 0, 0, 0); }
}
template <int VB>
__device__ __forceinline__ void pv_tile(f32x16* o, int vb0, f16x8 pa0, f16x8 pa1, f16x8 pa2, f16x8 pa3) {
#define AT_TRRD(dst, off) asm volatile("ds_read_b64_tr_b16 %0, %1 offset:%2" : "=&v"(dst) : "v"(vb0), "i"(off) : "memory")
#define AT_CAT(l, h) __builtin_bit_cast(f16x8, (s16x8){l[0], l[1], l[2], l[3], h[0], h[1], h[2], h[3]})
#define AT_PV_D0(d0) do { s16x4 l0, l1, l2, l3, h0, h1, h2, h3; constexpr int b_ = VB * SHM_V + v_rd_off(d0, 0, 0); \
        AT_TRRD(l0, b_); AT_TRRD(h0, b_ + 2048); AT_TRRD(l1, b_ + 4096); AT_TRRD(h1, b_ + 6144); AT_TRRD(l2, b_ + 8192); AT_TRRD(h2, b_ + 10240); AT_TRRD(l3, b_ + 12288); AT_TRRD(h3, b_ + 14336); \
        asm volatile("s_waitcnt lgkmcnt(0)" ::: "memory"); AT_SBAR();   \
        o[d0] = __builtin_amdgcn_mfma_f32_32x32x16_f16(pa0, AT_CAT(l0, h0), o[d0], 0, 0, 0);   \
        o[d0] = __builtin_amdgcn_mfma_f32_32x32x16_f16(pa1, AT_CAT(l1, h1), o[d0], 0, 0, 0);   \
        o[d0] = __builtin_amdgcn_mfma_f32_32x32x16_f16(pa2, AT_CAT(l2, h2), o[d0], 0, 0, 0);   \
        o[d0] = __builtin_amdgcn_mfma_f32_32x32x16_f16(pa3, AT_CAT(l3, h3), o[d0], 0, 0, 0); } while (0)
    AT_PV_D0(0); AT_PV_D0(1); AT_PV_D0(2); AT_PV_D0(3);
#undef AT_PV_D0
#undef AT_CAT
#undef AT_TRRD
}
struct BlockRef { const f16* Q; const f16* K; const f16* V; f16* O; const u64* M; int NT; };
struct Seam { f16x8 qr[8]; f16x8 st_v0, st_v1, st_k0, st_k1; };
#define AT_ROW(p, k0, rr) ((p) + (size_t)((k0) + (rr)) * KS + sc)
#define AT_VMW() asm volatile("s_waitcnt vmcnt(0)" ::: "memory")
#define AT_VMWN(n) asm volatile("s_waitcnt vmcnt(%0)" :: "i"(n) : "memory")
#define AT_SLOAD_H(Kp, Vp, k0) do { S.st_v0 = load8(AT_ROW(Vp, k0, sr)); S.st_v1 = load8(AT_ROW(Vp, k0, 32 + sr)); S.st_k0 = load8(AT_ROW(Kp, k0, sr)); S.st_k1 = load8(AT_ROW(Kp, k0, 32 + sr)); } while (0)
#define AT_SWRITE_HK(bf) do { *(LAS f16x8*)(K_lds + (bf) * SHM_K + kws) = S.st_k0; *(LAS f16x8*)(K_lds + (bf) * SHM_K + kws + 32 * 256) = S.st_k1; } while (0)
#define AT_SWRITE_HV(bf) do { *(LAS f16x8*)(V_lds + (bf) * SHM_V + vst0) = S.st_v0; *(LAS f16x8*)(V_lds + (bf) * SHM_V + vst1) = S.st_v1; } while (0)
#define AT_SWRITE_H(bf) do { AT_SWRITE_HV(bf); AT_SWRITE_HK(bf); } while (0)
__device__ __forceinline__ void prime(const BlockRef& cur, LAS unsigned char* lds, Seam& S) {
    const int tid = otid(), wid = __builtin_amdgcn_readfirstlane(tid >> 6), lane = tid & 63, r32 = lane & 31, hi = lane >> 5;
    const int sr = tid >> 4, sc = (tid & 15) * 8, kws = AT_KSWZ(sr, sc * 2); LAS unsigned char* K_lds = lds + 2 * SHM_V;
#pragma unroll
    for (int d0 = 0; d0 < 8; ++d0) S.qr[d0] = load8(cur.Q + (size_t)(wid * QBLK + r32) * QS + d0 * 16 + hi * 8);
    AT_SLOAD_H(cur.K, cur.V, 0); AT_VMW(); AT_SWRITE_HK(0);
    __syncthreads();
}
__device__ __forceinline__ void block(const BlockRef& cur, const BlockRef& nxt, LAS unsigned char* lds, Seam& S) {
    const int tid = otid(), wid = __builtin_amdgcn_readfirstlane(tid >> 6), lane = tid & 63, r32 = lane & 31, hi = lane >> 5;
    const int NT = cur.NT;
    LAS unsigned char* V_lds = lds; LAS unsigned char* K_lds = lds + 2 * SHM_V;
    LAS float* ws = (LAS float*)(lds + 2 * SHM_V + 2 * SHM_K) + wid * 64; LAS float* li_l = ws; LAS float* al_l = ws + 32;
    float m_reg = -1e30f, l_reg = 0; f32x16 o[4] = {};
    const int sr = tid >> 4, sc = (tid & 15) * 8, vst0 = v_st(sr, sc), vst1 = v_st(32 + sr, sc), kws = AT_KSWZ(sr, sc * 2);
    const int vb0 = (int)(unsigned)(size_t)V_lds + v_rd_base(lane);
    const f16* Kh = cur.K; const f16* Vh = cur.V;
    const u64* mrow = cur.M + (size_t)(wid * QBLK + r32) * 33;
    u64 mw;
#define AT_RESC(a) do { if (__any((a) < 1.f)) { if (hi == 0) al_l[r32] = (a); asm volatile("s_waitcnt lgkmcnt(0)" ::: "memory");              \
                     for (int d_ = 0; d_ < 4; ++d_) for (int r = 0; r < 16; ++r) o[d_][r] *= al_l[crow(r, hi)]; } } while (0)
#define AT_KBASE(t) ((t) * KVBLK)
#define AT_SEAM_K0() do { AT_VMWN(8); AT_SWRITE_HK(0); AT_SBAR(); } while (0)
    f32x16 pA0, pA1, pB0, pB1; float mnA, mnB, alA, alB; f16x8 pa0, pa1, pa2, pa3;
    AT_SWRITE_HV(0); AT_SBAR();
    mw = mrow[0];
    if (NT > 1) { AT_SLOAD_H(Kh, Vh, AT_KBASE(1)); }
    AT_SBAR(); qkt<0>(pA0, pA1, K_lds, r32, hi, S.qr);
    mask_bits(pA0, pA1, mw, hi); partialSM(pA0, pA1, m_reg, mnA, alA);
    if (NT > 1) { AT_VMW(); AT_SWRITE_H(1); }
    __syncthreads();
#define AT_HALF_STEP(PX0, PX1, mnX, alX, PY0, PY1, alY, t, KB, VB, SB) do {                                                      \
        AT_SBAR(); mw = mrow[(t)]; qkt<KB>(PX0, PX1, K_lds, r32, hi, S.qr);                                             \
        finishSM(PY0, PY1, alY, l_reg, pa0, pa1, pa2, pa3); AT_SBAR();                                                           \
        if ((t) + 1 < NT) { AT_SLOAD_H(Kh, Vh, AT_KBASE((t) + 1)); AT_SBAR(); }                                               \
        pv_tile<VB>(o, vb0, pa0, pa1, pa2, pa3); mask_bits(PX0, PX1, mw, hi); partialSM(PX0, PX1, m_reg, mnX, alX);                                        \
        __syncthreads();                                                                                                      \
        if ((t) + 1 < NT) { AT_VMW(); AT_SWRITE_H(SB); }                                                                          \
        AT_RESC(alX); __syncthreads(); } while (0)
    for (int t = 1; t + 1 < NT; t += 2) {
        AT_HALF_STEP(pB0, pB1, mnB, alB, pA0, pA1, alA, t, 1, 0, 0);
        AT_HALF_STEP(pA0, pA1, mnA, alA, pB0, pB1, alB, t + 1, 0, 1, 1);
    }
    const bool even = (NT & 1) == 0;
    if (even) { AT_SBAR(); mw = mrow[NT - 1]; qkt<1>(pB0, pB1, K_lds, r32, hi, S.qr); AT_SBAR(); }
    AT_SLOAD_H(nxt.K, nxt.V, 0); AT_SBAR();
#pragma unroll
    for (int d0 = 0; d0 < 8; ++d0) S.qr[d0] = load8(nxt.Q + (size_t)(wid * QBLK + r32) * QS + d0 * 16 + hi * 8);
    AT_SBAR();
    finishSM(pA0, pA1, alA, l_reg, pa0, pa1, pa2, pa3); AT_SBAR();
    pv_tile<0>(o, vb0, pa0, pa1, pa2, pa3);
    if (even) { mask_bits(pB0, pB1, mw, hi); partialSM(pB0, pB1, m_reg, mnB, alB); __syncthreads(); AT_RESC(alB);
        finishSM(pB0, pB1, alB, l_reg, pa0, pa1, pa2, pa3); AT_SBAR(); pv_tile<1>(o, vb0, pa0, pa1, pa2, pa3); }
    AT_SBAR(); AT_SEAM_K0();
    if (hi == 0) li_l[r32] = l_reg; asm volatile("s_waitcnt lgkmcnt(0)" ::: "memory");
    float rli[16];
#pragma unroll
    for (int r = 0; r < 16; ++r) rli[r] = __builtin_amdgcn_rcpf(li_l[crow(r, hi)]);
    f16* Ow = cur.O + (size_t)(wid * QBLK) * QS;
#pragma unroll
    for (int r = 0; r < 16; ++r) { const int orow = crow(r, hi);
#pragma unroll
        for (int d0 = 0; d0 < 4; ++d0) { const float v = o[d0][r] * rli[r];
            const float vn = __shfl_xor(v, 1);
            if ((r32 & 1) == 0) *(unsigned*)(Ow + (size_t)orow * QS + d0 * 32 + r32) = pk2h(v, vn); } }
    __syncthreads();
#undef AT_RESC
#undef AT_KBASE
#undef AT_SEAM_K0
#undef AT_HALF_STEP
}
#undef AT_ROW
#undef AT_VMW
#undef AT_VMWN
#undef AT_SLOAD_H
#undef AT_SWRITE_HK
#undef AT_SWRITE_HV
#undef AT_SWRITE_H
}
__device__ __forceinline__ att::BlockRef att_unit(const f16* Q16, const f16* K16, const f16* V16, const unsigned long long* MASK, f16* O16, int b, int h, int x) {
    att::BlockRef r; const size_t row0 = (size_t)b * SEQ + 256 * x; const int kvh = h >> 2;
    r.Q = Q16 + row0 * D + h * 128; r.K = K16 + (size_t)b * TP * 512 + kvh * 128; r.V = V16 + (size_t)b * TP * 512 + kvh * 128;
    r.O = O16 + row0 * D + h * 128; r.M = MASK + row0 * 33; r.NT = 4 * x + 5; return r;
}
__device__ __forceinline__ void attn_phase(LAS unsigned char* lds, const f16* Q16, const f16* K16, const f16* V16, const unsigned long long* MASK, f16* O16) {
    const int bid = obid();
    if (bid < 256) {
        const int xcd = bid & 7, j = bid >> 3, combo = xcd * 2 + (j & 1), item = j >> 1, hl = item >> 2, pp = item & 3;
        const int b = combo >> 2, kvh = combo & 3, h = kvh * 4 + hl;
        const att::BlockRef u0 = att_unit(Q16, K16, V16, MASK, O16, b, h, 7 - pp), u1 = att_unit(Q16, K16, V16, MASK, O16, b, h, pp);
        att::Seam S;
        att::prime(u0, lds, S);
        att::block(u0, u1, lds, S);
        att::block(u1, u1, lds, S);
    }
}

template <class F>
__device__ __forceinline__ void gemm(LAS unsigned char* lds, const f16* A, int lda, const f16* Bt, int ldb, int M, int N, int K, int cu, F f) {
    pg8::Gemm g{A, Bt, M, N, K, lda, ldb};
    pg8::StaticOrder S; S.init(M, N, (int)gridDim.x, cu);
    pg8::EpiRow8<F> E{f};
    pg8::gemm_phase<pg8::EpiRow8<F>, pg8::StaticOrder, true, true>(lds, g, S, E);
}

__global__ void __launch_bounds__(NTHREADS, 2) fwd(Params p) {
    cg::grid_group grid = cg::this_grid();
    extern __shared__ __attribute__((aligned(16))) unsigned char smem[];
    LAS unsigned char* lds = (LAS unsigned char*)smem;
    float* ldsf = (float*)smem;
    unsigned char* ws = p.ws;
    float* H = (float*)(ws + OFF_H); f16* A16 = (f16*)(ws + OFF_A16); f16* U16 = (f16*)(ws + OFF_U16);
    f16* DY16 = (f16*)(ws + OFF_DY16); f16* CAT16 = (f16*)(ws + OFF_CAT16);
    f16* HID16 = (f16*)(ws + OFF_BIG);
    CinOut co{(f16*)(ws + OFF_Q16), (f16*)(ws + OFF_K16), (f16*)(ws + OFF_V16), (f16*)(ws + OFF_QI16), (f16*)(ws + OFF_KI16), (float*)(ws + OFF_WI), (const float2*)(ws + OFF_ROPE16), (const float2*)(ws + OFF_ROPE8)};
    float* SCORE = (float*)(ws + OFF_SCORE); unsigned long long* MASK = (unsigned long long*)(ws + OFF_MASK); f16* O16 = (f16*)(ws + OFF_O16);
    const float* ng = p.in[I_NORMG];
    const int bid = (int)blockIdx.x, G = (int)gridDim.x;

    convert_weights(p, ldsf);
    init_rows(p, H, A16);
    build_rope((float2*)(ws + OFF_ROPE16), (float2*)(ws + OFF_ROPE8));
    grid.sync();
    gemm(lds, A16, D, (const f16*)(ws + W_IN), D, MP, D, D, bid, [=](int r, int c, f32x4 v0, f32x4 v1) { st8h(U16 + (size_t)r * D + c, v0, v1); });
    grid.sync();
    pool_diff(U16, DY16);
    ssm_phase(p, U16, DY16, lds);
    grid.sync();
    for (int g = 0; g < 4; ++g) {
        const float* ps = p.in[I_POOLS] + g * 256;
        gemm(lds, DY16 + g * 256, D, (const f16*)(ws + W_POOL) + (size_t)g * 65536, 256, MP, 256, 256, (bid + G - 33 * g) % G,
             [=](int r, int c, f32x4 v0, f32x4 v1) { const f32x4 s0 = *(const f32x4*)(ps + c), s1 = *(const f32x4*)(ps + c + 4); st8h(CAT16 + (size_t)r * D + g * 256 + c, v0 * s0, v1 * s1); });
    }
    gemm(lds, DY16 + 1024, D, (const f16*)(ws + W_GLU), 1024, MP, 1024, 1024, (bid + G - 132) % G,
         [=](int r, int c, f32x4 v0, f32x4 v1) {
             const f16* yp = DY16 + (size_t)r * D + 1024 + c; const float4 y0 = ld4(yp), y1 = ld4(yp + 4);
             f32x4 o0, o1;
             o0[0] = y0.x / (1.f + __expf(-v0[0])); o0[1] = y0.y / (1.f + __expf(-v0[1])); o0[2] = y0.z / (1.f + __expf(-v0[2])); o0[3] = y0.w / (1.f + __expf(-v0[3]));
             o1[0] = y1.x / (1.f + __expf(-v1[0])); o1[1] = y1.y / (1.f + __expf(-v1[1])); o1[2] = y1.z / (1.f + __expf(-v1[2])); o1[3] = y1.w / (1.f + __expf(-v1[3]));
             st8h(CAT16 + (size_t)r * D + 1024 + c, o0, o1); });
    grid.sync();
    gemm(lds, CAT16, D, (const f16*)(ws + W_OUT), D, MP, D, D, bid, [=](int r, int c, f32x4 v0, f32x4 v1) { st8h(U16 + (size_t)r * D + c, v0, v1); });
    grid.sync();
    rowpass(U16, ng + 1 * D, ng + 2 * D, H, A16, nullptr, MP);
    grid.sync();
    gemm(lds, A16, D, (const f16*)(ws + W_1), D, MP, DFF, D, bid, [=](int r, int c, f32x4 v0, f32x4 v1) {
        f32x4 z0 = __builtin_elementwise_max(v0, (f32x4){0.f, 0.f, 0.f, 0.f}), z1 = __builtin_elementwise_max(v1, (f32x4){0.f, 0.f, 0.f, 0.f}); st8h(HID16 + (size_t)r * DFF + c, z0 * z0, z1 * z1); });
    grid.sync();
    gemm(lds, HID16, DFF, (const f16*)(ws + W_2), DFF, MP, D, DFF, bid, [=](int r, int c, f32x4 v0, f32x4 v1) { st8h(U16 + (size_t)r * D + c, v0, v1); });
    grid.sync();
    rowpass(U16, ng + 3 * D, ng + 4 * D, H, A16, nullptr, MP);
    zero_kv_pads(co.K16, co.V16, co.KI16);
    grid.sync();
    gemm(lds, A16, D, (const f16*)(ws + W_CIN), D, MP, CINP, D, bid, [=](int r, int c, f32x4 v0, f32x4 v1) { cin_epilogue(co, r, c, v0, v1); });
    grid.sync();
#ifdef IDX_NAIVE
    idx_scores(co.QI16, co.KI16, co.WI, SCORE);
    grid.sync();
    select_topk(SCORE, MASK);
#else
    index_select(co.QI16, co.KI16, co.WI, MASK, lds);
#endif
    grid.sync();
#ifdef ATT_NAIVE
    attn_naive(ldsf, co.Q16, co.K16, co.V16, MASK, O16);
#else
    attn_phase(lds, co.Q16, co.K16, co.V16, MASK, O16);
#endif
    grid.sync();
    gemm(lds, O16, D, (const f16*)(ws + W_COUT), D, MMAIN, D, D, bid, [=](int r, int c, f32x4 v0, f32x4 v1) { st8h(U16 + (size_t)r * D + c, v0, v1); });
    grid.sync();
    rowpass(U16, ng + 5 * D, ng + 6 * D, H, A16, nullptr, MMAIN);
    grid.sync();
    gemm(lds, A16, D, (const f16*)(ws + W_1) + (size_t)D * DFF, D, MMAIN, DFF, D, bid, [=](int r, int c, f32x4 v0, f32x4 v1) {
        f32x4 z0 = __builtin_elementwise_max(v0, (f32x4){0.f, 0.f, 0.f, 0.f}), z1 = __builtin_elementwise_max(v1, (f32x4){0.f, 0.f, 0.f, 0.f}); st8h(HID16 + (size_t)r * DFF + c, z0 * z0, z1 * z1); });
    grid.sync();
    gemm(lds, HID16, DFF, (const f16*)(ws + W_2) + (size_t)D * DFF, DFF, MMAIN, D, DFF, bid, [=](int r, int c, f32x4 v0, f32x4 v1) { st8h(U16 + (size_t)r * D + c, v0, v1); });
    grid.sync();
    rowpass(U16, ng + 7 * D, nullptr, H, nullptr, p.out, MMAIN);
}

extern "C" void kernel_launch(void* const* d_in, const int* in_sizes, int n_in, void* d_out, int out_size, void* d_ws, size_t ws_size, hipStream_t stream) {
    static int grid_blocks = 0;
    if (!grid_blocks) {
        if (n_in != 20 || out_size != MMAIN * D || ws_size < WS_NEED) { fprintf(stderr, "kernel_launch: unexpected shapes n_in %d out %d ws %zu (need %zu)\n", n_in, out_size, ws_size, (size_t)WS_NEED); grid_blocks = -1; return; }
        int dev = 0, cus = 0, per_cu = 0;
        (void)hipGetDevice(&dev);
        (void)hipDeviceGetAttribute(&cus, hipDeviceAttributeMultiprocessorCount, dev);
        if (hipFuncSetAttribute((const void*)fwd, hipFuncAttributeMaxDynamicSharedMemorySize, LDS_BYTES) != hipSuccess) { fprintf(stderr, "kernel_launch: hipFuncSetAttribute failed\n"); grid_blocks = -1; return; }
        (void)hipOccupancyMaxActiveBlocksPerMultiprocessor(&per_cu, fwd, NTHREADS, LDS_BYTES);
        if (per_cu < 1) { fprintf(stderr, "kernel_launch: occupancy query says %d blocks per CU\n", per_cu); per_cu = 1; }
        grid_blocks = cus;
    }
    if (grid_blocks < 0) return;
    Params p{};
    for (int i = 0; i < 20; ++i) p.in[i] = (const float*)d_in[i];
    p.out = (float*)d_out; p.ws = (unsigned char*)d_ws;
    void* args[] = {&p};
    hipError_t e = hipLaunchCooperativeKernel((void*)fwd, dim3(grid_blocks), dim3(NTHREADS), args, LDS_BYTES, stream);
    if (e != hipSuccess) fprintf(stderr, "cooperative launch failed: %s (grid %d)\n", hipGetErrorString(e), grid_blocks);
}
```

```cpp
#include <hip/hip_runtime.h>
#include <hip/hip_fp16.h>
#include <hip/hip_cooperative_groups.h>
#include <cstdio>
#include <cstdint>
#include <cmath>
namespace cg = cooperative_groups;
__device__ __forceinline__ int otid() { int t = threadIdx.x; asm volatile("" : "+v"(t)); return t; }
__device__ __forceinline__ int obid() { int t = blockIdx.x; asm volatile("" : "+s"(t)); return t; }

namespace pg8 {
#define PG8_LAS __attribute__((address_space(3)))
typedef _Float16 f16_t;
typedef _Float16 f16x8 __attribute__((ext_vector_type(8)));
typedef float f32x4 __attribute__((ext_vector_type(4)));
typedef unsigned u32x4 __attribute__((ext_vector_type(4)));
constexpr int BM = 256, BK = 64, HALF = 128, HTB = HALF * BK * 2  , STAGE_BYTES = 8 * HTB, NXCD = 8, WGM = 8;

__host__ __device__ __forceinline__ int lds_byte(int r, int c) { const int st = (r >> 4) * 2 + (c >> 5), rr = r & 15, cc = c & 31, ob = rr * 64 + cc * 2; return st * 1024 + (ob ^ (((ob >> 9) & 1) << 5)); }
__host__ __device__ __forceinline__ void stage_rc(int b, int& R, int& C) { const int st = b / 1024, sb = b % 1024, swz = sb ^ (((sb >> 9) & 1) << 5); R = (st >> 1) * 16 + swz / 64; C = (st & 1) * 32 + (swz % 64) / 2; }
__host__ __device__ __forceinline__ int perm32(int rho) { const int n = rho >> 4, i = rho & 15; return 8 * (i >> 2) + 4 * n + (i & 3); }

struct Unit { int pm, pn; };
struct Gemm { const f16_t* A; const f16_t* Bt; int M, N, K, lda, ldb; };

struct StaticOrder {
    int nM, nN, nwg, G, c;
    __host__ __device__ void init(int M, int N, int G_, int c_) { nM = M / BM; nN = N / BM; nwg = nM * nN; G = G_; c = c_; }
    __host__ __device__ bool next(int i, Unit& u) const {
        const long L = (long)i * G + c; if (L >= nwg) return false;
        int wgid = (int)L; { const int q = nwg / NXCD, r = nwg % NXCD, xcd = wgid % NXCD, off = wgid / NXCD; wgid = (xcd < r ? xcd * (q + 1) : r * (q + 1) + (xcd - r) * q) + off; }
        const int nig = WGM * nN, gid = wgid / nig, fm = gid * WGM, gsz = (nM - fm) < WGM ? (nM - fm) : WGM;
        u.pm = fm + ((wgid % nig) % gsz); u.pn = (wgid % nig) / gsz; return true;
    }
    __device__ __forceinline__ void a_ready(const Unit&) const {}
    __device__ __forceinline__ void done(const Unit&) const {}
};


template <class Epi, class Sched, bool ALIGN_EPI = false, bool SP2 = false>
__device__ __forceinline__ void gemm_phase(PG8_LAS unsigned char* lds, const Gemm g, const Sched& S, const Epi& E) {
    const int tid = otid(), wid = __builtin_amdgcn_readfirstlane(tid >> 6), lane = tid & 63, wr = wid >> 2, wc = wid & 3, fr = lane & 15, fq = lane >> 4;
    const int K = g.K, nt = K / BK;
    unsigned voffA[2], voffB[2];
#pragma unroll
    for (int i = 0; i < 2; ++i) { int R, C; stage_rc(tid * 16 + i * 8192, R, C); const int Rb = Epi::PERM ? ((R & ~31) + perm32(R & 31)) : R;
        voffA[i] = (unsigned)(R * g.lda + C) * 2u; voffB[i] = (unsigned)(Rb * g.ldb + C) * 2u; }
    const size_t kstep = (size_t)(BK * 2);
    const size_t hstepA = (size_t)HALF * g.lda * 2, hstepB = (size_t)HALF * g.ldb * 2;
    const size_t tstepA = 2 * hstepA, tstepB = 2 * hstepB;
    const unsigned ldsw = (unsigned)wid * 1024u;
    const int aoff = lds_byte(wr * 64 + fr, fq * 8), boff = lds_byte(wc * 32 + fr, fq * 8);
#define PG8_SA(b, h) (((b) * 2 + (h)) * HTB)
#define PG8_SB(b, h) ((4 + (b) * 2 + (h)) * HTB)
#define PG8_STAGE(bufoff, gbase, voff) do { _Pragma("unroll") for (int _i = 0; _i < 2; ++_i) \
        __builtin_amdgcn_global_load_lds((const unsigned*)((const char*)(gbase) + (voff)[_i]), (PG8_LAS unsigned*)(lds + (bufoff) + ldsw + _i * 8192), 16, 0, 0); } while (0)
#define PG8_LDA(dst, b, h) do { _Pragma("unroll") for (int m = 0; m < 4; ++m) _Pragma("unroll") for (int k = 0; k < 2; ++k) dst[m][k] = *(const PG8_LAS f16x8*)(lds + PG8_SA(b, h) + aoff + m * 2048 + k * 1024); } while (0)
#define PG8_LDB(dst, b, h) do { _Pragma("unroll") for (int n = 0; n < 2; ++n) _Pragma("unroll") for (int k = 0; k < 2; ++k) dst[n][k] = *(const PG8_LAS f16x8*)(lds + PG8_SB(b, h) + boff + n * 2048 + k * 1024); } while (0)
#define PG8_MMA(ai, bj, At, Bt) do { __builtin_amdgcn_s_setprio(1); _Pragma("unroll") for (int m = 0; m < 4; ++m) _Pragma("unroll") for (int n = 0; n < 2; ++n) _Pragma("unroll") for (int k = 0; k < 2; ++k) \
        acc[ai][bj][m][n] = __builtin_amdgcn_mfma_f32_16x16x32_f16(Bt[n][k], At[m][k], acc[ai][bj][m][n], 0, 0, 0); __builtin_amdgcn_s_setprio(0); } while (0)
#define PG8_WAIT_V(n) asm volatile("s_waitcnt vmcnt(" #n ")" ::: "memory")
#define PG8_WAIT_L(n) asm volatile("s_waitcnt lgkmcnt(" #n ")" ::: "memory")
#define PG8_BAR __builtin_amdgcn_s_barrier()
#define PG8_SCHED __builtin_amdgcn_sched_barrier(0)
    Unit cur, nxt; int ui = 0;
    if (!S.next(0, cur)) return;
    f32x4 acc[2][2][4][2];
#pragma unroll
    for (int a = 0; a < 2; ++a)
#pragma unroll
        for (int b = 0; b < 2; ++b)
#pragma unroll
            for (int m = 0; m < 4; ++m)
#pragma unroll
                for (int n = 0; n < 2; ++n) acc[a][b][m][n] = (f32x4){0.f, 0.f, 0.f, 0.f};
    f16x8 At[4][2], B0[2][2], B1[2][2];
    const char* cA = (const char*)g.A + (size_t)cur.pm * tstepA; const char* cB = (const char*)g.Bt + (size_t)cur.pn * tstepB;
    S.a_ready(cur);
    if constexpr (SP2) {
        PG8_STAGE(PG8_SB(0, 0), cB, voffB); PG8_STAGE(PG8_SB(0, 1), cB + hstepB, voffB); PG8_STAGE(PG8_SA(0, 0), cA, voffA); PG8_STAGE(PG8_SA(0, 1), cA + hstepA, voffA);
        if (wr == 1) PG8_BAR;
        PG8_WAIT_V(2); PG8_BAR;
        PG8_STAGE(PG8_SB(1, 0), cB + kstep, voffB); PG8_STAGE(PG8_SA(1, 0), cA + kstep, voffA); PG8_STAGE(PG8_SB(1, 1), cB + hstepB + kstep, voffB);
        PG8_WAIT_V(6); PG8_BAR;
    } else {
        PG8_STAGE(PG8_SB(0, 0), cB, voffB); PG8_STAGE(PG8_SA(0, 0), cA, voffA); PG8_STAGE(PG8_SB(0, 1), cB + hstepB, voffB); PG8_STAGE(PG8_SA(0, 1), cA + hstepA, voffA);
        if (wr == 1) PG8_BAR;
        PG8_WAIT_V(4); PG8_BAR;
        PG8_STAGE(PG8_SB(1, 0), cB + kstep, voffB); PG8_STAGE(PG8_SA(1, 0), cA + kstep, voffA); PG8_STAGE(PG8_SB(1, 1), cB + hstepB + kstep, voffB);
        PG8_WAIT_V(6); PG8_BAR;
    }
    for (;;) {
        const bool has_next = S.next(ui + 1, nxt);
        const char* nA = has_next ? (const char*)g.A + (size_t)nxt.pm * tstepA : cA; const char* nB = has_next ? (const char*)g.Bt + (size_t)nxt.pn * tstepB : cB;
        for (int t = 0; t < nt; t += 2) {
            const bool last = (t == nt - 2);
            const char* a1 = cA + (size_t)(t + 1) * kstep;
            const char* a2 = last ? nA : cA + (size_t)(t + 2) * kstep; const char* b2 = last ? nB : cB + (size_t)(t + 2) * kstep;
            const char* a3 = a2 + kstep; const char* b3 = b2 + kstep;
            if (last && has_next) S.a_ready(nxt);
            if constexpr (SP2) {
            PG8_LDB(B0, 0, 0); PG8_LDB(B1, 0, 1); PG8_SCHED; PG8_LDA(At, 0, 0); PG8_STAGE(PG8_SA(1, 1), a1 + hstepA, voffA);
            PG8_WAIT_V(8); PG8_WAIT_L(0); PG8_BAR; PG8_MMA(0, 0, At, B0); PG8_MMA(0, 1, At, B1); PG8_BAR; PG8_SCHED;
            PG8_LDA(At, 0, 1); PG8_STAGE(PG8_SB(0, 0), b2, voffB); PG8_STAGE(PG8_SB(0, 1), b2 + hstepB, voffB); PG8_STAGE(PG8_SA(0, 0), a2, voffA);
            PG8_WAIT_V(8); PG8_WAIT_L(0); PG8_BAR; PG8_MMA(1, 0, At, B0); PG8_MMA(1, 1, At, B1); PG8_BAR; PG8_SCHED;
            PG8_LDB(B0, 1, 0); PG8_LDB(B1, 1, 1); PG8_SCHED; PG8_LDA(At, 1, 0); PG8_STAGE(PG8_SA(0, 1), a2 + hstepA, voffA);
            PG8_WAIT_V(8); PG8_WAIT_L(0); PG8_BAR; PG8_MMA(0, 0, At, B0); PG8_MMA(0, 1, At, B1); PG8_BAR; PG8_SCHED;
            PG8_LDA(At, 1, 1); PG8_STAGE(PG8_SB(1, 0), b3, voffB); PG8_STAGE(PG8_SB(1, 1), b3 + hstepB, voffB); PG8_STAGE(PG8_SA(1, 0), a3, voffA);
            PG8_WAIT_V(8); PG8_WAIT_L(0); PG8_BAR; PG8_MMA(1, 0, At, B0); PG8_MMA(1, 1, At, B1); PG8_BAR; PG8_SCHED;
            } else {
            PG8_LDB(B0, 0, 0); PG8_SCHED; PG8_LDA(At, 0, 0); PG8_STAGE(PG8_SA(1, 1), a1 + hstepA, voffA);
            PG8_WAIT_L(8); PG8_BAR; PG8_WAIT_L(0); PG8_MMA(0, 0, At, B0); PG8_BAR; PG8_SCHED;
            PG8_LDB(B1, 0, 1); PG8_STAGE(PG8_SB(0, 0), b2, voffB);
            PG8_BAR; PG8_WAIT_L(0); PG8_MMA(0, 1, At, B1); PG8_BAR;
            PG8_LDA(At, 0, 1); PG8_STAGE(PG8_SA(0, 0), a2, voffA);
            PG8_BAR; PG8_WAIT_L(0); PG8_MMA(1, 0, At, B0); PG8_BAR; PG8_SCHED;
            PG8_STAGE(PG8_SB(0, 1), b2 + hstepB, voffB);
            PG8_WAIT_V(6); PG8_BAR; PG8_MMA(1, 1, At, B1); PG8_BAR;
            PG8_LDB(B0, 1, 0); PG8_SCHED; PG8_LDA(At, 1, 0); PG8_STAGE(PG8_SA(0, 1), a2 + hstepA, voffA);
            PG8_WAIT_L(8); PG8_BAR; PG8_WAIT_L(0); PG8_MMA(0, 0, At, B0); PG8_BAR; PG8_SCHED;
            PG8_LDB(B1, 1, 1); PG8_STAGE(PG8_SB(1, 0), b3, voffB);
            PG8_BAR; PG8_WAIT_L(0); PG8_MMA(0, 1, At, B1); PG8_BAR;
            PG8_LDA(At, 1, 1); PG8_STAGE(PG8_SA(1, 0), a3, voffA);
            PG8_BAR; PG8_WAIT_L(0); PG8_MMA(1, 0, At, B0); PG8_BAR; PG8_SCHED;
            PG8_STAGE(PG8_SB(1, 1), b3 + hstepB, voffB);
            PG8_WAIT_V(6); PG8_BAR; PG8_MMA(1, 1, At, B1); PG8_BAR;
            }
        }
        if constexpr (ALIGN_EPI) { if (wr == 0) PG8_BAR; }
        if constexpr (!Epi::AFTER_DRAIN) { E(acc, cur, wr, wc, fr, fq); S.done(cur); }
        if (!has_next) break;
#pragma unroll
        for (int a = 0; a < 2; ++a)
#pragma unroll
            for (int b = 0; b < 2; ++b)
#pragma unroll
                for (int m = 0; m < 4; ++m)
#pragma unroll
                    for (int n = 0; n < 2; ++n) acc[a][b][m][n] = (f32x4){0.f, 0.f, 0.f, 0.f};
        cur = nxt; cA = nA; cB = nB; ++ui;
        if constexpr (ALIGN_EPI) { if (wr == 1) PG8_BAR; }
    }
    PG8_WAIT_V(0);
    if constexpr (!ALIGN_EPI) { if (wr == 0) PG8_BAR; }
    PG8_BAR;
    if constexpr (Epi::AFTER_DRAIN) { E.fused(acc, cur, wr, wc, fr, fq, lds, wid, lane); S.done(cur); }
#undef PG8_SA
#undef PG8_SB
#undef PG8_STAGE
#undef PG8_LDA
#undef PG8_LDB
#undef PG8_MMA
#undef PG8_WAIT_V
#undef PG8_WAIT_L
#undef PG8_BAR
#undef PG8_SCHED
}

template <class F> struct EpiRow8 {
    static constexpr bool PERM = true, AFTER_DRAIN = false;
    F f;
    __device__ __forceinline__ void operator()(const f32x4 (&acc)[2][2][4][2], const Unit& u, int wr, int wc, int fr, int fq) const {
        const int row0 = u.pm * BM + wr * 64 + fr, col0 = u.pn * BM + wc * 32 + 8 * fq;
#pragma unroll
        for (int ai = 0; ai < 2; ++ai)
#pragma unroll
            for (int m = 0; m < 4; ++m)
#pragma unroll
                for (int bj = 0; bj < 2; ++bj) f(row0 + ai * HALF + m * 16, col0 + bj * HALF, acc[ai][bj][m][0], acc[ai][bj][m][1]);
    }
};
}

#define LAS __attribute__((address_space(3)))
typedef _Float16 f16;
typedef float f32x4 __attribute__((ext_vector_type(4)));
typedef unsigned u32x4 __attribute__((ext_vector_type(4)));
typedef _Float16 h2v __attribute__((ext_vector_type(2)));

constexpr int D = 2048, NMETA = 16, SEQ = 2048, T = 2064, DFF = 8192;
constexpr int MMAIN = 8192;
constexpr int MREAL = 8208;
constexpr int MP = 8448;
constexpr int CIN = 4176, CINP = 4352;
constexpr int QOFF = 0, KOFF = 2048, VOFF = 2560, QIOFF = 3072, KIOFF = 4096, WIOFF = 4160;
constexpr int SROW = 2112;
constexpr float EPS = 1e-6f;
constexpr int NTHREADS = 512;
constexpr int LDS_BYTES = 147456;

struct Params { const float* in[20]; float* out; unsigned char* ws; };
enum { I_X = 0, I_META, I_NORMG, I_ABWIN, I_POOLW, I_POOLS, I_LRE, I_LIM, I_LOGDT, I_BRE, I_BIM, I_CRE, I_CIM, I_S5D, I_WGLU, I_ABWOUT, I_CWIN, I_CWOUT, I_W1, I_W2 };

constexpr int TP = 2112;
constexpr size_t SZ4 = (size_t)MP * D * 4, SZ2 = (size_t)MP * D * 2;
constexpr size_t OFF_H = 0, OFF_A16 = OFF_H + SZ4, OFF_U16 = OFF_A16 + SZ2, OFF_DY16 = OFF_U16 + SZ2, OFF_CAT16 = OFF_DY16 + SZ2, OFF_BIG = OFF_CAT16 + SZ2;
constexpr size_t SZ_BIG = (size_t)MP * DFF * 2;
constexpr size_t OFF_Q16 = OFF_BIG, OFF_K16 = OFF_Q16 + (size_t)MMAIN * D * 2, OFF_V16 = OFF_K16 + (size_t)4 * TP * 512 * 2, OFF_QI16 = OFF_V16 + (size_t)4 * TP * 512 * 2,
                 OFF_KI16 = OFF_QI16 + (size_t)MMAIN * 1024 * 2, OFF_WI = OFF_KI16 + (size_t)4 * TP * 64 * 2, OFF_ATT_END = OFF_WI + (size_t)MMAIN * 16 * 4;
static_assert(OFF_ATT_END <= OFF_BIG + SZ_BIG, "attention buffers fit the BIG region");
constexpr size_t OFF_MASK = OFF_BIG + SZ_BIG, SZ_MASK = (size_t)MMAIN * 33 * 8;
constexpr size_t OFF_ROPE16 = OFF_MASK + SZ_MASK, OFF_ROPE8 = OFF_ROPE16 + (size_t)T * 16 * 8;
constexpr size_t OFF_BAR = OFF_ROPE8 + (size_t)T * 8 * 8, SZ_BAR = 16384;
constexpr size_t OFF_W = OFF_BAR + SZ_BAR;
constexpr size_t OFF_SCORE = OFF_DY16, OFF_O16 = OFF_A16;
constexpr size_t W_IN = OFF_W, W_POOL = W_IN + (size_t)D * D * 2, W_GLU = W_POOL + (size_t)4 * 256 * 256 * 2, W_OUT = W_GLU + (size_t)1024 * 1024 * 2,
                 W_CIN = W_OUT + (size_t)D * D * 2, W_COUT = W_CIN + (size_t)CINP * D * 2, W_1 = W_COUT + (size_t)D * D * 2, W_2 = W_1 + (size_t)2 * D * DFF * 2,
                 WS_NEED = W_2 + (size_t)2 * D * DFF * 2;
static_assert((size_t)MMAIN * SROW * 4 <= 2 * SZ2, "SCORE fits DY16+CAT16");
static_assert(OFF_W % 256 == 0, "alignment");

__device__ __forceinline__ int row_of(int b, int t) { return t < NMETA ? MMAIN + t : b * SEQ + (t - NMETA); }
__device__ __forceinline__ float wave_sum(float v) {
#pragma unroll
    for (int o = 1; o < 64; o <<= 1) v += __shfl_xor(v, o);
    return v;
}
__device__ __forceinline__ float wave_max(float v) {
#pragma unroll
    for (int o = 1; o < 64; o <<= 1) v = fmaxf(v, __shfl_xor(v, o));
    return v;
}
__device__ __forceinline__ float4 ld4(const float* p) { return *(const float4*)p; }
__device__ __forceinline__ unsigned pk2h(float a, float b) { h2v r; r.x = (_Float16)a; r.y = (_Float16)b; return __builtin_bit_cast(unsigned, r); }
__device__ __forceinline__ float2 up2h(unsigned u) { const h2v r = __builtin_bit_cast(h2v, u); return make_float2((float)r.x, (float)r.y); }
__device__ __forceinline__ float4 ld4(const f16* p) { const uint2 r = *(const uint2*)p; const float2 a = up2h(r.x), b = up2h(r.y); return make_float4(a.x, a.y, b.x, b.y); }
__device__ __forceinline__ void st4h(f16* p, float4 v) { uint2 r; r.x = pk2h(v.x, v.y); r.y = pk2h(v.z, v.w); *(uint2*)p = r; }
__device__ __forceinline__ void st8h(f16* p, f32x4 a, f32x4 b) { u32x4 w; w.x = pk2h(a[0], a[1]); w.y = pk2h(a[2], a[3]); w.z = pk2h(b[0], b[1]); w.w = pk2h(b[2], b[3]); *(u32x4*)p = w; }

__device__ __forceinline__ void sincos_d(double x, double& sn, double& cs) {
    const double q = rint(x * 0.6366197723675814);
    double r = fma(-q, 1.5707963267948966, x); r = fma(-q, 6.123233995736766e-17, r);
    const double r2 = r * r;
    double sp = -1.0 / 6227020800.0; sp = fma(sp, r2, 1.0 / 39916800.0); sp = fma(sp, r2, -1.0 / 362880.0); sp = fma(sp, r2, 1.0 / 5040.0); sp = fma(sp, r2, -1.0 / 120.0); sp = fma(sp, r2, 1.0 / 6.0); sp = fma(sp, r2, -1.0); sp = -sp * r;
    double cp = 1.0 / 87178291200.0; cp = fma(cp, r2, -1.0 / 479001600.0); cp = fma(cp, r2, 1.0 / 3628800.0); cp = fma(cp, r2, -1.0 / 40320.0); cp = fma(cp, r2, 1.0 / 720.0); cp = fma(cp, r2, -1.0 / 24.0); cp = fma(cp, r2, 0.5); cp = fma(-cp, r2, 1.0);
    const int n = ((int)q) & 3;
    sn = (n == 0) ? sp : (n == 1) ? cp : (n == 2) ? -sp : -cp;
    cs = (n == 0) ? cp : (n == 1) ? -sp : (n == 2) ? -cp : sp;
}
__device__ __forceinline__ float rope_inv16(int idx) {
    const double r = 1.0 / sqrt(sqrt(sqrt(sqrt(500000.0))));
    double v = 1.0;
    for (int i = 0; i < idx; ++i) v *= r;
    return (float)v;
}

__device__ __forceinline__ void cvt_item(const float* W, int K, int N, int NPAD, f16* WT, float* scr, int item, int lane) {
    const int nblk = NPAD / 32, kb = item / nblk, nb = item % nblk, k0 = 64 * kb, n0 = 32 * nb;
    const int n = n0 + (lane & 31);
#pragma unroll 8
    for (int i = 0; i < 32; ++i) { const int kk = 2 * i + (lane >> 5); scr[kk * 33 + (lane & 31)] = (n < N) ? W[(size_t)(k0 + kk) * N + n] : 0.f; }
    const int c = lane & 7;
#pragma unroll
    for (int j = 0; j < 4; ++j) { const int nn = (lane >> 3) + 8 * j; const float* s = scr + (8 * c) * 33 + nn;
        u32x4 o; o.x = pk2h(s[0 * 33], s[1 * 33]); o.y = pk2h(s[2 * 33], s[3 * 33]); o.z = pk2h(s[4 * 33], s[5 * 33]); o.w = pk2h(s[6 * 33], s[7 * 33]);
        *(u32x4*)(WT + (size_t)(n0 + nn) * K + k0 + 8 * c) = o; }
}
__device__ __forceinline__ void convert_weights(const Params& p, float* ldsf) {
    const int tid_ = otid(), lane = tid_ & 63, wv = tid_ >> 6, gw = obid() * (NTHREADS / 64) + wv, ngw = gridDim.x * (NTHREADS / 64);
    float* scr = ldsf + wv * (64 * 33);
    unsigned char* ws = p.ws;
    constexpr int I_IN = 32 * 64, I_PG = 4 * 8, I_GLU = 16 * 32, I_OUT = 32 * 64, I_CI = 32 * (CINP / 32), I_CO = 32 * 64, I_M1 = 32 * 256, I_M2 = 128 * 64;
    constexpr int NITEMS = I_IN + 4 * I_PG + I_GLU + I_OUT + I_CI + I_CO + 2 * I_M1 + 2 * I_M2;
    for (int it = gw; it < NITEMS; it += ngw) {
        int r = it;
        if (r < I_IN) { cvt_item(p.in[I_ABWIN], D, D, D, (f16*)(ws + W_IN), scr, r, lane); continue; } r -= I_IN;
        if (r < 4 * I_PG) { const int g = r / I_PG; cvt_item(p.in[I_POOLW] + (size_t)g * 65536, 256, 256, 256, (f16*)(ws + W_POOL) + (size_t)g * 65536, scr, r % I_PG, lane); continue; } r -= 4 * I_PG;
        if (r < I_GLU) { cvt_item(p.in[I_WGLU], 1024, 1024, 1024, (f16*)(ws + W_GLU), scr, r, lane); continue; } r -= I_GLU;
        if (r < I_OUT) { cvt_item(p.in[I_ABWOUT], D, D, D, (f16*)(ws + W_OUT), scr, r, lane); continue; } r -= I_OUT;
        if (r < I_CI) { cvt_item(p.in[I_CWIN], D, CIN, CINP, (f16*)(ws + W_CIN), scr, r, lane); continue; } r -= I_CI;
        if (r < I_CO) { cvt_item(p.in[I_CWOUT], D, D, D, (f16*)(ws + W_COUT), scr, r, lane); continue; } r -= I_CO;
        if (r < 2 * I_M1) { const int l = r / I_M1; cvt_item(p.in[I_W1] + (size_t)l * D * DFF, D, DFF, DFF, (f16*)(ws + W_1) + (size_t)l * D * DFF, scr, r % I_M1, lane); continue; } r -= 2 * I_M1;
        { const int l = r / I_M2; cvt_item(p.in[I_W2] + (size_t)l * D * DFF, DFF, D, D, (f16*)(ws + W_2) + (size_t)l * D * DFF, scr, r % I_M2, lane); }
    }
}

__device__ __forceinline__ void init_rows(const Params& p, float* H, f16* A) {
    const int tid_ = otid(), lane = tid_ & 63, gw = obid() * (NTHREADS / 64) + (tid_ >> 6), ngw = gridDim.x * (NTHREADS / 64);
    const float* g = p.in[I_NORMG];
    for (int row = gw; row < MP; row += ngw) {
        float4 h[8]; float ss = 0.f;
#pragma unroll
        for (int j = 0; j < 8; ++j) {
            const int c = 4 * lane + 256 * j;
            if (row < MMAIN) h[j] = ld4(p.in[I_X] + (size_t)row * D + c);
            else if (row < MREAL) h[j] = ld4(p.in[I_META] + (size_t)(row - MMAIN) * D + c);
            else h[j] = make_float4(0.f, 0.f, 0.f, 0.f);
            ss += h[j].x * h[j].x + h[j].y * h[j].y + h[j].z * h[j].z + h[j].w * h[j].w;
        }
        const float r = rsqrtf(wave_sum(ss) * (1.f / D) + EPS);
#pragma unroll
        for (int j = 0; j < 8; ++j) {
            const int c = 4 * lane + 256 * j; const float4 gg = ld4(g + c);
            *(float4*)(H + (size_t)row * D + c) = h[j];
            st4h(A + (size_t)row * D + c, make_float4(h[j].x * r * gg.x, h[j].y * r * gg.y, h[j].z * r * gg.z, h[j].w * r * gg.w));
        }
    }
}
__device__ __forceinline__ void rowpass(const f16* MIX, const float* ga, const float* gb, float* H, f16* A, float* OUT, int nrows) {
    const int tid_ = otid(), lane = tid_ & 63, gw = obid() * (NTHREADS / 64) + (tid_ >> 6), ngw = gridDim.x * (NTHREADS / 64);
    for (int row = gw; row < nrows; row += ngw) {
        float4 m[8], h[8]; float ss = 0.f;
#pragma unroll
        for (int j = 0; j < 8; ++j) {
            const int c = 4 * lane + 256 * j;
            m[j] = ld4(MIX + (size_t)row * D + c); h[j] = ld4(H + (size_t)row * D + c);
            ss += m[j].x * m[j].x + m[j].y * m[j].y + m[j].z * m[j].z + m[j].w * m[j].w;
        }
        const float r = rsqrtf(wave_sum(ss) * (1.f / D) + EPS);
        float s2 = 0.f;
#pragma unroll
        for (int j = 0; j < 8; ++j) {
            const int c = 4 * lane + 256 * j; const float4 gg = ld4(ga + c);
            h[j].x += m[j].x * r * gg.x; h[j].y += m[j].y * r * gg.y; h[j].z += m[j].z * r * gg.z; h[j].w += m[j].w * r * gg.w;
            s2 += h[j].x * h[j].x + h[j].y * h[j].y + h[j].z * h[j].z + h[j].w * h[j].w;
        }
        if (OUT) {
#pragma unroll
            for (int j = 0; j < 8; ++j) *(float4*)(OUT + (size_t)row * D + 4 * lane + 256 * j) = h[j];
        } else {
            const float r2 = rsqrtf(wave_sum(s2) * (1.f / D) + EPS);
#pragma unroll
            for (int j = 0; j < 8; ++j) {
                const int c = 4 * lane + 256 * j; const float4 gg = ld4(gb + c);
                *(float4*)(H + (size_t)row * D + c) = h[j];
                st4h(A + (size_t)row * D + c, make_float4(h[j].x * r2 * gg.x, h[j].y * r2 * gg.y, h[j].z * r2 * gg.z, h[j].w * r2 * gg.w));
            }
        }
    }
}

__device__ __forceinline__ void pool_diff(const f16* U, f16* DY) {
    const int total = MREAL * 128, stride = (int)gridDim.x * NTHREADS;
    for (int i = obid() * NTHREADS + otid(); i < total; i += stride) {
        const int row = i >> 7, c = (i & 127) * 8;
        const int b = row < MMAIN ? row >> 11 : 0, t = row < MMAIN ? (row & 2047) + NMETA : row - MMAIN;
        const int win = 2 << (c >> 8);
        const int cnt = (t + 1) < win ? (t + 1) : win;
        const float4 ua = ld4(U + (size_t)row * D + c), ub = ld4(U + (size_t)row * D + c + 4);
        float4 sa = ua, sb = ub;
        for (int j = 1; j < cnt; ++j) {
            const f16* up = U + (size_t)row_of(b, t - j) * D + c; const float4 a = ld4(up), bb = ld4(up + 4);
            sa.x += a.x; sa.y += a.y; sa.z += a.z; sa.w += a.w; sb.x += bb.x; sb.y += bb.y; sb.z += bb.z; sb.w += bb.w;
        }
        const float ic = 1.f / (float)cnt;
        f32x4 o0 = {sa.x * ic - ua.x, sa.y * ic - ua.y, sa.z * ic - ua.z, sa.w * ic - ua.w}, o1 = {sb.x * ic - ub.x, sb.y * ic - ub.y, sb.z * ic - ub.z, sb.w * ic - ub.w};
        st8h(DY + (size_t)row * D + c, o0, o1);
    }
}

__device__ __forceinline__ void pool_diff_old(const f16* U, f16* DY) {
    const size_t total = (size_t)MREAL * 1024, stride = (size_t)gridDim.x * NTHREADS;
    for (size_t i = (size_t)obid() * NTHREADS + otid(); i < total; i += stride) {
        const int row = (int)(i >> 10), c = (int)(i & 1023);
        const int b = row < MMAIN ? row >> 11 : 0, t = row < MMAIN ? (row & 2047) + NMETA : row - MMAIN;
        const int win = 2 << (c >> 8);
        const int cnt = (t + 1) < win ? (t + 1) : win;
        float s = 0.f;
        for (int j = 0; j < cnt; ++j) s += (float)U[(size_t)row_of(b, t - j) * D + c];
        DY[(size_t)row * D + c] = (f16)(s / (float)cnt - (float)U[(size_t)row * D + c]);
    }
}

__device__ __forceinline__ float gelu_tanh(float x) {
    const float k0 = 0.7978845608028654f, k1 = 0.044715f;
    return 0.5f * x * (1.f + tanhf(k0 * (x + k1 * x * x * x)));
}

typedef _Float16 f16x8 __attribute__((ext_vector_type(8)));
constexpr int SSM_WAVE_LDS = 128 * 20 * 4 + 16 * 136 * 2;
constexpr int SSM_CARRY_OFF = 8 * SSM_WAVE_LDS;
__device__ __forceinline__ void ssm_phase(const Params& p, const f16* U, f16* DY, LAS unsigned char* lds) {
    const int tid_ = otid(), lane = tid_ & 63, wv = __builtin_amdgcn_readfirstlane(tid_ >> 6), l15 = lane & 15, g2 = lane >> 4;
    LAS float* BUT = (LAS float*)(lds + wv * SSM_WAVE_LDS);
    LAS f16* HT = (LAS f16*)(lds + wv * SSM_WAVE_LDS + 128 * 20 * 4);
    typedef float f32x2_t __attribute__((ext_vector_type(2)));
    LAS f32x2_t* CARRY = (LAS f32x2_t*)(lds + SSM_CARRY_OFF);
    for (int item = obid(); item < 256; item += gridDim.x) {
        const int b = item >> 6, g = item & 63, n = lane;
        const float dt = expf(p.in[I_LOGDT][g]);
        const float ar = p.in[I_LRE][g * 64 + n], ai = p.in[I_LIM][g * 64 + n];
        float are, aim, pw0r, pw0i, pw1r, pw1i;
        { const float mag = expf(dt * ar); double sd, cd; sincos_d((double)(dt * ai), sd, cd); are = mag * (float)cd; aim = mag * (float)sd; }
        { const float mag = expf(272.f * dt * ar); double sd, cd; sincos_d(272.0 * (double)(dt * ai), sd, cd); pw0r = mag * (float)cd; pw0i = mag * (float)sd; }
        { const float mag = expf(256.f * dt * ar); double sd, cd; sincos_d(256.0 * (double)(dt * ai), sd, cd); pw1r = mag * (float)cd; pw1i = mag * (float)sd; }
        {
            const float den = ar * ar + ai * ai, zr = are - 1.f, zi = aim;
            const float fre = (zr * ar + zi * ai) / (den * dt), fim = (zi * ar - zr * ai) / (den * dt);
            LAS f16* TB = (LAS f16*)BUT;
#pragma unroll
            for (int c = 0; c < 16; ++c) {
                const float br = p.in[I_BRE][(g * 64 + n) * 16 + c], bi = p.in[I_BIM][(g * 64 + n) * 16 + c];
                TB[n * 16 + c] = (f16)(fre * br - fim * bi); TB[(64 + n) * 16 + c] = (f16)(fre * bi + fim * br);
            }
        }
        asm volatile("" ::: "memory");
        f16x8 bbf[8];
#pragma unroll
        for (int nt = 0; nt < 8; ++nt) {
            const f16x8 z = {0, 0, 0, 0, 0, 0, 0, 0};
            bbf[nt] = (g2 < 2) ? *(const LAS f16x8*)((const LAS f16*)BUT + (16 * nt + l15) * 16 + 8 * g2) : z;
        }
        asm volatile("" ::: "memory");
        f16x8 cf[4];
#pragma unroll
        for (int ks = 0; ks < 4; ++ks) {
            const int k = 32 * ks + 8 * g2;
            const float* src = (k < 64) ? (p.in[I_CRE] + (g * 16 + l15) * 64 + k) : (p.in[I_CIM] + (g * 16 + l15) * 64 + (k - 64));
            const float sg = (k < 64) ? 1.f : -1.f;
            const float4 x0 = ld4(src), x1 = ld4(src + 4);
            f16x8 v; v[0] = (f16)(sg * x0.x); v[1] = (f16)(sg * x0.y); v[2] = (f16)(sg * x0.z); v[3] = (f16)(sg * x0.w); v[4] = (f16)(sg * x1.x); v[5] = (f16)(sg * x1.y); v[6] = (f16)(sg * x1.z); v[7] = (f16)(sg * x1.w);
            cf[ks] = v;
        }
        float dd[4];
#pragma unroll
        for (int j = 0; j < 4; ++j) dd[j] = p.in[I_S5D][g * 16 + 4 * g2 + j];
        const int blk0 = (wv == 0) ? 0 : 17 + 16 * (wv - 1), nblk = (wv == 0) ? 17 : 16;
        float hr = 0.f, hi = 0.f;
#pragma unroll 1
        for (int pass = 0; pass < 2; ++pass) {
            if (pass == 1) {
                CARRY[wv * 64 + n] = (f32x2_t){hr, hi};
                __syncthreads();
                float cr = 0.f, ci = 0.f;
                for (int j = 0; j < wv; ++j) {
                    const f32x2_t e = CARRY[j * 64 + n]; const float pr = (j == 0) ? pw0r : pw1r, pi = (j == 0) ? pw0i : pw1i;
                    const float nr = pr * cr - pi * ci + e.x, ni = pr * ci + pi * cr + e.y; cr = nr; ci = ni;
                }
                hr = cr; hi = ci;
                __syncthreads();
            }
#pragma unroll 1
            for (int kb = 0; kb < nblk; ++kb) {
                const int t0 = (blk0 + kb) * 16;
                const int rowa = row_of(b, t0 + l15);
                f16x8 ua = {0, 0, 0, 0, 0, 0, 0, 0};
                if (g2 < 2) ua = *(const f16x8*)(U + (size_t)rowa * D + 1024 + g * 16 + 8 * g2);
                f32x4 bacc[8];
#pragma unroll
                for (int nt = 0; nt < 8; ++nt) bacc[nt] = __builtin_amdgcn_mfma_f32_16x16x32_f16(ua, bbf[nt], (f32x4){0.f, 0.f, 0.f, 0.f}, 0, 0, 0);
                __builtin_amdgcn_sched_barrier(0);
                asm volatile("s_nop 15\n\ts_nop 15" ::: "memory");
                __builtin_amdgcn_sched_barrier(0);
#pragma unroll
                for (int nt = 0; nt < 8; ++nt) *(LAS f32x4*)(BUT + (16 * nt + l15) * 20 + 4 * g2) = bacc[nt];
                asm volatile("" ::: "memory");
                float bre[16], bim[16];
#pragma unroll
                for (int q4 = 0; q4 < 4; ++q4) {
                    const f32x4 x = *(const LAS f32x4*)(BUT + n * 20 + 4 * q4), y = *(const LAS f32x4*)(BUT + (64 + n) * 20 + 4 * q4);
                    bre[4 * q4] = x[0]; bre[4 * q4 + 1] = x[1]; bre[4 * q4 + 2] = x[2]; bre[4 * q4 + 3] = x[3];
                    bim[4 * q4] = y[0]; bim[4 * q4 + 1] = y[1]; bim[4 * q4 + 2] = y[2]; bim[4 * q4 + 3] = y[3];
                }
#pragma unroll
                for (int tt = 0; tt < 16; ++tt) {
                    const float nr = fmaf(are, hr, fmaf(-aim, hi, bre[tt])), ni = fmaf(are, hi, fmaf(aim, hr, bim[tt]));
                    hr = nr; hi = ni;
                    if (pass == 1) { HT[tt * 136 + n] = (f16)hr; HT[tt * 136 + 64 + n] = (f16)hi; }
                }
                asm volatile("" ::: "memory");
                if (pass == 1) {
                    f32x4 ya = {0.f, 0.f, 0.f, 0.f};
#pragma unroll
                    for (int ks = 0; ks < 4; ++ks) {
                        const f16x8 hb = *(const LAS f16x8*)(HT + l15 * 136 + 32 * ks + 8 * g2);
                        ya = __builtin_amdgcn_mfma_f32_16x16x32_f16(cf[ks], hb, ya, 0, 0, 0);
                    }
                    __builtin_amdgcn_sched_barrier(0);
                    asm volatile("s_nop 15\n\ts_nop 15" ::: "memory");
                    __builtin_amdgcn_sched_barrier(0);
                    if (t0 >= NMETA || b == 0) {
                        const float4 uu = ld4(U + (size_t)rowa * D + 1024 + g * 16 + 4 * g2);
                        const float4 o = make_float4(gelu_tanh(dt * ya[0] + dd[0] * uu.x), gelu_tanh(dt * ya[1] + dd[1] * uu.y), gelu_tanh(dt * ya[2] + dd[2] * uu.z), gelu_tanh(dt * ya[3] + dd[3] * uu.w));
                        st4h(DY + (size_t)rowa * D + 1024 + g * 16 + 4 * g2, o);
                    }
                }
            }
        }
        __syncthreads();
    }
}

__device__ __forceinline__ void ssm_naive(const Params& p, const f16* U, f16* DY) {
    const int tid_ = otid(), lane = tid_ & 63, gw = obid() * (NTHREADS / 64) + (tid_ >> 6), ngw = gridDim.x * (NTHREADS / 64);
    for (int item = gw; item < 256; item += ngw) {
        const int b = item >> 6, g = item & 63, n = lane;
        const float dt = expf(p.in[I_LOGDT][g]);
        const float ar = p.in[I_LRE][g * 64 + n], ai = p.in[I_LIM][g * 64 + n];
        const float mag = expf(dt * ar); double sd, cd; sincos_d((double)(dt * ai), sd, cd); const float sn = (float)sd, cs = (float)cd;
        const float are = mag * cs, aim = mag * sn;
        const float den = ar * ar + ai * ai, zr = are - 1.f, zi = aim;
        const float fre = (zr * ar + zi * ai) / den, fim = (zi * ar - zr * ai) / den;
        float bbr[16], bbi[16], cr[16], ci[16];
#pragma unroll
        for (int c = 0; c < 16; ++c) {
            const float br = p.in[I_BRE][(g * 64 + n) * 16 + c], bi = p.in[I_BIM][(g * 64 + n) * 16 + c];
            bbr[c] = fre * br - fim * bi; bbi[c] = fre * bi + fim * br;
            cr[c] = p.in[I_CRE][(g * 16 + c) * 64 + n]; ci[c] = p.in[I_CIM][(g * 16 + c) * 64 + n];
        }
        const float dd = p.in[I_S5D][g * 16 + (lane & 15)];
        float hr = 0.f, hi = 0.f;
#pragma unroll 1
        for (int t = 0; t < T; ++t) {
            const int row = row_of(b, t);
            const f16* ur = U + (size_t)row * D + 1024 + g * 16;
            const float4 u0 = ld4(ur), u1 = ld4(ur + 4), u2 = ld4(ur + 8), u3 = ld4(ur + 12);
            const float uu[16] = {u0.x, u0.y, u0.z, u0.w, u1.x, u1.y, u1.z, u1.w, u2.x, u2.y, u2.z, u2.w, u3.x, u3.y, u3.z, u3.w};
            float bur = 0.f, bui = 0.f;
#pragma unroll
            for (int c = 0; c < 16; ++c) { bur = fmaf(bbr[c], uu[c], bur); bui = fmaf(bbi[c], uu[c], bui); }
            const float nhr = are * hr - aim * hi + bur, nhi = are * hi + aim * hr + bui;
            hr = nhr; hi = nhi;
            float myy = 0.f;
#pragma unroll
            for (int c = 0; c < 16; ++c) { const float v = wave_sum(cr[c] * hr - ci[c] * hi); if (lane == c) myy = v; }
            if (lane < 16 && (t >= NMETA || b == 0)) {
                const float y = myy + dd * (float)ur[lane];
                DY[(size_t)row * D + 1024 + g * 16 + lane] = (f16)gelu_tanh(y);
            }
        }
    }
}

__device__ __forceinline__ void build_rope(float2* R16, float2* R8) {
    const int total = T * 16, stride = (int)gridDim.x * NTHREADS;
    for (int i = obid() * NTHREADS + otid(); i < total; i += stride) {
        const int t = i >> 4, idx = i & 15;
        const float ang = (float)t * rope_inv16(idx);
        double sd, cd; sincos_d((double)ang, sd, cd);
        const float2 v = make_float2((float)cd, (float)sd);
        R16[i] = v; if ((idx & 1) == 0) R8[t * 8 + (idx >> 1)] = v;
    }
}
__device__ __forceinline__ void zero_kv_pads(f16* K16, f16* V16, f16* KI16) {
    const int per_b = (TP - T) * (512 + 512 + 64) / 8, total = 4 * per_b, stride = (int)gridDim.x * NTHREADS;
    for (int i = obid() * NTHREADS + otid(); i < total; i += stride) {
        const int b = i / per_b, r = i % per_b; const u32x4 z = {0u, 0u, 0u, 0u};
        if (r < (TP - T) * 64) *(u32x4*)(K16 + ((size_t)b * TP + T) * 512 + (size_t)r * 8) = z;
        else if (r < (TP - T) * 128) *(u32x4*)(V16 + ((size_t)b * TP + T) * 512 + (size_t)(r - (TP - T) * 64) * 8) = z;
        else *(u32x4*)(KI16 + ((size_t)b * TP + T) * 64 + (size_t)(r - (TP - T) * 128) * 8) = z;
    }
}
struct CinOut { f16* Q16; f16* K16; f16* V16; f16* QI16; f16* KI16; float* WI; const float2* R16; const float2* R8; };
__device__ __forceinline__ void rope_lanes(f32x4& v0, f32x4& v1, const float2* tab, int xr, bool active, bool second) {
    const float4 t0 = *(const float4*)(tab), t1 = *(const float4*)(tab + 2), t2 = *(const float4*)(tab + 4), t3 = *(const float4*)(tab + 6);
    const float cs[8] = {t0.x, t0.z, t1.x, t1.z, t2.x, t2.z, t3.x, t3.z}, sn[8] = {t0.y, t0.w, t1.y, t1.w, t2.y, t2.w, t3.y, t3.w};
    const float sg = second ? 1.f : -1.f;
#pragma unroll
    for (int e = 0; e < 4; ++e) {
        const float o0 = __shfl_xor(v0[e], xr), o1 = __shfl_xor(v1[e], xr);
        if (active) { v0[e] = v0[e] * cs[e] + sg * o0 * sn[e]; v1[e] = v1[e] * cs[4 + e] + sg * o1 * sn[4 + e]; }
    }
}
__device__ __forceinline__ void cin_epilogue(const CinOut& o, int r, int c, f32x4 v0, f32x4 v1) {
    const int fq = (threadIdx.x & 63) >> 4, cb = c & ~31;
    const bool valid = r < MREAL, mainrow = r < MMAIN;
    const int t = mainrow ? (r & 2047) + NMETA : (valid ? r - MMAIN : 0), b = r >> 11;
    if (cb < 2560) {
        if ((cb & 127) == 0) rope_lanes(v0, v1, o.R16 + t * 16 + 8 * (fq & 1), 32, true, fq >= 2);
        if (cb < 2048) { if (mainrow) st8h(o.Q16 + (size_t)r * D + c, v0, v1); }
        else if (mainrow) st8h(o.K16 + ((size_t)b * TP + t) * 512 + (c - 2048), v0, v1);
        else if (valid) { for (int bb = 0; bb < 4; ++bb) st8h(o.K16 + ((size_t)bb * TP + t) * 512 + (c - 2048), v0, v1); }
    } else if (cb < 3072) {
        if (mainrow) st8h(o.V16 + ((size_t)b * TP + t) * 512 + (c - 2560), v0, v1);
        else if (valid) { for (int bb = 0; bb < 4; ++bb) st8h(o.V16 + ((size_t)bb * TP + t) * 512 + (c - 2560), v0, v1); }
    } else if (cb < 4096) {
        if ((cb & 63) == 0) rope_lanes(v0, v1, o.R8 + t * 8, 16, fq < 2, fq == 1);
        if (mainrow) st8h(o.QI16 + (size_t)r * 1024 + (c - 3072), v0, v1);
    } else if (cb < 4160) {
        if (cb == 4096) rope_lanes(v0, v1, o.R8 + t * 8, 16, fq < 2, fq == 1);
        if (mainrow) st8h(o.KI16 + ((size_t)b * TP + t) * 64 + (c - 4096), v0, v1);
        else if (valid) { for (int bb = 0; bb < 4; ++bb) st8h(o.KI16 + ((size_t)bb * TP + t) * 64 + (c - 4096), v0, v1); }
    } else if (c < CIN) {
        if (mainrow) { float* w = o.WI + (size_t)r * 16 + (c - 4160); *(f32x4*)w = v0 * 0.03125f; *(f32x4*)(w + 4) = v1 * 0.03125f; }
    }
}

__device__ __forceinline__ void idx_scores(const f16* QI16, const f16* KI16, const float* WI, float* SCORE) {
    const int tid_ = otid(), lane = tid_ & 63, gw = obid() * (NTHREADS / 64) + (tid_ >> 6), ngw = gridDim.x * (NTHREADS / 64);
    for (int q = gw; q < MMAIN; q += ngw) {
        const int b = q >> 11, s = q & 2047, nall = 80 + 64 * (s >> 6);
        const f16* qi = QI16 + (size_t)q * 1024;
        const float* wi = WI + (size_t)q * 16;
        for (int t = lane; t < nall; t += 64) {
            const f16* kp = KI16 + ((size_t)b * TP + t) * 64;
            float4 kv[16];
#pragma unroll
            for (int j = 0; j < 16; ++j) kv[j] = ld4(kp + 4 * j);
            float score = 0.f;
#pragma unroll 1
            for (int h = 0; h < 16; ++h) {
                float dot = 0.f;
#pragma unroll
                for (int j = 0; j < 16; ++j) { const float4 qv = ld4(qi + h * 64 + 4 * j); dot += qv.x * kv[j].x + qv.y * kv[j].y + qv.z * kv[j].z + qv.w * kv[j].w; }
                score += wi[h] * fmaxf(dot, 0.f);
            }
            SCORE[(size_t)q * SROW + t] = score;
        }
    }
}

__device__ __forceinline__ unsigned okey(float f) { const unsigned u = __float_as_uint(f); return (u & 0x80000000u) ? ~u : (u | 0x80000000u); }
__device__ __forceinline__ void select_topk(const float* SCORE, unsigned long long* MASK) {
    const int tid_ = otid(), lane = tid_ & 63, gw = obid() * (NTHREADS / 64) + (tid_ >> 6), ngw = gridDim.x * (NTHREADS / 64);
    for (int q = gw; q < MMAIN; q += ngw) {
        const int s = q & 2047, nall = 80 + 64 * (s >> 6);
        unsigned key[33];
#pragma unroll
        for (int i = 0; i < 33; ++i) { const int t = 64 * i + lane; key[i] = (t < nall) ? okey(SCORE[(size_t)q * SROW + t]) : 0u; }
        unsigned long long mymask = 0ull;
        if (nall <= 256) {
#pragma unroll
            for (int i = 0; i < 33; ++i) { const unsigned long long m = __ballot(64 * i + lane < nall); if (lane == i) mymask = m; }
        } else {
            unsigned tau = 0u;
#pragma unroll 1
            for (int bit = 31; bit >= 0; --bit) {
                const unsigned cand = tau | (1u << bit); int cnt = 0;
#pragma unroll
                for (int i = 0; i < 33; ++i) cnt += __popcll(__ballot(key[i] >= cand));
                if (cnt >= 256) tau = cand;
            }
            int ngt = 0;
#pragma unroll
            for (int i = 0; i < 33; ++i) ngt += __popcll(__ballot(key[i] > tau));
            const int need = 256 - ngt; int eqb = 0;
            const unsigned long long lt = (1ull << lane) - 1ull;
#pragma unroll
            for (int i = 0; i < 33; ++i) {
                const unsigned long long gm = __ballot(key[i] > tau), em = __ballot(key[i] == tau);
                const int rank = eqb + __popcll(em & lt);
                const unsigned long long sm = __ballot(key[i] == tau && rank < need);
                if (lane == i) mymask = gm | sm;
                eqb += __popcll(em);
            }
        }
        if (lane < 33) MASK[(size_t)q * 33 + lane] = mymask;
    }
}

constexpr int IDX_WAVE_LDS = 2 * TP * 4;
__device__ __forceinline__ unsigned long long select_row(const LAS float* srow, int nall, int lane) {
    unsigned key[33];
#pragma unroll
    for (int i = 0; i < 33; ++i) { const int t = 64 * i + lane; key[i] = (t < nall) ? okey(srow[t]) : 0u; }
    unsigned long long mymask = 0ull;
    unsigned tau = 0u;
#pragma unroll 1
    for (int bit = 31; bit >= 0; --bit) {
        const unsigned cand = tau | (1u << bit); int cnt = 0;
#pragma unroll
        for (int i = 0; i < 33; ++i) cnt += __popcll(__ballot(key[i] >= cand));
        if (cnt >= 256) tau = cand;
    }
    int ngt = 0;
#pragma unroll
    for (int i = 0; i < 33; ++i) ngt += __popcll(__ballot(key[i] > tau));
    const int need = 256 - ngt; int eqb = 0;
    const unsigned long long lt = (1ull << lane) - 1ull;
#pragma unroll
    for (int i = 0; i < 33; ++i) {
        const unsigned long long gm = __ballot(key[i] > tau), em = __ballot(key[i] == tau);
        const int rank = eqb + __popcll(em & lt);
        const unsigned long long sm = __ballot(key[i] == tau && rank < need);
        if (lane == i) mymask = gm | sm;
        eqb += __popcll(em);
    }
    return mymask;
}
__device__ __forceinline__ void index_select(const f16* QI16, const f16* KI16, const float* WI, unsigned long long* MASK, LAS unsigned char* lds) {
    const int tid_ = otid(), lane = tid_ & 63, wv = __builtin_amdgcn_readfirstlane(tid_ >> 6), l15 = lane & 15, g2 = lane >> 4;
    const int gw = obid() * (NTHREADS / 64) + wv;
    LAS float* SL = (LAS float*)(lds + wv * IDX_WAVE_LDS);
    if (gw >= 2048) return;
    const int b = gw >> 9, wq = gw & 511;
#pragma unroll 1
    for (int it = 0; it < 2; ++it) {
        const int u = (it == 0) ? wq : 1023 - wq, s0 = 2 * u, q0 = b * SEQ + s0, nall = 80 + 64 * (s0 >> 6);
        if (nall <= 256) {
            if (lane < 33) { const int lo = 64 * lane; const unsigned long long m = (nall >= lo + 64) ? ~0ull : (nall > lo ? ((1ull << (nall - lo)) - 1ull) : 0ull);
                MASK[(size_t)q0 * 33 + lane] = m; MASK[(size_t)(q0 + 1) * 33 + lane] = m; }
            continue;
        }
        f16x8 a[2][2]; float w[2][4];
#pragma unroll
        for (int qq = 0; qq < 2; ++qq) {
#pragma unroll
            for (int ks = 0; ks < 2; ++ks) a[qq][ks] = *(const f16x8*)(QI16 + (size_t)(q0 + qq) * 1024 + l15 * 64 + 32 * ks + 8 * g2);
            const float4 ww = ld4(WI + (size_t)(q0 + qq) * 16 + 4 * g2); w[qq][0] = ww.x; w[qq][1] = ww.y; w[qq][2] = ww.z; w[qq][3] = ww.w;
        }
        const int nkb = nall >> 4;
        const f16* kbase = KI16 + (size_t)b * TP * 64 + l15 * 64 + 8 * g2;
#pragma unroll 1
        for (int kb = 0; kb < nkb; kb += 2) {
            f16x8 bf[2][2];
#pragma unroll
            for (int e = 0; e < 2; ++e)
#pragma unroll
                for (int ks = 0; ks < 2; ++ks) bf[e][ks] = *(const f16x8*)(kbase + (size_t)(kb + e) * 16 * 64 + 32 * ks);
            f32x4 acc[2][2];
#pragma unroll
            for (int e = 0; e < 2; ++e)
#pragma unroll
                for (int qq = 0; qq < 2; ++qq) {
                    acc[e][qq] = __builtin_amdgcn_mfma_f32_16x16x32_f16(a[qq][0], bf[e][0], (f32x4){0.f, 0.f, 0.f, 0.f}, 0, 0, 0);
                    acc[e][qq] = __builtin_amdgcn_mfma_f32_16x16x32_f16(a[qq][1], bf[e][1], acc[e][qq], 0, 0, 0);
                }
            __builtin_amdgcn_sched_barrier(0);
            asm volatile("s_nop 15\n\ts_nop 15" ::: "memory");
            __builtin_amdgcn_sched_barrier(0);
#pragma unroll
            for (int e = 0; e < 2; ++e)
#pragma unroll
                for (int qq = 0; qq < 2; ++qq) {
                    const f32x4 c = acc[e][qq];
                    float sc = w[qq][0] * fmaxf(c[0], 0.f) + w[qq][1] * fmaxf(c[1], 0.f) + w[qq][2] * fmaxf(c[2], 0.f) + w[qq][3] * fmaxf(c[3], 0.f);
                    sc += __shfl_xor(sc, 16); sc += __shfl_xor(sc, 32);
                    if (g2 == 0) SL[qq * TP + (kb + e) * 16 + l15] = sc;
                }
        }
        asm volatile("" ::: "memory");
#pragma unroll 1
        for (int qq = 0; qq < 2; ++qq) {
            const unsigned long long m = select_row(SL + qq * TP, nall, lane);
            if (lane < 33) MASK[(size_t)(q0 + qq) * 33 + lane] = m;
        }
        asm volatile("" ::: "memory");
    }
}

__device__ __forceinline__ void attn_naive(float* lds, const f16* Q16, const f16* K16, const f16* V16, const unsigned long long* MASK, f16* O) {
    const int tid_ = otid(), lane = tid_ & 63, wv = tid_ >> 6, gw = obid() * (NTHREADS / 64) + wv, ngw = gridDim.x * (NTHREADS / 64);
    int* list = (int*)(lds + wv * 640);
    float* pl = lds + wv * 640 + 256;
    float* ql = lds + wv * 640 + 512;
    for (int item = gw; item < MMAIN * 16; item += ngw) {
        const int q = item >> 4, hq = item & 15, b = q >> 11, kvh = hq >> 2;
        int base = 0;
        for (int i = 0; i < 33; ++i) {
            const unsigned long long w = MASK[(size_t)q * 33 + i];
            if ((w >> lane) & 1ull) list[base + __popcll(w & ((1ull << lane) - 1ull))] = 64 * i + lane;
            base += __popcll(w);
        }
        const int nk = base;
        const f16* qp = Q16 + (size_t)q * D + hq * 128;
        ql[lane] = (float)qp[lane]; ql[64 + lane] = (float)qp[64 + lane];
        __builtin_amdgcn_s_waitcnt(0); __builtin_amdgcn_wave_barrier();
        float lg[4]; float mx = -INFINITY;
#pragma unroll
        for (int j = 0; j < 4; ++j) {
            const int kk = lane + 64 * j; lg[j] = -INFINITY;
            if (kk < nk) {
                const f16* kp = K16 + ((size_t)b * TP + list[kk]) * 512 + kvh * 128;
                float dot = 0.f;
#pragma unroll 4
                for (int d = 0; d < 128; d += 4) { const float4 kv = ld4(kp + d); dot += kv.x * ql[d] + kv.y * ql[d + 1] + kv.z * ql[d + 2] + kv.w * ql[d + 3]; }
                lg[j] = dot * 0.08838834764831845f;
            }
            mx = fmaxf(mx, lg[j]);
        }
        mx = wave_max(mx);
        float sm = 0.f;
#pragma unroll
        for (int j = 0; j < 4; ++j) { const int kk = lane + 64 * j; const float e = (kk < nk) ? expf(lg[j] - mx) : 0.f; sm += e; pl[kk] = e; }
        sm = wave_sum(sm);
        __builtin_amdgcn_s_waitcnt(0); __builtin_amdgcn_wave_barrier();
        float o0 = 0.f, o1 = 0.f;
#pragma unroll 2
        for (int kk = 0; kk < nk; ++kk) {
            const f16* vp = V16 + ((size_t)b * TP + list[kk]) * 512 + kvh * 128;
            const float pw = pl[kk];
            o0 = fmaf(pw, (float)vp[lane], o0); o1 = fmaf(pw, (float)vp[64 + lane], o1);
        }
        const float inv = 1.f / sm;
        O[(size_t)q * D + hq * 128 + lane] = (f16)(o0 * inv); O[(size_t)q * D + hq * 128 + 64 + lane] = (f16)(o1 * inv);
        __builtin_amdgcn_s_waitcnt(0); __builtin_amdgcn_wave_barrier();
    }
}

namespace att {
typedef short s16x4 __attribute__((ext_vector_type(4)));
typedef short s16x8 __attribute__((ext_vector_type(8)));
typedef float f32x16 __attribute__((ext_vector_type(16)));
typedef unsigned long long u64;
constexpr int NW = 8, QBLK = 32, KVBLK = 64, QS = 2048, KS = 512;
constexpr int SHM_V = KVBLK * 128 * 2, SHM_K = KVBLK * 128 * 2;
constexpr int LDS_BYTES = 2 * SHM_V + 2 * SHM_K + NW * 64 * 4;
constexpr float SCALE = 0.08838834764831845f, THR = 8.f;
#define AT_KSWZ(row, colB) ((row) * 256 + ((colB) ^ (((row) & 7) << 4)))
#define AT_SBAR() __builtin_amdgcn_sched_barrier(0)
__device__ __forceinline__ int v_st(int k, int c) { const int kk = (k & ~0xC) | ((k & 4) << 1) | ((k & 8) >> 1); return ((kk >> 3) * 4 + (c >> 5)) * 512 + ((kk & 7) * 32 + (c & 31)) * 2; }
__device__ __forceinline__ int v_rd_base(int lane) { return ((lane & 3) << 3) | (((lane >> 2) & 3) << 6) | (((lane >> 4) & 1) << 5) | (((lane >> 5) & 1) << 8); }
constexpr int v_rd_off(int d0, int ks, int half) { return d0 * 512 + ks * 4096 + half * 2048; }
__device__ __forceinline__ int crow(int r, int hi) { return (r & 3) + 8 * (r >> 2) + 4 * hi; }
__device__ __forceinline__ f16x8 load8(const f16* p) { return *(const f16x8*)p; }
__device__ __forceinline__ void mask_bits(f32x16& p0, f32x16& p1, u64 w, int hi) {
    const float NEG = -__builtin_inff();
    const unsigned lo = (unsigned)w >> (4 * hi), up = (unsigned)(w >> 32) >> (4 * hi);
#pragma unroll
    for (int r = 0; r < 16; ++r) {
        const int c = (r & 3) + 8 * (r >> 2);
        if (!((lo >> c) & 1u)) p0[r] = NEG;
        if (!((up >> c) & 1u)) p1[r] = NEG;
    }
}
__device__ __forceinline__ void partialSM(f32x16& p0, f32x16& p1, float& m_reg, float& mn, float& alpha) {
    float pmax = p0[0];
#pragma unroll
    for (int r = 1; r < 16; ++r) pmax = fmaxf(pmax, p0[r]);
#pragma unroll
    for (int r = 0; r < 16; ++r) pmax = fmaxf(pmax, p1[r]);
    { auto rr = __builtin_amdgcn_permlane32_swap(__float_as_uint(pmax), __float_as_uint(pmax), false, false);
      pmax = fmaxf(__uint_as_float(rr[0]), __uint_as_float(rr[1])); }
    constexpr float C2 = 1.4426950408889634f * SCALE;
    if (__builtin_expect(__all((pmax - m_reg) * SCALE <= THR), 1)) { mn = m_reg; alpha = 1.f; }
    else { mn = fmaxf(m_reg, pmax); alpha = __builtin_amdgcn_exp2f((m_reg - mn) * C2); m_reg = mn; }
    const float mnL = -mn * C2;
#pragma unroll
    for (int r = 0; r < 16; ++r) p0[r] = fmaf(p0[r], C2, mnL);
#pragma unroll
    for (int r = 0; r < 16; ++r) p1[r] = fmaf(p1[r], C2, mnL);
#pragma unroll
    for (int r = 0; r < 16; ++r) p0[r] = __builtin_amdgcn_exp2f(p0[r]);
}
__device__ __forceinline__ void finishSM(f32x16& p0, f32x16& p1, float alpha, float& l_reg, f16x8& pa0, f16x8& pa1, f16x8& pa2, f16x8& pa3) {
#pragma unroll
    for (int r = 0; r < 16; ++r) p1[r] = __builtin_amdgcn_exp2f(p1[r]);
    float ps = 0;
#pragma unroll
    for (int r = 0; r < 16; ++r) ps += p0[r];
#pragma unroll
    for (int r = 0; r < 16; ++r) ps += p1[r];
    { auto rr = __builtin_amdgcn_permlane32_swap(__float_as_uint(ps), __float_as_uint(ps), false, false);
      ps = __uint_as_float(rr[0]) + __uint_as_float(rr[1]); }
    l_reg = l_reg * alpha + ps;
#define AT_PK4(P, B_, OUT) do { unsigned a0 = pk2h(P[B_+0], P[B_+1]), a1 = pk2h(P[B_+2], P[B_+3]);                          \
        unsigned b0 = pk2h(P[B_+4], P[B_+5]), b1 = pk2h(P[B_+6], P[B_+7]);                                             \
        auto r0 = __builtin_amdgcn_permlane32_swap(a0, b0, false, false); auto r1 = __builtin_amdgcn_permlane32_swap(a1, b1, false, false); \
        u32x4 w_ = {r0[0], r1[0], r0[1], r1[1]}; OUT = __builtin_bit_cast(f16x8, w_); } while (0)
    AT_PK4(p0, 0, pa0); AT_PK4(p0, 8, pa1); AT_PK4(p1, 0, pa2); AT_PK4(p1, 8, pa3);
#undef AT_PK4
}
template <int KB>
__device__ __forceinline__ void qkt(f32x16& p0, f32x16& p1, LAS const unsigned char* K_lds, int r32, int hi, const f16x8* qr) {
    p0 = f32x16{}; p1 = f32x16{};
    LAS const unsigned char* kb[4];
#pragma unroll
    for (int dd = 0; dd < 4; ++dd) kb[dd] = K_lds + KB * SHM_K + AT_KSWZ(r32, (dd * 16 + hi * 8) * 2);
#pragma unroll
    for (int d0 = 0; d0 < 8; ++d0) { LAS const unsigned char* a = kb[d0 & 3] + (d0 >> 2) * 128;
        const f16x8 b0 = *(LAS const f16x8*)a;
        const f16x8 b1 = *(LAS const f16x8*)(a + 32 * 256);
        p0 = __builtin_amdgcn_mfma_f32_32x32x16_f16(b0, qr[d0], p0, 0, 0, 0);
        p1 = __builtin_amdgcn_mfma_f32_32x32x16_f16(b1, qr[d0], p1, 0, 0, 0); }
}
template <int VB>
__device__ __forceinline__ void pv_tile(f32x16* o, int vb0, f16x8 pa0, f16x8 pa1, f16x8 pa2, f16x8 pa3) {
#define AT_TRRD(dst, off) asm volatile("ds_read_b64_tr_b16 %0, %1 offset:%2" : "=&v"(dst) : "v"(vb0), "i"(off) : "memory")
#define AT_CAT(l, h) __builtin_bit_cast(f16x8, (s16x8){l[0], l[1], l[2], l[3], h[0], h[1], h[2], h[3]})
#define AT_PV_D0(d0) do { s16x4 l0, l1, l2, l3, h0, h1, h2, h3; constexpr int b_ = VB * SHM_V + v_rd_off(d0, 0, 0); \
        AT_TRRD(l0, b_); AT_TRRD(h0, b_ + 2048); AT_TRRD(l1, b_ + 4096); AT_TRRD(h1, b_ + 6144); AT_TRRD(l2, b_ + 8192); AT_TRRD(h2, b_ + 10240); AT_TRRD(l3, b_ + 12288); AT_TRRD(h3, b_ + 14336); \
        asm volatile("s_waitcnt lgkmcnt(0)" ::: "memory"); AT_SBAR();   \
        o[d0] = __builtin_amdgcn_mfma_f32_32x32x16_f16(pa0, AT_CAT(l0, h0), o[d0], 0, 0, 0);   \
        o[d0] = __builtin_amdgcn_mfma_f32_32x32x16_f16(pa1, AT_CAT(l1, h1), o[d0], 0, 0, 0);   \
        o[d0] = __builtin_amdgcn_mfma_f32_32x32x16_f16(pa2, AT_CAT(l2, h2), o[d0], 0, 0, 0);   \
        o[d0] = __builtin_amdgcn_mfma_f32_32x32x16_f16(pa3, AT_CAT(l3, h3), o[d0], 0, 0, 0); } while (0)
    AT_PV_D0(0); AT_PV_D0(1); AT_PV_D0(2); AT_PV_D0(3);
#undef AT_PV_D0
#undef AT_CAT
#undef AT_TRRD
}
struct BlockRef { const f16* Q; const f16* K; const f16* V; f16* O; const u64* M; int NT; };
struct Seam { f16x8 qr[8]; f16x8 st_v0, st_v1, st_k0, st_k1; };
#define AT_ROW(p, k0, rr) ((p) + (size_t)((k0) + (rr)) * KS + sc)
#define AT_VMW() asm volatile("s_waitcnt vmcnt(0)" ::: "memory")
#define AT_VMWN(n) asm volatile("s_waitcnt vmcnt(%0)" :: "i"(n) : "memory")
#define AT_SLOAD_H(Kp, Vp, k0) do { S.st_v0 = load8(AT_ROW(Vp, k0, sr)); S.st_v1 = load8(AT_ROW(Vp, k0, 32 + sr)); S.st_k0 = load8(AT_ROW(Kp, k0, sr)); S.st_k1 = load8(AT_ROW(Kp, k0, 32 + sr)); } while (0)
#define AT_SWRITE_HK(bf) do { *(LAS f16x8*)(K_lds + (bf) * SHM_K + kws) = S.st_k0; *(LAS f16x8*)(K_lds + (bf) * SHM_K + kws + 32 * 256) = S.st_k1; } while (0)
#define AT_SWRITE_HV(bf) do { *(LAS f16x8*)(V_lds + (bf) * SHM_V + vst0) = S.st_v0; *(LAS f16x8*)(V_lds + (bf) * SHM_V + vst1) = S.st_v1; } while (0)
#define AT_SWRITE_H(bf) do { AT_SWRITE_HV(bf); AT_SWRITE_HK(bf); } while (0)
__device__ __forceinline__ void prime(const BlockRef& cur, LAS unsigned char* lds, Seam& S) {
    const int tid = otid(), wid = __builtin_amdgcn_readfirstlane(tid >> 6), lane = tid & 63, r32 = lane & 31, hi = lane >> 5;
    const int sr = tid >> 4, sc = (tid & 15) * 8, kws = AT_KSWZ(sr, sc * 2); LAS unsigned char* K_lds = lds + 2 * SHM_V;
#pragma unroll
    for (int d0 = 0; d0 < 8; ++d0) S.qr[d0] = load8(cur.Q + (size_t)(wid * QBLK + r32) * QS + d0 * 16 + hi * 8);
    AT_SLOAD_H(cur.K, cur.V, 0); AT_VMW(); AT_SWRITE_HK(0);
    __syncthreads();
}
__device__ __forceinline__ void block(const BlockRef& cur, const BlockRef& nxt, LAS unsigned char* lds, Seam& S) {
    const int tid = otid(), wid = __builtin_amdgcn_readfirstlane(tid >> 6), lane = tid & 63, r32 = lane & 31, hi = lane >> 5;
    const int NT = cur.NT;
    LAS unsigned char* V_lds = lds; LAS unsigned char* K_lds = lds + 2 * SHM_V;
    LAS float* ws = (LAS float*)(lds + 2 * SHM_V + 2 * SHM_K) + wid * 64; LAS float* li_l = ws; LAS float* al_l = ws + 32;
    float m_reg = -1e30f, l_reg = 0; f32x16 o[4] = {};
    const int sr = tid >> 4, sc = (tid & 15) * 8, vst0 = v_st(sr, sc), vst1 = v_st(32 + sr, sc), kws = AT_KSWZ(sr, sc * 2);
    const int vb0 = (int)(unsigned)(size_t)V_lds + v_rd_base(lane);
    const f16* Kh = cur.K; const f16* Vh = cur.V;
    const u64* mrow = cur.M + (size_t)(wid * QBLK + r32) * 33;
    u64 mw;
#define AT_RESC(a) do { if (__any((a) < 1.f)) { if (hi == 0) al_l[r32] = (a); asm volatile("s_waitcnt lgkmcnt(0)" ::: "memory");              \
                     for (int d_ = 0; d_ < 4; ++d_) for (int r = 0; r < 16; ++r) o[d_][r] *= al_l[crow(r, hi)]; } } while (0)
#define AT_KBASE(t) ((t) * KVBLK)
#define AT_SEAM_K0() do { AT_VMWN(8); AT_SWRITE_HK(0); AT_SBAR(); } while (0)
    f32x16 pA0, pA1, pB0, pB1; float mnA, mnB, alA, alB; f16x8 pa0, pa1, pa2, pa3;
    AT_SWRITE_HV(0); AT_SBAR();
    mw = mrow[0];
    if (NT > 1) { AT_SLOAD_H(Kh, Vh, AT_KBASE(1)); }
    AT_SBAR(); qkt<0>(pA0, pA1, K_lds, r32, hi, S.qr);
    mask_bits(pA0, pA1, mw, hi); partialSM(pA0, pA1, m_reg, mnA, alA);
    if (NT > 1) { AT_VMW(); AT_SWRITE_H(1); }
    __syncthreads();
#define AT_HALF_STEP(PX0, PX1, mnX, alX, PY0, PY1, alY, t, KB, VB, SB) do {                                                      \
        AT_SBAR(); mw = mrow[(t)]; qkt<KB>(PX0, PX1, K_lds, r32, hi, S.qr);                                             \
        finishSM(PY0, PY1, alY, l_reg, pa0, pa1, pa2, pa3); AT_SBAR();                                                           \
        if ((t) + 1 < NT) { AT_SLOAD_H(Kh, Vh, AT_KBASE((t) + 1)); AT_SBAR(); }                                               \
        pv_tile<VB>(o, vb0, pa0, pa1, pa2, pa3); mask_bits(PX0, PX1, mw, hi); partialSM(PX0, PX1, m_reg, mnX, alX);                                        \
        __syncthreads();                                                                                                      \
        if ((t) + 1 < NT) { AT_VMW(); AT_SWRITE_H(SB); }                                                                          \
        AT_RESC(alX); __syncthreads(); } while (0)
    for (int t = 1; t + 1 < NT; t += 2) {
        AT_HALF_STEP(pB0, pB1, mnB, alB, pA0, pA1, alA, t, 1, 0, 0);
        AT_HALF_STEP(pA0, pA1, mnA, alA, pB0, pB1, alB, t + 1, 0, 1, 1);
    }
    const bool even = (NT & 1) == 0;
    if (even) { AT_SBAR(); mw = mrow[NT - 1]; qkt<1>(pB0, pB1, K_lds, r32, hi, S.qr); AT_SBAR(); }
    AT_SLOAD_H(nxt.K, nxt.V, 0); AT_SBAR();
#pragma unroll
    for (int d0 = 0; d0 < 8; ++d0) S.qr[d0] = load8(nxt.Q + (size_t)(wid * QBLK + r32) * QS + d0 * 16 + hi * 8);
    AT_SBAR();
    finishSM(pA0, pA1, alA, l_reg, pa0, pa1, pa2, pa3); AT_SBAR();
    pv_tile<0>(o, vb0, pa0, pa1, pa2, pa3);
    if (even) { mask_bits(pB0, pB1, mw, hi); partialSM(pB0, pB1, m_reg, mnB, alB); __syncthreads(); AT_RESC(alB);
        finishSM(pB0, pB1, alB, l_reg, pa0, pa1, pa2, pa3); AT_SBAR(); pv_tile<1>(o, vb0, pa0, pa1, pa2, pa3); }
    AT_SBAR(); AT_SEAM_K0();
    if (hi == 0) li_l[r32] = l_reg; asm volatile("s_waitcnt lgkmcnt(0)" ::: "memory");
    float rli[16];
#pragma unroll
    for (int r = 0; r < 16; ++r) rli[r] = __builtin_amdgcn_rcpf(li_l[crow(r, hi)]);
    f16* Ow = cur.O + (size_t)(wid * QBLK) * QS;
#pragma unroll
    for (int r = 0; r < 16; ++r) { const int orow = crow(r, hi);
#pragma unroll
        for (int d0 = 0; d0 < 4; ++d0) { const float v = o[d0][r] * rli[r];
            const float vn = __shfl_xor(v, 1);
            if ((r32 & 1) == 0) *(unsigned*)(Ow + (size_t)orow * QS + d0 * 32 + r32) = pk2h(v, vn); } }
    __syncthreads();
#undef AT_RESC
#undef AT_KBASE
#undef AT_SEAM_K0
#undef AT_HALF_STEP
}
#undef AT_ROW
#undef AT_VMW
#undef AT_VMWN
#undef AT_SLOAD_H
#undef AT_SWRITE_HK
#undef AT_SWRITE_HV
#undef AT_SWRITE_H
}
__device__ __forceinline__ att::BlockRef att_unit(const f16* Q16, const f16* K16, const f16* V16, const unsigned long long* MASK, f16* O16, int b, int h, int x) {
    att::BlockRef r; const size_t row0 = (size_t)b * SEQ + 256 * x; const int kvh = h >> 2;
    r.Q = Q16 + row0 * D + h * 128; r.K = K16 + (size_t)b * TP * 512 + kvh * 128; r.V = V16 + (size_t)b * TP * 512 + kvh * 128;
    r.O = O16 + row0 * D + h * 128; r.M = MASK + row0 * 33; r.NT = 4 * x + 5; return r;
}
__device__ __forceinline__ void attn_phase(LAS unsigned char* lds, const f16* Q16, const f16* K16, const f16* V16, const unsigned long long* MASK, f16* O16) {
    const int bid = obid();
    if (bid < 256) {
        const int xcd = bid & 7, j = bid >> 3, combo = xcd * 2 + (j & 1), item = j >> 1, hl = item >> 2, pp = item & 3;
        const int b = combo >> 2, kvh = combo & 3, h = kvh * 4 + hl;
        const att::BlockRef u0 = att_unit(Q16, K16, V16, MASK, O16, b, h, 7 - pp), u1 = att_unit(Q16, K16, V16, MASK, O16, b, h, pp);
        att::Seam S;
        att::prime(u0, lds, S);
        att::block(u0, u1, lds, S);
        att::block(u1, u1, lds, S);
    }
}

template <class F>
__device__ __forceinline__ void gemm(LAS unsigned char* lds, const f16* A, int lda, const f16* Bt, int ldb, int M, int N, int K, int cu, F f) {
    pg8::Gemm g{A, Bt, M, N, K, lda, ldb};
    pg8::StaticOrder S; S.init(M, N, (int)gridDim.x, cu);
    pg8::EpiRow8<F> E{f};
    pg8::gemm_phase<pg8::EpiRow8<F>, pg8::StaticOrder, true, true>(lds, g, S, E);
}

#define XB_TMO      128
#define XB_XCNT(j)  (256  + 64 * (j))
#define XB_XSUB(j)  (1280 + 64 * (j))
#define XB_XGEN(j)  (2304 + 64 * (j))
#define XB_TOP      3328
#define XB_TOPGEN   3392
#define XCD_BAR_WORDS 3456
#define XB_SPIN_CAP (1u << 18)

__device__ __forceinline__ unsigned xb_ld(unsigned* p)              { return __hip_atomic_load(p, __ATOMIC_RELAXED, __HIP_MEMORY_SCOPE_AGENT); }
__device__ __forceinline__ unsigned xb_add(unsigned* p, unsigned v) { return __hip_atomic_fetch_add(p, v, __ATOMIC_RELAXED, __HIP_MEMORY_SCOPE_AGENT); }
__device__ __forceinline__ unsigned xb_xcc_id() { return (unsigned)__builtin_amdgcn_s_getreg((3 << 11) | 20) & 0xFu; }
#define XB_SPIN(cond, bar) do { unsigned _sp = 0; while (cond) { __builtin_amdgcn_s_sleep(1); \
    if ((++_sp & 255u) == 0u) { if (xb_ld(&(bar)[XB_TMO])) break; if (_sp > XB_SPIN_CAP) { atomicAdd(&(bar)[XB_TMO], 1u); break; } } } } while (0)

struct XcdBarrier {
    unsigned* bar; unsigned x;
    volatile LAS unsigned* st;
};

__device__ __forceinline__ XcdBarrier xcd_barrier_post(unsigned* bar, volatile LAS unsigned* st) {
    XcdBarrier b; b.bar = bar; b.x = xb_xcc_id(); b.st = st;
    if (threadIdx.x == 0) (void)xb_add(&bar[XB_XCNT(b.x)], 1u);
    return b;
}
__device__ __forceinline__ void xcd_barrier_complete(unsigned* bar, unsigned x, unsigned& nloc, unsigned& nx) {
    const unsigned G = gridDim.x * gridDim.y * gridDim.z;
    unsigned sum, cnt, mine, sp = 0u;
    for (;;) {
        sum = 0u; cnt = 0u; mine = 0u;
#pragma unroll
        for (unsigned j = 0; j < 16; ++j) { const unsigned c = xb_ld(&bar[XB_XCNT(j)]); sum += c; cnt += (c > 0u) ? 1u : 0u; mine = (j == x) ? c : mine; }
        if (sum == G) break;
        __builtin_amdgcn_s_sleep(1);
        if ((++sp & 255u) == 0u) { if (xb_ld(&bar[XB_TMO])) break; if (sp > XB_SPIN_CAP) { atomicAdd(&bar[XB_TMO], 1u); break; } }
    }
    nloc = mine > 0u ? mine : 1u; nx = cnt > 0u ? cnt : 1u;
}

__device__ __forceinline__ void xcd_barrier(const XcdBarrier& b) {
    asm volatile("s_waitcnt vmcnt(0)" ::: "memory");
    __syncthreads();
    if (threadIdx.x == 0) {
        unsigned* bar = b.bar;
        __builtin_amdgcn_s_waitcnt(0);
        unsigned nloc = b.st[0], nx = b.st[1];
        if (nloc == 0u) { xcd_barrier_complete(bar, b.x, nloc, nx); b.st[0] = nloc; b.st[1] = nx; }
        const unsigned old = xb_add(&bar[XB_XSUB(b.x)], 1u);
        const unsigned gen = old / nloc;
        if (old + 1u == (gen + 1u) * nloc) {
            __builtin_amdgcn_fence(__ATOMIC_RELEASE, "agent");
            asm volatile("s_waitcnt vmcnt(0)" ::: "memory");
            const unsigned og = xb_add(&bar[XB_TOP], 1u);
            const unsigned tg = og / nx;
            if (og + 1u == (tg + 1u) * nx) xb_add(&bar[XB_TOPGEN], 1u);
            else XB_SPIN(xb_ld(&bar[XB_TOPGEN]) == tg, bar);
            __builtin_amdgcn_fence(__ATOMIC_ACQUIRE, "agent");
            xb_add(&bar[XB_XGEN(b.x)], 1u);
            asm volatile("s_waitcnt vmcnt(0)" ::: "memory");
        } else {
            XB_SPIN(xb_ld(&bar[XB_XGEN(b.x)]) == gen, bar);
            __builtin_amdgcn_fence(__ATOMIC_ACQUIRE, "agent");
            asm volatile("s_waitcnt vmcnt(0)" ::: "memory");
        }
    }
    __syncthreads();
}

__global__ void __launch_bounds__(NTHREADS, 2) fwd(Params p) {
    cg::grid_group grid = cg::this_grid();
    extern __shared__ __attribute__((aligned(16))) unsigned char smem[];
    LAS unsigned char* lds = (LAS unsigned char*)smem;
    float* ldsf = (float*)smem;
    unsigned char* ws = p.ws;
    float* H = (float*)(ws + OFF_H); f16* A16 = (f16*)(ws + OFF_A16); f16* U16 = (f16*)(ws + OFF_U16);
    f16* DY16 = (f16*)(ws + OFF_DY16); f16* CAT16 = (f16*)(ws + OFF_CAT16);
    f16* HID16 = (f16*)(ws + OFF_BIG);
    CinOut co{(f16*)(ws + OFF_Q16), (f16*)(ws + OFF_K16), (f16*)(ws + OFF_V16), (f16*)(ws + OFF_QI16), (f16*)(ws + OFF_KI16), (float*)(ws + OFF_WI), (const float2*)(ws + OFF_ROPE16), (const float2*)(ws + OFF_ROPE8)};
    float* SCORE = (float*)(ws + OFF_SCORE); unsigned long long* MASK = (unsigned long long*)(ws + OFF_MASK); f16* O16 = (f16*)(ws + OFF_O16);
    const float* ng = p.in[I_NORMG];
    const int bid = (int)blockIdx.x, G = (int)gridDim.x;
    volatile LAS unsigned* bst = (volatile LAS unsigned*)(lds + LDS_BYTES - 64);
    if (threadIdx.x < 16) bst[threadIdx.x] = 0u;
    __syncthreads();
    const XcdBarrier xbar = xcd_barrier_post((unsigned*)(ws + OFF_BAR), bst);

    convert_weights(p, ldsf);
    init_rows(p, H, A16);
    build_rope((float2*)(ws + OFF_ROPE16), (float2*)(ws + OFF_ROPE8));
    grid.sync();
    gemm(lds, A16, D, (const f16*)(ws + W_IN), D, MP, D, D, bid, [=](int r, int c, f32x4 v0, f32x4 v1) { st8h(U16 + (size_t)r * D + c, v0, v1); });
    xcd_barrier(xbar);
    pool_diff(U16, DY16);
    ssm_phase(p, U16, DY16, lds);
    xcd_barrier(xbar);
    for (int g = 0; g < 4; ++g) {
        const float* ps = p.in[I_POOLS] + g * 256;
        gemm(lds, DY16 + g * 256, D, (const f16*)(ws + W_POOL) + (size_t)g * 65536, 256, MP, 256, 256, (bid + G - 33 * g) % G,
             [=](int r, int c, f32x4 v0, f32x4 v1) { const f32x4 s0 = *(const f32x4*)(ps + c), s1 = *(const f32x4*)(ps + c + 4); st8h(CAT16 + (size_t)r * D + g * 256 + c, v0 * s0, v1 * s1); });
    }
    gemm(lds, DY16 + 1024, D, (const f16*)(ws + W_GLU), 1024, MP, 1024, 1024, (bid + G - 132) % G,
         [=](int r, int c, f32x4 v0, f32x4 v1) {
             const f16* yp = DY16 + (size_t)r * D + 1024 + c; const float4 y0 = ld4(yp), y1 = ld4(yp + 4);
             f32x4 o0, o1;
             o0[0] = y0.x / (1.f + __expf(-v0[0])); o0[1] = y0.y / (1.f + __expf(-v0[1])); o0[2] = y0.z / (1.f + __expf(-v0[2])); o0[3] = y0.w / (1.f + __expf(-v0[3]));
             o1[0] = y1.x / (1.f + __expf(-v1[0])); o1[1] = y1.y / (1.f + __expf(-v1[1])); o1[2] = y1.z / (1.f + __expf(-v1[2])); o1[3] = y1.w / (1.f + __expf(-v1[3]));
             st8h(CAT16 + (size_t)r * D + 1024 + c, o0, o1); });
    xcd_barrier(xbar);
    gemm(lds, CAT16, D, (const f16*)(ws + W_OUT), D, MP, D, D, bid, [=](int r, int c, f32x4 v0, f32x4 v1) { st8h(U16 + (size_t)r * D + c, v0, v1); });
    xcd_barrier(xbar);
    rowpass(U16, ng + 1 * D, ng + 2 * D, H, A16, nullptr, MP);
    xcd_barrier(xbar);
    gemm(lds, A16, D, (const f16*)(ws + W_1), D, MP, DFF, D, bid, [=](int r, int c, f32x4 v0, f32x4 v1) {
        f32x4 z0 = __builtin_elementwise_max(v0, (f32x4){0.f, 0.f, 0.f, 0.f}), z1 = __builtin_elementwise_max(v1, (f32x4){0.f, 0.f, 0.f, 0.f}); st8h(HID16 + (size_t)r * DFF + c, z0 * z0, z1 * z1); });
    xcd_barrier(xbar);
    gemm(lds, HID16, DFF, (const f16*)(ws + W_2), DFF, MP, D, DFF, bid, [=](int r, int c, f32x4 v0, f32x4 v1) { st8h(U16 + (size_t)r * D + c, v0, v1); });
    xcd_barrier(xbar);
    rowpass(U16, ng + 3 * D, ng + 4 * D, H, A16, nullptr, MP);
    zero_kv_pads(co.K16, co.V16, co.KI16);
    xcd_barrier(xbar);
    gemm(lds, A16, D, (const f16*)(ws + W_CIN), D, MP, CINP, D, bid, [=](int r, int c, f32x4 v0, f32x4 v1) { cin_epilogue(co, r, c, v0, v1); });
    xcd_barrier(xbar);
#ifdef IDX_NAIVE
    idx_scores(co.QI16, co.KI16, co.WI, SCORE);
    xcd_barrier(xbar);
    select_topk(SCORE, MASK);
#else
    index_select(co.QI16, co.KI16, co.WI, MASK, lds);
#endif
    xcd_barrier(xbar);
#ifdef ATT_NAIVE
    attn_naive(ldsf, co.Q16, co.K16, co.V16, MASK, O16);
#else
    attn_phase(lds, co.Q16, co.K16, co.V16, MASK, O16);
#endif
    xcd_barrier(xbar);
    gemm(lds, O16, D, (const f16*)(ws + W_COUT), D, MMAIN, D, D, bid, [=](int r, int c, f32x4 v0, f32x4 v1) { st8h(U16 + (size_t)r * D + c, v0, v1); });
    xcd_barrier(xbar);
    rowpass(U16, ng + 5 * D, ng + 6 * D, H, A16, nullptr, MMAIN);
    xcd_barrier(xbar);
    gemm(lds, A16, D, (const f16*)(ws + W_1) + (size_t)D * DFF, D, MMAIN, DFF, D, bid, [=](int r, int c, f32x4 v0, f32x4 v1) {
        f32x4 z0 = __builtin_elementwise_max(v0, (f32x4){0.f, 0.f, 0.f, 0.f}), z1 = __builtin_elementwise_max(v1, (f32x4){0.f, 0.f, 0.f, 0.f}); st8h(HID16 + (size_t)r * DFF + c, z0 * z0, z1 * z1); });
    xcd_barrier(xbar);
    gemm(lds, HID16, DFF, (const f16*)(ws + W_2) + (size_t)D * DFF, DFF, MMAIN, D, DFF, bid, [=](int r, int c, f32x4 v0, f32x4 v1) { st8h(U16 + (size_t)r * D + c, v0, v1); });
    xcd_barrier(xbar);
    rowpass(U16, ng + 7 * D, nullptr, H, nullptr, p.out, MMAIN);
}

extern "C" void kernel_launch(void* const* d_in, const int* in_sizes, int n_in, void* d_out, int out_size, void* d_ws, size_t ws_size, hipStream_t stream) {
    static int grid_blocks = 0;
    if (!grid_blocks) {
        if (n_in != 20 || out_size != MMAIN * D || ws_size < WS_NEED) { fprintf(stderr, "kernel_launch: unexpected shapes n_in %d out %d ws %zu (need %zu)\n", n_in, out_size, ws_size, (size_t)WS_NEED); grid_blocks = -1; return; }
        int dev = 0, cus = 0, per_cu = 0;
        (void)hipGetDevice(&dev);
        (void)hipDeviceGetAttribute(&cus, hipDeviceAttributeMultiprocessorCount, dev);
        if (hipFuncSetAttribute((const void*)fwd, hipFuncAttributeMaxDynamicSharedMemorySize, LDS_BYTES) != hipSuccess) { fprintf(stderr, "kernel_launch: hipFuncSetAttribute failed\n"); grid_blocks = -1; return; }
        (void)hipOccupancyMaxActiveBlocksPerMultiprocessor(&per_cu, fwd, NTHREADS, LDS_BYTES);
        if (per_cu < 1) { fprintf(stderr, "kernel_launch: occupancy query says %d blocks per CU\n", per_cu); per_cu = 1; }
        grid_blocks = cus;
    }
    if (grid_blocks < 0) return;
    Params p{};
    for (int i = 0; i < 20; ++i) p.in[i] = (const float*)d_in[i];
    p.out = (float*)d_out; p.ws = (unsigned char*)d_ws;
    if (hipMemsetAsync((char*)d_ws + OFF_BAR, 0, SZ_BAR, stream) != hipSuccess) { fprintf(stderr, "kernel_launch: hipMemsetAsync failed\n"); return; }
    void* args[] = {&p};
    hipError_t e = hipLaunchCooperativeKernel((void*)fwd, dim3(grid_blocks), dim3(NTHREADS), args, LDS_BYTES, stream);
    if (e != hipSuccess) fprintf(stderr, "cooperative launch failed: %s (grid %d)\n", hipGetErrorString(e), grid_blocks);
}
```

```cpp
#include <hip/hip_runtime.h>
#include <hip/hip_fp16.h>
#include <hip/hip_cooperative_groups.h>
#include <cstdio>
#include <cstdint>
#include <cmath>
namespace cg = cooperative_groups;
__device__ __forceinline__ int otid() { int t = threadIdx.x; asm volatile("" : "+v"(t)); return t; }
__device__ __forceinline__ int obid() { int t = blockIdx.x; asm volatile("" : "+s"(t)); return t; }

namespace pg8 {
#define PG8_LAS __attribute__((address_space(3)))
typedef _Float16 f16_t;
typedef _Float16 f16x8 __attribute__((ext_vector_type(8)));
typedef float f32x4 __attribute__((ext_vector_type(4)));
typedef unsigned u32x4 __attribute__((ext_vector_type(4)));
constexpr int BM = 256, BK = 64, HALF = 128, HTB = HALF * BK * 2  , STAGE_BYTES = 8 * HTB, NXCD = 8, WGM = 8;

__host__ __device__ __forceinline__ int lds_byte(int r, int c) { const int st = (r >> 4) * 2 + (c >> 5), rr = r & 15, cc = c & 31, ob = rr * 64 + cc * 2; return st * 1024 + (ob ^ (((ob >> 9) & 1) << 5)); }
__host__ __device__ __forceinline__ void stage_rc(int b, int& R, int& C) { const int st = b / 1024, sb = b % 1024, swz = sb ^ (((sb >> 9) & 1) << 5); R = (st >> 1) * 16 + swz / 64; C = (st & 1) * 32 + (swz % 64) / 2; }
__host__ __device__ __forceinline__ int perm32(int rho) { const int n = rho >> 4, i = rho & 15; return 8 * (i >> 2) + 4 * n + (i & 3); }

struct Unit { int pm, pn; };
struct Gemm { const f16_t* A; const f16_t* Bt; int M, N, K, lda, ldb; };

struct StaticOrder {
    int nM, nN, nwg, G, c;
    __host__ __device__ void init(int M, int N, int G_, int c_) { nM = M / BM; nN = N / BM; nwg = nM * nN; G = G_; c = c_; }
    __host__ __device__ bool next(int i, Unit& u) const {
        const long L = (long)i * G + c; if (L >= nwg) return false;
        int wgid = (int)L; { const int q = nwg / NXCD, r = nwg % NXCD, xcd = wgid % NXCD, off = wgid / NXCD; wgid = (xcd < r ? xcd * (q + 1) : r * (q + 1) + (xcd - r) * q) + off; }
        const int nig = WGM * nN, gid = wgid / nig, fm = gid * WGM, gsz = (nM - fm) < WGM ? (nM - fm) : WGM;
        u.pm = fm + ((wgid % nig) % gsz); u.pn = (wgid % nig) / gsz; return true;
    }
    __device__ __forceinline__ void a_ready(const Unit&) const {}
    __device__ __forceinline__ void done(const Unit&) const {}
};


template <class Epi, class Sched, bool ALIGN_EPI = false, bool SP2 = false>
__device__ __forceinline__ void gemm_phase(PG8_LAS unsigned char* lds, const Gemm g, const Sched& S, const Epi& E) {
    const int tid = otid(), wid = __builtin_amdgcn_readfirstlane(tid >> 6), lane = tid & 63, wr = wid >> 2, wc = wid & 3, fr = lane & 15, fq = lane >> 4;
    const int K = g.K, nt = K / BK;
    unsigned voffA[2], voffB[2];
#pragma unroll
    for (int i = 0; i < 2; ++i) { int R, C; stage_rc(tid * 16 + i * 8192, R, C); const int Rb = Epi::PERM ? ((R & ~31) + perm32(R & 31)) : R;
        voffA[i] = (unsigned)(R * g.lda + C) * 2u; voffB[i] = (unsigned)(Rb * g.ldb + C) * 2u; }
    const size_t kstep = (size_t)(BK * 2);
    const size_t hstepA = (size_t)HALF * g.lda * 2, hstepB = (size_t)HALF * g.ldb * 2;
    const size_t tstepA = 2 * hstepA, tstepB = 2 * hstepB;
    const unsigned ldsw = (unsigned)wid * 1024u;
    const int aoff = lds_byte(wr * 64 + fr, fq * 8), boff = lds_byte(wc * 32 + fr, fq * 8);
#define PG8_SA(b, h) (((b) * 2 + (h)) * HTB)
#define PG8_SB(b, h) ((4 + (b) * 2 + (h)) * HTB)
#define PG8_STAGE(bufoff, gbase, voff) do { _Pragma("unroll") for (int _i = 0; _i < 2; ++_i) \
        __builtin_amdgcn_global_load_lds((const unsigned*)((const char*)(gbase) + (voff)[_i]), (PG8_LAS unsigned*)(lds + (bufoff) + ldsw + _i * 8192), 16, 0, 0); } while (0)
#define PG8_LDA(dst, b, h) do { _Pragma("unroll") for (int m = 0; m < 4; ++m) _Pragma("unroll") for (int k = 0; k < 2; ++k) dst[m][k] = *(const PG8_LAS f16x8*)(lds + PG8_SA(b, h) + aoff + m * 2048 + k * 1024); } while (0)
#define PG8_LDB(dst, b, h) do { _Pragma("unroll") for (int n = 0; n < 2; ++n) _Pragma("unroll") for (int k = 0; k < 2; ++k) dst[n][k] = *(const PG8_LAS f16x8*)(lds + PG8_SB(b, h) + boff + n * 2048 + k * 1024); } while (0)
#define PG8_MMA(ai, bj, At, Bt) do { __builtin_amdgcn_s_setprio(1); _Pragma("unroll") for (int m = 0; m < 4; ++m) _Pragma("unroll") for (int n = 0; n < 2; ++n) _Pragma("unroll") for (int k = 0; k < 2; ++k) \
        acc[ai][bj][m][n] = __builtin_amdgcn_mfma_f32_16x16x32_f16(Bt[n][k], At[m][k], acc[ai][bj][m][n], 0, 0, 0); __builtin_amdgcn_s_setprio(0); } while (0)
#define PG8_WAIT_V(n) asm volatile("s_waitcnt vmcnt(" #n ")" ::: "memory")
#define PG8_WAIT_L(n) asm volatile("s_waitcnt lgkmcnt(" #n ")" ::: "memory")
#define PG8_BAR __builtin_amdgcn_s_barrier()
#define PG8_SCHED __builtin_amdgcn_sched_barrier(0)
    Unit cur, nxt; int ui = 0;
    if (!S.next(0, cur)) return;
    f32x4 acc[2][2][4][2];
#pragma unroll
    for (int a = 0; a < 2; ++a)
#pragma unroll
        for (int b = 0; b < 2; ++b)
#pragma unroll
            for (int m = 0; m < 4; ++m)
#pragma unroll
                for (int n = 0; n < 2; ++n) acc[a][b][m][n] = (f32x4){0.f, 0.f, 0.f, 0.f};
    f16x8 At[4][2], B0[2][2], B1[2][2];
    const char* cA = (const char*)g.A + (size_t)cur.pm * tstepA; const char* cB = (const char*)g.Bt + (size_t)cur.pn * tstepB;
    S.a_ready(cur);
    if constexpr (SP2) {
        PG8_STAGE(PG8_SB(0, 0), cB, voffB); PG8_STAGE(PG8_SB(0, 1), cB + hstepB, voffB); PG8_STAGE(PG8_SA(0, 0), cA, voffA); PG8_STAGE(PG8_SA(0, 1), cA + hstepA, voffA);
        if (wr == 1) PG8_BAR;
        PG8_WAIT_V(2); PG8_BAR;
        PG8_STAGE(PG8_SB(1, 0), cB + kstep, voffB); PG8_STAGE(PG8_SA(1, 0), cA + kstep, voffA); PG8_STAGE(PG8_SB(1, 1), cB + hstepB + kstep, voffB);
        PG8_WAIT_V(6); PG8_BAR;
    } else {
        PG8_STAGE(PG8_SB(0, 0), cB, voffB); PG8_STAGE(PG8_SA(0, 0), cA, voffA); PG8_STAGE(PG8_SB(0, 1), cB + hstepB, voffB); PG8_STAGE(PG8_SA(0, 1), cA + hstepA, voffA);
        if (wr == 1) PG8_BAR;
        PG8_WAIT_V(4); PG8_BAR;
        PG8_STAGE(PG8_SB(1, 0), cB + kstep, voffB); PG8_STAGE(PG8_SA(1, 0), cA + kstep, voffA); PG8_STAGE(PG8_SB(1, 1), cB + hstepB + kstep, voffB);
        PG8_WAIT_V(6); PG8_BAR;
    }
    for (;;) {
        const bool has_next = S.next(ui + 1, nxt);
        const char* nA = has_next ? (const char*)g.A + (size_t)nxt.pm * tstepA : cA; const char* nB = has_next ? (const char*)g.Bt + (size_t)nxt.pn * tstepB : cB;
        for (int t = 0; t < nt; t += 2) {
            const bool last = (t == nt - 2);
            const char* a1 = cA + (size_t)(t + 1) * kstep;
            const char* a2 = last ? nA : cA + (size_t)(t + 2) * kstep; const char* b2 = last ? nB : cB + (size_t)(t + 2) * kstep;
            const char* a3 = a2 + kstep; const char* b3 = b2 + kstep;
            if (last && has_next) S.a_ready(nxt);
            if constexpr (SP2) {
            PG8_LDB(B0, 0, 0); PG8_LDB(B1, 0, 1); PG8_SCHED; PG8_LDA(At, 0, 0); PG8_STAGE(PG8_SA(1, 1), a1 + hstepA, voffA);
            PG8_WAIT_V(8); PG8_WAIT_L(0); PG8_BAR; PG8_MMA(0, 0, At, B0); PG8_MMA(0, 1, At, B1); PG8_BAR; PG8_SCHED;
            PG8_LDA(At, 0, 1); PG8_STAGE(PG8_SB(0, 0), b2, voffB); PG8_STAGE(PG8_SB(0, 1), b2 + hstepB, voffB); PG8_STAGE(PG8_SA(0, 0), a2, voffA);
            PG8_WAIT_V(8); PG8_WAIT_L(0); PG8_BAR; PG8_MMA(1, 0, At, B0); PG8_MMA(1, 1, At, B1); PG8_BAR; PG8_SCHED;
            PG8_LDB(B0, 1, 0); PG8_LDB(B1, 1, 1); PG8_SCHED; PG8_LDA(At, 1, 0); PG8_STAGE(PG8_SA(0, 1), a2 + hstepA, voffA);
            PG8_WAIT_V(8); PG8_WAIT_L(0); PG8_BAR; PG8_MMA(0, 0, At, B0); PG8_MMA(0, 1, At, B1); PG8_BAR; PG8_SCHED;
            PG8_LDA(At, 1, 1); PG8_STAGE(PG8_SB(1, 0), b3, voffB); PG8_STAGE(PG8_SB(1, 1), b3 + hstepB, voffB); PG8_STAGE(PG8_SA(1, 0), a3, voffA);
            PG8_WAIT_V(8); PG8_WAIT_L(0); PG8_BAR; PG8_MMA(1, 0, At, B0); PG8_MMA(1, 1, At, B1); PG8_BAR; PG8_SCHED;
            } else {
            PG8_LDB(B0, 0, 0); PG8_SCHED; PG8_LDA(At, 0, 0); PG8_STAGE(PG8_SA(1, 1), a1 + hstepA, voffA);
            PG8_WAIT_L(8); PG8_BAR; PG8_WAIT_L(0); PG8_MMA(0, 0, At, B0); PG8_BAR; PG8_SCHED;
            PG8_LDB(B1, 0, 1); PG8_STAGE(PG8_SB(0, 0), b2, voffB);
            PG8_BAR; PG8_WAIT_L(0); PG8_MMA(0, 1, At, B1); PG8_BAR;
            PG8_LDA(At, 0, 1); PG8_STAGE(PG8_SA(0, 0), a2, voffA);
            PG8_BAR; PG8_WAIT_L(0); PG8_MMA(1, 0, At, B0); PG8_BAR; PG8_SCHED;
            PG8_STAGE(PG8_SB(0, 1), b2 + hstepB, voffB);
            PG8_WAIT_V(6); PG8_BAR; PG8_MMA(1, 1, At, B1); PG8_BAR;
            PG8_LDB(B0, 1, 0); PG8_SCHED; PG8_LDA(At, 1, 0); PG8_STAGE(PG8_SA(0, 1), a2 + hstepA, voffA);
            PG8_WAIT_L(8); PG8_BAR; PG8_WAIT_L(0); PG8_MMA(0, 0, At, B0); PG8_BAR; PG8_SCHED;
            PG8_LDB(B1, 1, 1); PG8_STAGE(PG8_SB(1, 0), b3, voffB);
            PG8_BAR; PG8_WAIT_L(0); PG8_MMA(0, 1, At, B1); PG8_BAR;
            PG8_LDA(At, 1, 1); PG8_STAGE(PG8_SA(1, 0), a3, voffA);
            PG8_BAR; PG8_WAIT_L(0); PG8_MMA(1, 0, At, B0); PG8_BAR; PG8_SCHED;
            PG8_STAGE(PG8_SB(1, 1), b3 + hstepB, voffB);
            PG8_WAIT_V(6); PG8_BAR; PG8_MMA(1, 1, At, B1); PG8_BAR;
            }
        }
        if constexpr (ALIGN_EPI) { if (wr == 0) PG8_BAR; }
        if constexpr (!Epi::AFTER_DRAIN) { E(acc, cur, wr, wc, fr, fq); S.done(cur); }
        if (!has_next) break;
#pragma unroll
        for (int a = 0; a < 2; ++a)
#pragma unroll
            for (int b = 0; b < 2; ++b)
#pragma unroll
                for (int m = 0; m < 4; ++m)
#pragma unroll
                    for (int n = 0; n < 2; ++n) acc[a][b][m][n] = (f32x4){0.f, 0.f, 0.f, 0.f};
        cur = nxt; cA = nA; cB = nB; ++ui;
        if constexpr (ALIGN_EPI) { if (wr == 1) PG8_BAR; }
    }
    PG8_WAIT_V(0);
    if constexpr (!ALIGN_EPI) { if (wr == 0) PG8_BAR; }
    PG8_BAR;
    if constexpr (Epi::AFTER_DRAIN) { E.fused(acc, cur, wr, wc, fr, fq, lds, wid, lane); S.done(cur); }
#undef PG8_SA
#undef PG8_SB
#undef PG8_STAGE
#undef PG8_LDA
#undef PG8_LDB
#undef PG8_MMA
#undef PG8_WAIT_V
#undef PG8_WAIT_L
#undef PG8_BAR
#undef PG8_SCHED
}

template <class F> struct EpiRow8 {
    static constexpr bool PERM = true, AFTER_DRAIN = false;
    F f;
    __device__ __forceinline__ void operator()(const f32x4 (&acc)[2][2][4][2], const Unit& u, int wr, int wc, int fr, int fq) const {
        const int row0 = u.pm * BM + wr * 64 + fr, col0 = u.pn * BM + wc * 32 + 8 * fq;
#pragma unroll
        for (int ai = 0; ai < 2; ++ai)
#pragma unroll
            for (int m = 0; m < 4; ++m)
#pragma unroll
                for (int bj = 0; bj < 2; ++bj) f(row0 + ai * HALF + m * 16, col0 + bj * HALF, acc[ai][bj][m][0], acc[ai][bj][m][1]);
    }
};
}

#define LAS __attribute__((address_space(3)))
typedef _Float16 f16;
typedef float f32x4 __attribute__((ext_vector_type(4)));
typedef unsigned u32x4 __attribute__((ext_vector_type(4)));
typedef _Float16 h2v __attribute__((ext_vector_type(2)));

constexpr int D = 2048, NMETA = 16, SEQ = 2048, T = 2064, DFF = 8192;
constexpr int MMAIN = 8192;
constexpr int MREAL = 8208;
constexpr int MP = 8448;
constexpr int CIN = 4176, CINP = 4352;
constexpr int QOFF = 0, KOFF = 2048, VOFF = 2560, QIOFF = 3072, KIOFF = 4096, WIOFF = 4160;
constexpr int SROW = 2112;
constexpr float EPS = 1e-6f;
constexpr int NTHREADS = 512;
constexpr int LDS_BYTES = 147456;

struct Params { const float* in[20]; float* out; unsigned char* ws; };
enum { I_X = 0, I_META, I_NORMG, I_ABWIN, I_POOLW, I_POOLS, I_LRE, I_LIM, I_LOGDT, I_BRE, I_BIM, I_CRE, I_CIM, I_S5D, I_WGLU, I_ABWOUT, I_CWIN, I_CWOUT, I_W1, I_W2 };

constexpr int TP = 2112;
constexpr size_t SZ4 = (size_t)MP * D * 4, SZ2 = (size_t)MP * D * 2;
constexpr size_t OFF_H = 0, OFF_A16 = OFF_H + SZ4, OFF_U16 = OFF_A16 + SZ2, OFF_DY16 = OFF_U16 + SZ2, OFF_CAT16 = OFF_DY16 + SZ2, OFF_BIG = OFF_CAT16 + SZ2;
constexpr size_t SZ_BIG = (size_t)MP * DFF * 2;
constexpr size_t OFF_Q16 = OFF_BIG, OFF_K16 = OFF_Q16 + (size_t)MMAIN * D * 2, OFF_V16 = OFF_K16 + (size_t)4 * TP * 512 * 2, OFF_QI16 = OFF_V16 + (size_t)4 * TP * 512 * 2,
                 OFF_KI16 = OFF_QI16 + (size_t)MMAIN * 1024 * 2, OFF_WI = OFF_KI16 + (size_t)4 * TP * 64 * 2, OFF_ATT_END = OFF_WI + (size_t)MMAIN * 16 * 4;
static_assert(OFF_ATT_END <= OFF_BIG + SZ_BIG, "attention buffers fit the BIG region");
constexpr size_t OFF_MASK = OFF_BIG + SZ_BIG, SZ_MASK = (size_t)MMAIN * 33 * 8;
constexpr size_t OFF_ROPE16 = OFF_MASK + SZ_MASK, OFF_ROPE8 = OFF_ROPE16 + (size_t)T * 16 * 8;
constexpr size_t OFF_BAR = OFF_ROPE8 + (size_t)T * 8 * 8, SZ_BAR = 16384;
constexpr size_t OFF_W = OFF_BAR + SZ_BAR;
constexpr size_t OFF_SCORE = OFF_DY16, OFF_O16 = OFF_A16;
constexpr size_t W_IN = OFF_W, W_POOL = W_IN + (size_t)D * D * 2, W_GLU = W_POOL + (size_t)4 * 256 * 256 * 2, W_OUT = W_GLU + (size_t)1024 * 1024 * 2,
                 W_CIN = W_OUT + (size_t)D * D * 2, W_COUT = W_CIN + (size_t)CINP * D * 2, W_1 = W_COUT + (size_t)D * D * 2, W_2 = W_1 + (size_t)2 * D * DFF * 2,
                 WS_NEED = W_2 + (size_t)2 * D * DFF * 2;
static_assert((size_t)MMAIN * SROW * 4 <= 2 * SZ2, "SCORE fits DY16+CAT16");
static_assert(OFF_W % 256 == 0, "alignment");

__device__ __forceinline__ int row_of(int b, int t) { return t < NMETA ? MMAIN + t : b * SEQ + (t - NMETA); }
__device__ __forceinline__ float wave_sum(float v) {
#pragma unroll
    for (int o = 1; o < 64; o <<= 1) v += __shfl_xor(v, o);
    return v;
}
__device__ __forceinline__ float wave_max(float v) {
#pragma unroll
    for (int o = 1; o < 64; o <<= 1) v = fmaxf(v, __shfl_xor(v, o));
    return v;
}
__device__ __forceinline__ float4 ld4(const float* p) { return *(const float4*)p; }
__device__ __forceinline__ unsigned pk2h(float a, float b) { h2v r; r.x = (_Float16)a; r.y = (_Float16)b; return __builtin_bit_cast(unsigned, r); }
__device__ __forceinline__ float2 up2h(unsigned u) { const h2v r = __builtin_bit_cast(h2v, u); return make_float2((float)r.x, (float)r.y); }
__device__ __forceinline__ float4 ld4(const f16* p) { const uint2 r = *(const uint2*)p; const float2 a = up2h(r.x), b = up2h(r.y); return make_float4(a.x, a.y, b.x, b.y); }
__device__ __forceinline__ void st4h(f16* p, float4 v) { uint2 r; r.x = pk2h(v.x, v.y); r.y = pk2h(v.z, v.w); *(uint2*)p = r; }
__device__ __forceinline__ void st8h(f16* p, f32x4 a, f32x4 b) { u32x4 w; w.x = pk2h(a[0], a[1]); w.y = pk2h(a[2], a[3]); w.z = pk2h(b[0], b[1]); w.w = pk2h(b[2], b[3]); *(u32x4*)p = w; }

__device__ __forceinline__ void sincos_d(double x, double& sn, double& cs) {
    const double q = rint(x * 0.6366197723675814);
    double r = fma(-q, 1.5707963267948966, x); r = fma(-q, 6.123233995736766e-17, r);
    const double r2 = r * r;
    double sp = -1.0 / 6227020800.0; sp = fma(sp, r2, 1.0 / 39916800.0); sp = fma(sp, r2, -1.0 / 362880.0); sp = fma(sp, r2, 1.0 / 5040.0); sp = fma(sp, r2, -1.0 / 120.0); sp = fma(sp, r2, 1.0 / 6.0); sp = fma(sp, r2, -1.0); sp = -sp * r;
    double cp = 1.0 / 87178291200.0; cp = fma(cp, r2, -1.0 / 479001600.0); cp = fma(cp, r2, 1.0 / 3628800.0); cp = fma(cp, r2, -1.0 / 40320.0); cp = fma(cp, r2, 1.0 / 720.0); cp = fma(cp, r2, -1.0 / 24.0); cp = fma(cp, r2, 0.5); cp = fma(-cp, r2, 1.0);
    const int n = ((int)q) & 3;
    sn = (n == 0) ? sp : (n == 1) ? cp : (n == 2) ? -sp : -cp;
    cs = (n == 0) ? cp : (n == 1) ? -sp : (n == 2) ? -cp : sp;
}
__device__ __forceinline__ float rope_inv16(int idx) {
    const double r = 1.0 / sqrt(sqrt(sqrt(sqrt(500000.0))));
    double v = 1.0;
    for (int i = 0; i < idx; ++i) v *= r;
    return (float)v;
}

__device__ __forceinline__ void cvt_item(const float* W, int K, int N, int NPAD, f16* WT, float* scr, int item, int lane) {
    const int nblk = NPAD / 32, kb = item / nblk, nb = item % nblk, k0 = 64 * kb, n0 = 32 * nb;
    const int n = n0 + (lane & 31);
#pragma unroll 8
    for (int i = 0; i < 32; ++i) { const int kk = 2 * i + (lane >> 5); scr[kk * 33 + (lane & 31)] = (n < N) ? W[(size_t)(k0 + kk) * N + n] : 0.f; }
    const int c = lane & 7;
#pragma unroll
    for (int j = 0; j < 4; ++j) { const int nn = (lane >> 3) + 8 * j; const float* s = scr + (8 * c) * 33 + nn;
        u32x4 o; o.x = pk2h(s[0 * 33], s[1 * 33]); o.y = pk2h(s[2 * 33], s[3 * 33]); o.z = pk2h(s[4 * 33], s[5 * 33]); o.w = pk2h(s[6 * 33], s[7 * 33]);
        *(u32x4*)(WT + (size_t)(n0 + nn) * K + k0 + 8 * c) = o; }
}
__device__ __forceinline__ void convert_weights(const Params& p, float* ldsf) {
    const int tid_ = otid(), lane = tid_ & 63, wv = tid_ >> 6, gw = obid() * (NTHREADS / 64) + wv, ngw = gridDim.x * (NTHREADS / 64);
    float* scr = ldsf + wv * (64 * 33);
    unsigned char* ws = p.ws;
    constexpr int I_IN = 32 * 64, I_PG = 4 * 8, I_GLU = 16 * 32, I_OUT = 32 * 64, I_CI = 32 * (CINP / 32), I_CO = 32 * 64, I_M1 = 32 * 256, I_M2 = 128 * 64;
    constexpr int NITEMS = I_IN + 4 * I_PG + I_GLU + I_OUT + I_CI + I_CO + 2 * I_M1 + 2 * I_M2;
    for (int it = gw; it < NITEMS; it += ngw) {
        int r = it;
        if (r < I_IN) { cvt_item(p.in[I_ABWIN], D, D, D, (f16*)(ws + W_IN), scr, r, lane); continue; } r -= I_IN;
        if (r < 4 * I_PG) { const int g = r / I_PG; cvt_item(p.in[I_POOLW] + (size_t)g * 65536, 256, 256, 256, (f16*)(ws + W_POOL) + (size_t)g * 65536, scr, r % I_PG, lane); continue; } r -= 4 * I_PG;
        if (r < I_GLU) { cvt_item(p.in[I_WGLU], 1024, 1024, 1024, (f16*)(ws + W_GLU), scr, r, lane); continue; } r -= I_GLU;
        if (r < I_OUT) { cvt_item(p.in[I_ABWOUT], D, D, D, (f16*)(ws + W_OUT), scr, r, lane); continue; } r -= I_OUT;
        if (r < I_CI) { cvt_item(p.in[I_CWIN], D, CIN, CINP, (f16*)(ws + W_CIN), scr, r, lane); continue; } r -= I_CI;
        if (r < I_CO) { cvt_item(p.in[I_CWOUT], D, D, D, (f16*)(ws + W_COUT), scr, r, lane); continue; } r -= I_CO;
        if (r < 2 * I_M1) { const int l = r / I_M1; cvt_item(p.in[I_W1] + (size_t)l * D * DFF, D, DFF, DFF, (f16*)(ws + W_1) + (size_t)l * D * DFF, scr, r % I_M1, lane); continue; } r -= 2 * I_M1;
        { const int l = r / I_M2; cvt_item(p.in[I_W2] + (size_t)l * D * DFF, DFF, D, D, (f16*)(ws + W_2) + (size_t)l * D * DFF, scr, r % I_M2, lane); }
    }
}

__device__ __forceinline__ void init_rows(const Params& p, float* H, f16* A) {
    const int tid_ = otid(), lane = tid_ & 63, gw = obid() * (NTHREADS / 64) + (tid_ >> 6), ngw = gridDim.x * (NTHREADS / 64);
    const float* g = p.in[I_NORMG];
    for (int row = gw; row < MP; row += ngw) {
        float4 h[8]; float ss = 0.f;
#pragma unroll
        for (int j = 0; j < 8; ++j) {
            const int c = 4 * lane + 256 * j;
            if (row < MMAIN) h[j] = ld4(p.in[I_X] + (size_t)row * D + c);
            else if (row < MREAL) h[j] = ld4(p.in[I_META] + (size_t)(row - MMAIN) * D + c);
            else h[j] = make_float4(0.f, 0.f, 0.f, 0.f);
            ss += h[j].x * h[j].x + h[j].y * h[j].y + h[j].z * h[j].z + h[j].w * h[j].w;
        }
        const float r = rsqrtf(wave_sum(ss) * (1.f / D) + EPS);
#pragma unroll
        for (int j = 0; j < 8; ++j) {
            const int c = 4 * lane + 256 * j; const float4 gg = ld4(g + c);
            *(float4*)(H + (size_t)row * D + c) = h[j];
            st4h(A + (size_t)row * D + c, make_float4(h[j].x * r * gg.x, h[j].y * r * gg.y, h[j].z * r * gg.z, h[j].w * r * gg.w));
        }
    }
}
__device__ __forceinline__ void rowpass(const f16* MIX, const float* ga, const float* gb, float* H, f16* A, float* OUT, int nrows) {
    const int tid_ = otid(), lane = tid_ & 63, gw = obid() * (NTHREADS / 64) + (tid_ >> 6), ngw = gridDim.x * (NTHREADS / 64);
    for (int row = gw; row < nrows; row += ngw) {
        float4 m[8], h[8]; float ss = 0.f;
#pragma unroll
        for (int j = 0; j < 8; ++j) {
            const int c = 4 * lane + 256 * j;
            m[j] = ld4(MIX + (size_t)row * D + c); h[j] = ld4(H + (size_t)row * D + c);
            ss += m[j].x * m[j].x + m[j].y * m[j].y + m[j].z * m[j].z + m[j].w * m[j].w;
        }
        const float r = rsqrtf(wave_sum(ss) * (1.f / D) + EPS);
        float s2 = 0.f;
#pragma unroll
        for (int j = 0; j < 8; ++j) {
            const int c = 4 * lane + 256 * j; const float4 gg = ld4(ga + c);
            h[j].x += m[j].x * r * gg.x; h[j].y += m[j].y * r * gg.y; h[j].z += m[j].z * r * gg.z; h[j].w += m[j].w * r * gg.w;
            s2 += h[j].x * h[j].x + h[j].y * h[j].y + h[j].z * h[j].z + h[j].w * h[j].w;
        }
        if (OUT) {
#pragma unroll
            for (int j = 0; j < 8; ++j) *(float4*)(OUT + (size_t)row * D + 4 * lane + 256 * j) = h[j];
        } else {
            const float r2 = rsqrtf(wave_sum(s2) * (1.f / D) + EPS);
#pragma unroll
            for (int j = 0; j < 8; ++j) {
                const int c = 4 * lane + 256 * j; const float4 gg = ld4(gb + c);
                *(float4*)(H + (size_t)row * D + c) = h[j];
                st4h(A + (size_t)row * D + c, make_float4(h[j].x * r2 * gg.x, h[j].y * r2 * gg.y, h[j].z * r2 * gg.z, h[j].w * r2 * gg.w));
            }
        }
    }
}

__device__ __forceinline__ void pool_diff(const f16* U, f16* DY) {
    const int total = MREAL * 128, stride = (int)gridDim.x * NTHREADS;
    for (int i = obid() * NTHREADS + otid(); i < total; i += stride) {
        const int row = i >> 7, c = (i & 127) * 8;
        const int b = row < MMAIN ? row >> 11 : 0, t = row < MMAIN ? (row & 2047) + NMETA : row - MMAIN;
        const int win = 2 << (c >> 8);
        const int cnt = (t + 1) < win ? (t + 1) : win;
        const float4 ua = ld4(U + (size_t)row * D + c), ub = ld4(U + (size_t)row * D + c + 4);
        float4 sa = ua, sb = ub;
        for (int j = 1; j < cnt; ++j) {
            const f16* up = U + (size_t)row_of(b, t - j) * D + c; const float4 a = ld4(up), bb = ld4(up + 4);
            sa.x += a.x; sa.y += a.y; sa.z += a.z; sa.w += a.w; sb.x += bb.x; sb.y += bb.y; sb.z += bb.z; sb.w += bb.w;
        }
        const float ic = 1.f / (float)cnt;
        f32x4 o0 = {sa.x * ic - ua.x, sa.y * ic - ua.y, sa.z * ic - ua.z, sa.w * ic - ua.w}, o1 = {sb.x * ic - ub.x, sb.y * ic - ub.y, sb.z * ic - ub.z, sb.w * ic - ub.w};
        st8h(DY + (size_t)row * D + c, o0, o1);
    }
}

__device__ __forceinline__ void pool_diff_old(const f16* U, f16* DY) {
    const size_t total = (size_t)MREAL * 1024, stride = (size_t)gridDim.x * NTHREADS;
    for (size_t i = (size_t)obid() * NTHREADS + otid(); i < total; i += stride) {
        const int row = (int)(i >> 10), c = (int)(i & 1023);
        const int b = row < MMAIN ? row >> 11 : 0, t = row < MMAIN ? (row & 2047) + NMETA : row - MMAIN;
        const int win = 2 << (c >> 8);
        const int cnt = (t + 1) < win ? (t + 1) : win;
        float s = 0.f;
        for (int j = 0; j < cnt; ++j) s += (float)U[(size_t)row_of(b, t - j) * D + c];
        DY[(size_t)row * D + c] = (f16)(s / (float)cnt - (float)U[(size_t)row * D + c]);
    }
}

__device__ __forceinline__ float gelu_tanh(float x) {
    const float k0 = 0.7978845608028654f, k1 = 0.044715f;
    return 0.5f * x * (1.f + tanhf(k0 * (x + k1 * x * x * x)));
}

typedef _Float16 f16x8 __attribute__((ext_vector_type(8)));
constexpr int SSM_WAVE_LDS = 128 * 20 * 4 + 16 * 136 * 2;
constexpr int SSM_CARRY_OFF = 8 * SSM_WAVE_LDS;
__device__ __forceinline__ void ssm_phase(const Params& p, const f16* U, f16* DY, LAS unsigned char* lds) {
    const int tid_ = otid(), lane = tid_ & 63, wv = __builtin_amdgcn_readfirstlane(tid_ >> 6), l15 = lane & 15, g2 = lane >> 4;
    LAS float* BUT = (LAS float*)(lds + wv * SSM_WAVE_LDS);
    LAS f16* HT = (LAS f16*)(lds + wv * SSM_WAVE_LDS + 128 * 20 * 4);
    typedef float f32x2_t __attribute__((ext_vector_type(2)));
    LAS f32x2_t* CARRY = (LAS f32x2_t*)(lds + SSM_CARRY_OFF);
    for (int item = obid(); item < 256; item += gridDim.x) {
        const int b = item >> 6, g = item & 63, n = lane;
        const float dt = expf(p.in[I_LOGDT][g]);
        const float ar = p.in[I_LRE][g * 64 + n], ai = p.in[I_LIM][g * 64 + n];
        float are, aim, pw0r, pw0i, pw1r, pw1i;
        { const float mag = expf(dt * ar); double sd, cd; sincos_d((double)(dt * ai), sd, cd); are = mag * (float)cd; aim = mag * (float)sd; }
        { const float mag = expf(272.f * dt * ar); double sd, cd; sincos_d(272.0 * (double)(dt * ai), sd, cd); pw0r = mag * (float)cd; pw0i = mag * (float)sd; }
        { const float mag = expf(256.f * dt * ar); double sd, cd; sincos_d(256.0 * (double)(dt * ai), sd, cd); pw1r = mag * (float)cd; pw1i = mag * (float)sd; }
        {
            const float den = ar * ar + ai * ai, zr = are - 1.f, zi = aim;
            const float fre = (zr * ar + zi * ai) / (den * dt), fim = (zi * ar - zr * ai) / (den * dt);
            LAS f16* TB = (LAS f16*)BUT;
#pragma unroll
            for (int c = 0; c < 16; ++c) {
                const float br = p.in[I_BRE][(g * 64 + n) * 16 + c], bi = p.in[I_BIM][(g * 64 + n) * 16 + c];
                TB[n * 16 + c] = (f16)(fre * br - fim * bi); TB[(64 + n) * 16 + c] = (f16)(fre * bi + fim * br);
            }
        }
        asm volatile("" ::: "memory");
        f16x8 bbf[8];
#pragma unroll
        for (int nt = 0; nt < 8; ++nt) {
            const f16x8 z = {0, 0, 0, 0, 0, 0, 0, 0};
            bbf[nt] = (g2 < 2) ? *(const LAS f16x8*)((const LAS f16*)BUT + (16 * nt + l15) * 16 + 8 * g2) : z;
        }
        asm volatile("" ::: "memory");
        f16x8 cf[4];
#pragma unroll
        for (int ks = 0; ks < 4; ++ks) {
            const int k = 32 * ks + 8 * g2;
            const float* src = (k < 64) ? (p.in[I_CRE] + (g * 16 + l15) * 64 + k) : (p.in[I_CIM] + (g * 16 + l15) * 64 + (k - 64));
            const float sg = (k < 64) ? 1.f : -1.f;
            const float4 x0 = ld4(src), x1 = ld4(src + 4);
            f16x8 v; v[0] = (f16)(sg * x0.x); v[1] = (f16)(sg * x0.y); v[2] = (f16)(sg * x0.z); v[3] = (f16)(sg * x0.w); v[4] = (f16)(sg * x1.x); v[5] = (f16)(sg * x1.y); v[6] = (f16)(sg * x1.z); v[7] = (f16)(sg * x1.w);
            cf[ks] = v;
        }
        float dd[4];
#pragma unroll
        for (int j = 0; j < 4; ++j) dd[j] = p.in[I_S5D][g * 16 + 4 * g2 + j];
        const int blk0 = (wv == 0) ? 0 : 17 + 16 * (wv - 1), nblk = (wv == 0) ? 17 : 16;
        float hr = 0.f, hi = 0.f;
#pragma unroll 1
        for (int pass = 0; pass < 2; ++pass) {
            if (pass == 1) {
                CARRY[wv * 64 + n] = (f32x2_t){hr, hi};
                __syncthreads();
                float cr = 0.f, ci = 0.f;
                for (int j = 0; j < wv; ++j) {
                    const f32x2_t e = CARRY[j * 64 + n]; const float pr = (j == 0) ? pw0r : pw1r, pi = (j == 0) ? pw0i : pw1i;
                    const float nr = pr * cr - pi * ci + e.x, ni = pr * ci + pi * cr + e.y; cr = nr; ci = ni;
                }
                hr = cr; hi = ci;
                __syncthreads();
            }
#pragma unroll 1
            for (int kb = 0; kb < nblk; ++kb) {
                const int t0 = (blk0 + kb) * 16;
                const int rowa = row_of(b, t0 + l15);
                f16x8 ua = {0, 0, 0, 0, 0, 0, 0, 0};
                if (g2 < 2) ua = *(const f16x8*)(U + (size_t)rowa * D + 1024 + g * 16 + 8 * g2);
                f32x4 bacc[8];
#pragma unroll
                for (int nt = 0; nt < 8; ++nt) bacc[nt] = __builtin_amdgcn_mfma_f32_16x16x32_f16(ua, bbf[nt], (f32x4){0.f, 0.f, 0.f, 0.f}, 0, 0, 0);
                __builtin_amdgcn_sched_barrier(0);
                asm volatile("s_nop 15\n\ts_nop 15" ::: "memory");
                __builtin_amdgcn_sched_barrier(0);
#pragma unroll
                for (int nt = 0; nt < 8; ++nt) *(LAS f32x4*)(BUT + (16 * nt + l15) * 20 + 4 * g2) = bacc[nt];
                asm volatile("" ::: "memory");
                float bre[16], bim[16];
#pragma unroll
                for (int q4 = 0; q4 < 4; ++q4) {
                    const f32x4 x = *(const LAS f32x4*)(BUT + n * 20 + 4 * q4), y = *(const LAS f32x4*)(BUT + (64 + n) * 20 + 4 * q4);
                    bre[4 * q4] = x[0]; bre[4 * q4 + 1] = x[1]; bre[4 * q4 + 2] = x[2]; bre[4 * q4 + 3] = x[3];
                    bim[4 * q4] = y[0]; bim[4 * q4 + 1] = y[1]; bim[4 * q4 + 2] = y[2]; bim[4 * q4 + 3] = y[3];
                }
#pragma unroll
                for (int tt = 0; tt < 16; ++tt) {
                    const float nr = fmaf(are, hr, fmaf(-aim, hi, bre[tt])), ni = fmaf(are, hi, fmaf(aim, hr, bim[tt]));
                    hr = nr; hi = ni;
                    if (pass == 1) { HT[tt * 136 + n] = (f16)hr; HT[tt * 136 + 64 + n] = (f16)hi; }
                }
                asm volatile("" ::: "memory");
                if (pass == 1) {
                    f32x4 ya = {0.f, 0.f, 0.f, 0.f};
#pragma unroll
                    for (int ks = 0; ks < 4; ++ks) {
                        const f16x8 hb = *(const LAS f16x8*)(HT + l15 * 136 + 32 * ks + 8 * g2);
                        ya = __builtin_amdgcn_mfma_f32_16x16x32_f16(cf[ks], hb, ya, 0, 0, 0);
                    }
                    __builtin_amdgcn_sched_barrier(0);
                    asm volatile("s_nop 15\n\ts_nop 15" ::: "memory");
                    __builtin_amdgcn_sched_barrier(0);
                    if (t0 >= NMETA || b == 0) {
                        const float4 uu = ld4(U + (size_t)rowa * D + 1024 + g * 16 + 4 * g2);
                        const float4 o = make_float4(gelu_tanh(dt * ya[0] + dd[0] * uu.x), gelu_tanh(dt * ya[1] + dd[1] * uu.y), gelu_tanh(dt * ya[2] + dd[2] * uu.z), gelu_tanh(dt * ya[3] + dd[3] * uu.w));
                        st4h(DY + (size_t)rowa * D + 1024 + g * 16 + 4 * g2, o);
                    }
                }
            }
        }
        __syncthreads();
    }
}

__device__ __forceinline__ void ssm_naive(const Params& p, const f16* U, f16* DY) {
    const int tid_ = otid(), lane = tid_ & 63, gw = obid() * (NTHREADS / 64) + (tid_ >> 6), ngw = gridDim.x * (NTHREADS / 64);
    for (int item = gw; item < 256; item += ngw) {
        const int b = item >> 6, g = item & 63, n = lane;
        const float dt = expf(p.in[I_LOGDT][g]);
        const float ar = p.in[I_LRE][g * 64 + n], ai = p.in[I_LIM][g * 64 + n];
        const float mag = expf(dt * ar); double sd, cd; sincos_d((double)(dt * ai), sd, cd); const float sn = (float)sd, cs = (float)cd;
        const float are = mag * cs, aim = mag * sn;
        const float den = ar * ar + ai * ai, zr = are - 1.f, zi = aim;
        const float fre = (zr * ar + zi * ai) / den, fim = (zi * ar - zr * ai) / den;
        float bbr[16], bbi[16], cr[16], ci[16];
#pragma unroll
        for (int c = 0; c < 16; ++c) {
            const float br = p.in[I_BRE][(g * 64 + n) * 16 + c], bi = p.in[I_BIM][(g * 64 + n) * 16 + c];
            bbr[c] = fre * br - fim * bi; bbi[c] = fre * bi + fim * br;
            cr[c] = p.in[I_CRE][(g * 16 + c) * 64 + n]; ci[c] = p.in[I_CIM][(g * 16 + c) * 64 + n];
        }
        const float dd = p.in[I_S5D][g * 16 + (lane & 15)];
        float hr = 0.f, hi = 0.f;
#pragma unroll 1
        for (int t = 0; t < T; ++t) {
            const int row = row_of(b, t);
            const f16* ur = U + (size_t)row * D + 1024 + g * 16;
            const float4 u0 = ld4(ur), u1 = ld4(ur + 4), u2 = ld4(ur + 8), u3 = ld4(ur + 12);
            const float uu[16] = {u0.x, u0.y, u0.z, u0.w, u1.x, u1.y, u1.z, u1.w, u2.x, u2.y, u2.z, u2.w, u3.x, u3.y, u3.z, u3.w};
            float bur = 0.f, bui = 0.f;
#pragma unroll
            for (int c = 0; c < 16; ++c) { bur = fmaf(bbr[c], uu[c], bur); bui = fmaf(bbi[c], uu[c], bui); }
            const float nhr = are * hr - aim * hi + bur, nhi = are * hi + aim * hr + bui;
            hr = nhr; hi = nhi;
            float myy = 0.f;
#pragma unroll
            for (int c = 0; c < 16; ++c) { const float v = wave_sum(cr[c] * hr - ci[c] * hi); if (lane == c) myy = v; }
            if (lane < 16 && (t >= NMETA || b == 0)) {
                const float y = myy + dd * (float)ur[lane];
                DY[(size_t)row * D + 1024 + g * 16 + lane] = (f16)gelu_tanh(y);
            }
        }
    }
}

__device__ __forceinline__ void build_rope(float2* R16, float2* R8) {
    const int total = T * 16, stride = (int)gridDim.x * NTHREADS;
    for (int i = obid() * NTHREADS + otid(); i < total; i += stride) {
        const int t = i >> 4, idx = i & 15;
        const float ang = (float)t * rope_inv16(idx);
        double sd, cd; sincos_d((double)ang, sd, cd);
        const float2 v = make_float2((float)cd, (float)sd);
        R16[i] = v; if ((idx & 1) == 0) R8[t * 8 + (idx >> 1)] = v;
    }
}
__device__ __forceinline__ void zero_kv_pads(f16* K16, f16* V16, f16* KI16) {
    const int per_b = (TP - T) * (512 + 512 + 64) / 8, total = 4 * per_b, stride = (int)gridDim.x * NTHREADS;
    for (int i = obid() * NTHREADS + otid(); i < total; i += stride) {
        const int b = i / per_b, r = i % per_b; const u32x4 z = {0u, 0u, 0u, 0u};
        if (r < (TP - T) * 64) *(u32x4*)(K16 + ((size_t)b * TP + T) * 512 + (size_t)r * 8) = z;
        else if (r < (TP - T) * 128) *(u32x4*)(V16 + ((size_t)b * TP + T) * 512 + (size_t)(r - (TP - T) * 64) * 8) = z;
        else *(u32x4*)(KI16 + ((size_t)b * TP + T) * 64 + (size_t)(r - (TP - T) * 128) * 8) = z;
    }
}
struct CinOut { f16* Q16; f16* K16; f16* V16; f16* QI16; f16* KI16; float* WI; const float2* R16; const float2* R8; };
__device__ __forceinline__ void rope_lanes(f32x4& v0, f32x4& v1, const float2* tab, int xr, bool active, bool second) {
    const float4 t0 = *(const float4*)(tab), t1 = *(const float4*)(tab + 2), t2 = *(const float4*)(tab + 4), t3 = *(const float4*)(tab + 6);
    const float cs[8] = {t0.x, t0.z, t1.x, t1.z, t2.x, t2.z, t3.x, t3.z}, sn[8] = {t0.y, t0.w, t1.y, t1.w, t2.y, t2.w, t3.y, t3.w};
    const float sg = second ? 1.f : -1.f;
#pragma unroll
    for (int e = 0; e < 4; ++e) {
        const float o0 = __shfl_xor(v0[e], xr), o1 = __shfl_xor(v1[e], xr);
        if (active) { v0[e] = v0[e] * cs[e] + sg * o0 * sn[e]; v1[e] = v1[e] * cs[4 + e] + sg * o1 * sn[4 + e]; }
    }
}
__device__ __forceinline__ void cin_epilogue(const CinOut& o, int r, int c, f32x4 v0, f32x4 v1) {
    const int fq = (threadIdx.x & 63) >> 4, cb = c & ~31;
    const bool valid = r < MREAL, mainrow = r < MMAIN;
    const int t = mainrow ? (r & 2047) + NMETA : (valid ? r - MMAIN : 0), b = r >> 11;
    if (cb < 2560) {
        if ((cb & 127) == 0) rope_lanes(v0, v1, o.R16 + t * 16 + 8 * (fq & 1), 32, true, fq >= 2);
        if (cb < 2048) { if (mainrow) st8h(o.Q16 + (size_t)r * D + c, v0, v1); }
        else if (mainrow) st8h(o.K16 + ((size_t)b * TP + t) * 512 + (c - 2048), v0, v1);
        else if (valid) { for (int bb = 0; bb < 4; ++bb) st8h(o.K16 + ((size_t)bb * TP + t) * 512 + (c - 2048), v0, v1); }
    } else if (cb < 3072) {
        if (mainrow) st8h(o.V16 + ((size_t)b * TP + t) * 512 + (c - 2560), v0, v1);
        else if (valid) { for (int bb = 0; bb < 4; ++bb) st8h(o.V16 + ((size_t)bb * TP + t) * 512 + (c - 2560), v0, v1); }
    } else if (cb < 4096) {
        if ((cb & 63) == 0) rope_lanes(v0, v1, o.R8 + t * 8, 16, fq < 2, fq == 1);
        if (mainrow) st8h(o.QI16 + (size_t)r * 1024 + (c - 3072), v0, v1);
    } else if (cb < 4160) {
        if (cb == 4096) rope_lanes(v0, v1, o.R8 + t * 8, 16, fq < 2, fq == 1);
        if (mainrow) st8h(o.KI16 + ((size_t)b * TP + t) * 64 + (c - 4096), v0, v1);
        else if (valid) { for (int bb = 0; bb < 4; ++bb) st8h(o.KI16 + ((size_t)bb * TP + t) * 64 + (c - 4096), v0, v1); }
    } else if (c < CIN) {
        if (mainrow) { float* w = o.WI + (size_t)r * 16 + (c - 4160); *(f32x4*)w = v0 * 0.03125f; *(f32x4*)(w + 4) = v1 * 0.03125f; }
    }
}

__device__ __forceinline__ void idx_scores(const f16* QI16, const f16* KI16, const float* WI, float* SCORE) {
    const int tid_ = otid(), lane = tid_ & 63, gw = obid() * (NTHREADS / 64) + (tid_ >> 6), ngw = gridDim.x * (NTHREADS / 64);
    for (int q = gw; q < MMAIN; q += ngw) {
        const int b = q >> 11, s = q & 2047, nall = 80 + 64 * (s >> 6);
        const f16* qi = QI16 + (size_t)q * 1024;
        const float* wi = WI + (size_t)q * 16;
        for (int t = lane; t < nall; t += 64) {
            const f16* kp = KI16 + ((size_t)b * TP + t) * 64;
            float4 kv[16];
#pragma unroll
            for (int j = 0; j < 16; ++j) kv[j] = ld4(kp + 4 * j);
            float score = 0.f;
#pragma unroll 1
            for (int h = 0; h < 16; ++h) {
                float dot = 0.f;
#pragma unroll
                for (int j = 0; j < 16; ++j) { const float4 qv = ld4(qi + h * 64 + 4 * j); dot += qv.x * kv[j].x + qv.y * kv[j].y + qv.z * kv[j].z + qv.w * kv[j].w; }
                score += wi[h] * fmaxf(dot, 0.f);
            }
            SCORE[(size_t)q * SROW + t] = score;
        }
    }
}

__device__ __forceinline__ unsigned okey(float f) { const unsigned u = __float_as_uint(f); return (u & 0x80000000u) ? ~u : (u | 0x80000000u); }
__device__ __forceinline__ void select_topk(const float* SCORE, unsigned long long* MASK) {
    const int tid_ = otid(), lane = tid_ & 63, gw = obid() * (NTHREADS / 64) + (tid_ >> 6), ngw = gridDim.x * (NTHREADS / 64);
    for (int q = gw; q < MMAIN; q += ngw) {
        const int s = q & 2047, nall = 80 + 64 * (s >> 6);
        unsigned key[33];
#pragma unroll
        for (int i = 0; i < 33; ++i) { const int t = 64 * i + lane; key[i] = (t < nall) ? okey(SCORE[(size_t)q * SROW + t]) : 0u; }
        unsigned long long mymask = 0ull;
        if (nall <= 256) {
#pragma unroll
            for (int i = 0; i < 33; ++i) { const unsigned long long m = __ballot(64 * i + lane < nall); if (lane == i) mymask = m; }
        } else {
            unsigned tau = 0u;
#pragma unroll 1
            for (int bit = 31; bit >= 0; --bit) {
                const unsigned cand = tau | (1u << bit); int cnt = 0;
#pragma unroll
                for (int i = 0; i < 33; ++i) cnt += __popcll(__ballot(key[i] >= cand));
                if (cnt >= 256) tau = cand;
            }
            int ngt = 0;
#pragma unroll
            for (int i = 0; i < 33; ++i) ngt += __popcll(__ballot(key[i] > tau));
            const int need = 256 - ngt; int eqb = 0;
            const unsigned long long lt = (1ull << lane) - 1ull;
#pragma unroll
            for (int i = 0; i < 33; ++i) {
                const unsigned long long gm = __ballot(key[i] > tau), em = __ballot(key[i] == tau);
                const int rank = eqb + __popcll(em & lt);
                const unsigned long long sm = __ballot(key[i] == tau && rank < need);
                if (lane == i) mymask = gm | sm;
                eqb += __popcll(em);
            }
        }
        if (lane < 33) MASK[(size_t)q * 33 + lane] = mymask;
    }
}

constexpr int IDX_WAVE_LDS = 2 * TP * 4;
__device__ __forceinline__ unsigned long long select_row(const LAS float* srow, int nall, int lane) {
    unsigned key[33];
#pragma unroll
    for (int i = 0; i < 33; ++i) { const int t = 64 * i + lane; key[i] = (t < nall) ? okey(srow[t]) : 0u; }
    unsigned long long mymask = 0ull;
    unsigned tau = 0u;
#pragma unroll 1
    for (int bit = 31; bit >= 0; --bit) {
        const unsigned cand = tau | (1u << bit); int cnt = 0;
#pragma unroll
        for (int i = 0; i < 33; ++i) cnt += __popcll(__ballot(key[i] >= cand));
        if (cnt >= 256) tau = cand;
    }
    int ngt = 0;
#pragma unroll
    for (int i = 0; i < 33; ++i) ngt += __popcll(__ballot(key[i] > tau));
    const int need = 256 - ngt; int eqb = 0;
    const unsigned long long lt = (1ull << lane) - 1ull;
#pragma unroll
    for (int i = 0; i < 33; ++i) {
        const unsigned long long gm = __ballot(key[i] > tau), em = __ballot(key[i] == tau);
        const int rank = eqb + __popcll(em & lt);
        const unsigned long long sm = __ballot(key[i] == tau && rank < need);
        if (lane == i) mymask = gm | sm;
        eqb += __popcll(em);
    }
    return mymask;
}
__device__ __forceinline__ void index_select(const f16* QI16, const f16* KI16, const float* WI, unsigned long long* MASK, LAS unsigned char* lds) {
    const int tid_ = otid(), lane = tid_ & 63, wv = __builtin_amdgcn_readfirstlane(tid_ >> 6), l15 = lane & 15, g2 = lane >> 4;
    const int gw = obid() * (NTHREADS / 64) + wv;
    LAS float* SL = (LAS float*)(lds + wv * IDX_WAVE_LDS);
    if (gw >= 2048) return;
    const int b = gw >> 9, wq = gw & 511;
#pragma unroll 1
    for (int it = 0; it < 2; ++it) {
        const int u = (it == 0) ? wq : 1023 - wq, s0 = 2 * u, q0 = b * SEQ + s0, nall = 80 + 64 * (s0 >> 6);
        if (nall <= 256) {
            if (lane < 33) { const int lo = 64 * lane; const unsigned long long m = (nall >= lo + 64) ? ~0ull : (nall > lo ? ((1ull << (nall - lo)) - 1ull) : 0ull);
                MASK[(size_t)q0 * 33 + lane] = m; MASK[(size_t)(q0 + 1) * 33 + lane] = m; }
            continue;
        }
        f16x8 a[2][2]; float w[2][4];
#pragma unroll
        for (int qq = 0; qq < 2; ++qq) {
#pragma unroll
            for (int ks = 0; ks < 2; ++ks) a[qq][ks] = *(const f16x8*)(QI16 + (size_t)(q0 + qq) * 1024 + l15 * 64 + 32 * ks + 8 * g2);
            const float4 ww = ld4(WI + (size_t)(q0 + qq) * 16 + 4 * g2); w[qq][0] = ww.x; w[qq][1] = ww.y; w[qq][2] = ww.z; w[qq][3] = ww.w;
        }
        const int nkb = nall >> 4;
        const f16* kbase = KI16 + (size_t)b * TP * 64 + l15 * 64 + 8 * g2;
#pragma unroll 1
        for (int kb = 0; kb < nkb; kb += 2) {
            f16x8 bf[2][2];
#pragma unroll
            for (int e = 0; e < 2; ++e)
#pragma unroll
                for (int ks = 0; ks < 2; ++ks) bf[e][ks] = *(const f16x8*)(kbase + (size_t)(kb + e) * 16 * 64 + 32 * ks);
            f32x4 acc[2][2];
#pragma unroll
            for (int e = 0; e < 2; ++e)
#pragma unroll
                for (int qq = 0; qq < 2; ++qq) {
                    acc[e][qq] = __builtin_amdgcn_mfma_f32_16x16x32_f16(a[qq][0], bf[e][0], (f32x4){0.f, 0.f, 0.f, 0.f}, 0, 0, 0);
                    acc[e][qq] = __builtin_amdgcn_mfma_f32_16x16x32_f16(a[qq][1], bf[e][1], acc[e][qq], 0, 0, 0);
                }
            __builtin_amdgcn_sched_barrier(0);
            asm volatile("s_nop 15\n\ts_nop 15" ::: "memory");
            __builtin_amdgcn_sched_barrier(0);
#pragma unroll
            for (int e = 0; e < 2; ++e)
#pragma unroll
                for (int qq = 0; qq < 2; ++qq) {
                    const f32x4 c = acc[e][qq];
                    float sc = w[qq][0] * fmaxf(c[0], 0.f) + w[qq][1] * fmaxf(c[1], 0.f) + w[qq][2] * fmaxf(c[2], 0.f) + w[qq][3] * fmaxf(c[3], 0.f);
                    sc += __shfl_xor(sc, 16); sc += __shfl_xor(sc, 32);
                    if (g2 == 0) SL[qq * TP + (kb + e) * 16 + l15] = sc;
                }
        }
        asm volatile("" ::: "memory");
#pragma unroll 1
        for (int qq = 0; qq < 2; ++qq) {
            const unsigned long long m = select_row(SL + qq * TP, nall, lane);
            if (lane < 33) MASK[(size_t)(q0 + qq) * 33 + lane] = m;
        }
        asm volatile("" ::: "memory");
    }
}

__device__ __forceinline__ void attn_naive(float* lds, const f16* Q16, const f16* K16, const f16* V16, const unsigned long long* MASK, f16* O) {
    const int tid_ = otid(), lane = tid_ & 63, wv = tid_ >> 6, gw = obid() * (NTHREADS / 64) + wv, ngw = gridDim.x * (NTHREADS / 64);
    int* list = (int*)(lds + wv * 640);
    float* pl = lds + wv * 640 + 256;
    float* ql = lds + wv * 640 + 512;
    for (int item = gw; item < MMAIN * 16; item += ngw) {
        const int q = item >> 4, hq = item & 15, b = q >> 11, kvh = hq >> 2;
        int base = 0;
        for (int i = 0; i < 33; ++i) {
            const unsigned long long w = MASK[(size_t)q * 33 + i];
            if ((w >> lane) & 1ull) list[base + __popcll(w & ((1ull << lane) - 1ull))] = 64 * i + lane;
            base += __popcll(w);
        }
        const int nk = base;
        const f16* qp = Q16 + (size_t)q * D + hq * 128;
        ql[lane] = (float)qp[lane]; ql[64 + lane] = (float)qp[64 + lane];
        __builtin_amdgcn_s_waitcnt(0); __builtin_amdgcn_wave_barrier();
        float lg[4]; float mx = -INFINITY;
#pragma unroll
        for (int j = 0; j < 4; ++j) {
            const int kk = lane + 64 * j; lg[j] = -INFINITY;
            if (kk < nk) {
                const f16* kp = K16 + ((size_t)b * TP + list[kk]) * 512 + kvh * 128;
                float dot = 0.f;
#pragma unroll 4
                for (int d = 0; d < 128; d += 4) { const float4 kv = ld4(kp + d); dot += kv.x * ql[d] + kv.y * ql[d + 1] + kv.z * ql[d + 2] + kv.w * ql[d + 3]; }
                lg[j] = dot * 0.08838834764831845f;
            }
            mx = fmaxf(mx, lg[j]);
        }
        mx = wave_max(mx);
        float sm = 0.f;
#pragma unroll
        for (int j = 0; j < 4; ++j) { const int kk = lane + 64 * j; const float e = (kk < nk) ? expf(lg[j] - mx) : 0.f; sm += e; pl[kk] = e; }
        sm = wave_sum(sm);
        __builtin_amdgcn_s_waitcnt(0); __builtin_amdgcn_wave_barrier();
        float o0 = 0.f, o1 = 0.f;
#pragma unroll 2
        for (int kk = 0; kk < nk; ++kk) {
            const f16* vp = V16 + ((size_t)b * TP + list[kk]) * 512 + kvh * 128;
            const float pw = pl[kk];
            o0 = fmaf(pw, (float)vp[lane], o0); o1 = fmaf(pw, (float)vp[64 + lane], o1);
        }
        const float inv = 1.f / sm;
        O[(size_t)q * D + hq * 128 + lane] = (f16)(o0 * inv); O[(size_t)q * D + hq * 128 + 64 + lane] = (f16)(o1 * inv);
        __builtin_amdgcn_s_waitcnt(0); __builtin_amdgcn_wave_barrier();
    }
}

namespace att {
typedef short s16x4 __attribute__((ext_vector_type(4)));
typedef short s16x8 __attribute__((ext_vector_type(8)));
typedef float f32x16 __attribute__((ext_vector_type(16)));
typedef unsigned long long u64;
constexpr int NW = 8, QBLK = 32, KVBLK = 64, QS = 2048, KS = 512;
constexpr int SHM_V = KVBLK * 128 * 2, SHM_K = KVBLK * 128 * 2;
constexpr int LDS_BYTES = 2 * SHM_V + 2 * SHM_K + NW * 64 * 4;
constexpr float SCALE = 0.08838834764831845f, THR = 8.f;
#define AT_KSWZ(row, colB) ((row) * 256 + ((colB) ^ (((row) & 7) << 4)))
#define AT_SBAR() __builtin_amdgcn_sched_barrier(0)
__device__ __forceinline__ int v_st(int k, int c) { const int kk = (k & ~0xC) | ((k & 4) << 1) | ((k & 8) >> 1); return ((kk >> 3) * 4 + (c >> 5)) * 512 + ((kk & 7) * 32 + (c & 31)) * 2; }
__device__ __forceinline__ int v_rd_base(int lane) { return ((lane & 3) << 3) | (((lane >> 2) & 3) << 6) | (((lane >> 4) & 1) << 5) | (((lane >> 5) & 1) << 8); }
constexpr int v_rd_off(int d0, int ks, int half) { return d0 * 512 + ks * 4096 + half * 2048; }
__device__ __forceinline__ int crow(int r, int hi) { return (r & 3) + 8 * (r >> 2) + 4 * hi; }
__device__ __forceinline__ f16x8 load8(const f16* p) { return *(const f16x8*)p; }
__device__ __forceinline__ void mask_bits(f32x16& p0, f32x16& p1, u64 w, int hi) {
    const float NEG = -__builtin_inff();
    const unsigned lo = (unsigned)w >> (4 * hi), up = (unsigned)(w >> 32) >> (4 * hi);
#pragma unroll
    for (int r = 0; r < 16; ++r) {
        const int c = (r & 3) + 8 * (r >> 2);
        if (!((lo >> c) & 1u)) p0[r] = NEG;
        if (!((up >> c) & 1u)) p1[r] = NEG;
    }
}
__device__ __forceinline__ void partialSM(f32x16& p0, f32x16& p1, float& m_reg, float& mn, float& alpha) {
    float pmax = p0[0];
#pragma unroll
    for (int r = 1; r < 16; ++r) pmax = fmaxf(pmax, p0[r]);
#pragma unroll
    for (int r = 0; r < 16; ++r) pmax = fmaxf(pmax, p1[r]);
    { auto rr = __builtin_amdgcn_permlane32_swap(__float_as_uint(pmax), __float_as_uint(pmax), false, false);
      pmax = fmaxf(__uint_as_float(rr[0]), __uint_as_float(rr[1])); }
    constexpr float C2 = 1.4426950408889634f * SCALE;
    if (__builtin_expect(__all((pmax - m_reg) * SCALE <= THR), 1)) { mn = m_reg; alpha = 1.f; }
    else { mn = fmaxf(m_reg, pmax); alpha = __builtin_amdgcn_exp2f((m_reg - mn) * C2); m_reg = mn; }
    const float mnL = -mn * C2;
#pragma unroll
    for (int r = 0; r < 16; ++r) p0[r] = fmaf(p0[r], C2, mnL);
#pragma unroll
    for (int r = 0; r < 16; ++r) p1[r] = fmaf(p1[r], C2, mnL);
#pragma unroll
    for (int r = 0; r < 16; ++r) p0[r] = __builtin_amdgcn_exp2f(p0[r]);
}
__device__ __forceinline__ void finishSM(f32x16& p0, f32x16& p1, float alpha, float& l_reg, f16x8& pa0, f16x8& pa1, f16x8& pa2, f16x8& pa3) {
#pragma unroll
    for (int r = 0; r < 16; ++r) p1[r] = __builtin_amdgcn_exp2f(p1[r]);
    float ps = 0;
#pragma unroll
    for (int r = 0; r < 16; ++r) ps += p0[r];
#pragma unroll
    for (int r = 0; r < 16; ++r) ps += p1[r];
    { auto rr = __builtin_amdgcn_permlane32_swap(__float_as_uint(ps), __float_as_uint(ps), false, false);
      ps = __uint_as_float(rr[0]) + __uint_as_float(rr[1]); }
    l_reg = l_reg * alpha + ps;
#define AT_PK4(P, B_, OUT) do { unsigned a0 = pk2h(P[B_+0], P[B_+1]), a1 = pk2h(P[B_+2], P[B_+3]);                          \
        unsigned b0 = pk2h(P[B_+4], P[B_+5]), b1 = pk2h(P[B_+6], P[B_+7]);                                             \
        auto r0 = __builtin_amdgcn_permlane32_swap(a0, b0, false, false); auto r1 = __builtin_amdgcn_permlane32_swap(a1, b1, false, false); \
        u32x4 w_ = {r0[0], r1[0], r0[1], r1[1]}; OUT = __builtin_bit_cast(f16x8, w_); } while (0)
    AT_PK4(p0, 0, pa0); AT_PK4(p0, 8, pa1); AT_PK4(p1, 0, pa2); AT_PK4(p1, 8, pa3);
#undef AT_PK4
}
template <int KB>
__device__ __forceinline__ void qkt(f32x16& p0, f32x16& p1, LAS const unsigned char* K_lds, int r32, int hi, const f16x8* qr) {
    p0 = f32x16{}; p1 = f32x16{};
    LAS const unsigned char* kb[4];
#pragma unroll
    for (int dd = 0; dd < 4; ++dd) kb[dd] = K_lds + KB * SHM_K + AT_KSWZ(r32, (dd * 16 + hi * 8) * 2);
#pragma unroll
    for (int d0 = 0; d0 < 8; ++d0) { LAS const unsigned char* a = kb[d0 & 3] + (d0 >> 2) * 128;
        const f16x8 b0 = *(LAS const f16x8*)a;
        const f16x8 b1 = *(LAS const f16x8*)(a + 32 * 256);
        p0 = __builtin_amdgcn_mfma_f32_32x32x16_f16(b0, qr[d0], p0, 0, 0, 0);
        p1 = __builtin_amdgcn_mfma_f32_32x32x16_f16(b1, qr[d0], p1, 0, 0, 0); }
}
template <int VB>
__device__ __forceinline__ void pv_tile(f32x16* o, int vb0, f16x8 pa0, f16x8 pa1, f16x8 pa2, f16x8 pa3) {
#define AT_TRRD(dst, off) asm volatile("ds_read_b64_tr_b16 %0, %1 offset:%2" : "=&v"(dst) : "v"(vb0), "i"(off) : "memory")
#define AT_CAT(l, h) __builtin_bit_cast(f16x8, (s16x8){l[0], l[1], l[2], l[3], h[0], h[1], h[2], h[3]})
#define AT_PV_D0(d0) do { s16x4 l0, l1, l2, l3, h0, h1, h2, h3; constexpr int b_ = VB * SHM_V + v_rd_off(d0, 0, 0); \
        AT_TRRD(l0, b_); AT_TRRD(h0, b_ + 2048); AT_TRRD(l1, b_ + 4096); AT_TRRD(h1, b_ + 6144); AT_TRRD(l2, b_ + 8192); AT_TRRD(h2, b_ + 10240); AT_TRRD(l3, b_ + 12288); AT_TRRD(h3, b_ + 14336); \
        asm volatile("s_waitcnt lgkmcnt(0)" ::: "memory"); AT_SBAR();   \
        o[d0] = __builtin_amdgcn_mfma_f32_32x32x16_f16(pa0, AT_CAT(l0, h0), o[d0], 0, 0, 0);   \
        o[d0] = __builtin_amdgcn_mfma_f32_32x32x16_f16(pa1, AT_CAT(l1, h1), o[d0], 0, 0, 0);   \
        o[d0] = __builtin_amdgcn_mfma_f32_32x32x16_f16(pa2, AT_CAT(l2, h2), o[d0], 0, 0, 0);   \
        o[d0] = __builtin_amdgcn_mfma_f32_32x32x16_f16(pa3, AT_CAT(l3, h3), o[d0], 0, 0, 0); } while (0)
    AT_PV_D0(0); AT_PV_D0(1); AT_PV_D0(2); AT_PV_D0(3);
#undef AT_PV_D0
#undef AT_CAT
#undef AT_TRRD
}
struct BlockRef { const f16* Q; const f16* K; const f16* V; f16* O; const u64* M; int NT; };
struct Seam { f16x8 qr[8]; f16x8 st_v0, st_v1, st_k0, st_k1; };
#define AT_ROW(p, k0, rr) ((p) + (size_t)((k0) + (rr)) * KS + sc)
#define AT_VMW() asm volatile("s_waitcnt vmcnt(0)" ::: "memory")
#define AT_VMWN(n) asm volatile("s_waitcnt vmcnt(%0)" :: "i"(n) : "memory")
#define AT_SLOAD_H(Kp, Vp, k0) do { S.st_v0 = load8(AT_ROW(Vp, k0, sr)); S.st_v1 = load8(AT_ROW(Vp, k0, 32 + sr)); S.st_k0 = load8(AT_ROW(Kp, k0, sr)); S.st_k1 = load8(AT_ROW(Kp, k0, 32 + sr)); } while (0)
#define AT_SWRITE_HK(bf) do { *(LAS f16x8*)(K_lds + (bf) * SHM_K + kws) = S.st_k0; *(LAS f16x8*)(K_lds + (bf) * SHM_K + kws + 32 * 256) = S.st_k1; } while (0)
#define AT_SWRITE_HV(bf) do { *(LAS f16x8*)(V_lds + (bf) * SHM_V + vst0) = S.st_v0; *(LAS f16x8*)(V_lds + (bf) * SHM_V + vst1) = S.st_v1; } while (0)
#define AT_SWRITE_H(bf) do { AT_SWRITE_HV(bf); AT_SWRITE_HK(bf); } while (0)
__device__ __forceinline__ void prime(const BlockRef& cur, LAS unsigned char* lds, Seam& S) {
    const int tid = otid(), wid = __builtin_amdgcn_readfirstlane(tid >> 6), lane = tid & 63, r32 = lane & 31, hi = lane >> 5;
    const int sr = tid >> 4, sc = (tid & 15) * 8, kws = AT_KSWZ(sr, sc * 2); LAS unsigned char* K_lds = lds + 2 * SHM_V;
#pragma unroll
    for (int d0 = 0; d0 < 8; ++d0) S.qr[d0] = load8(cur.Q + (size_t)(wid * QBLK + r32) * QS + d0 * 16 + hi * 8);
    AT_SLOAD_H(cur.K, cur.V, 0); AT_VMW(); AT_SWRITE_HK(0);
    __syncthreads();
}
__device__ __forceinline__ void block(const BlockRef& cur, const BlockRef& nxt, LAS unsigned char* lds, Seam& S) {
    const int tid = otid(), wid = __builtin_amdgcn_readfirstlane(tid >> 6), lane = tid & 63, r32 = lane & 31, hi = lane >> 5;
    const int NT = cur.NT;
    LAS unsigned char* V_lds = lds; LAS unsigned char* K_lds = lds + 2 * SHM_V;
    LAS float* ws = (LAS float*)(lds + 2 * SHM_V + 2 * SHM_K) + wid * 64; LAS float* li_l = ws; LAS float* al_l = ws + 32;
    float m_reg = -1e30f, l_reg = 0; f32x16 o[4] = {};
    const int sr = tid >> 4, sc = (tid & 15) * 8, vst0 = v_st(sr, sc), vst1 = v_st(32 + sr, sc), kws = AT_KSWZ(sr, sc * 2);
    const int vb0 = (int)(unsigned)(size_t)V_lds + v_rd_base(lane);
    const f16* Kh = cur.K; const f16* Vh = cur.V;
    const u64* mrow = cur.M + (size_t)(wid * QBLK + r32) * 33;
    u64 mw;
#define AT_RESC(a) do { if (__any((a) < 1.f)) { if (hi == 0) al_l[r32] = (a); asm volatile("s_waitcnt lgkmcnt(0)" ::: "memory");              \
                     for (int d_ = 0; d_ < 4; ++d_) for (int r = 0; r < 16; ++r) o[d_][r] *= al_l[crow(r, hi)]; } } while (0)
#define AT_KBASE(t) ((t) * KVBLK)
#define AT_SEAM_K0() do { AT_VMWN(8); AT_SWRITE_HK(0); AT_SBAR(); } while (0)
    f32x16 pA0, pA1, pB0, pB1; float mnA, mnB, alA, alB; f16x8 pa0, pa1, pa2, pa3;
    AT_SWRITE_HV(0); AT_SBAR();
    mw = mrow[0];
    if (NT > 1) { AT_SLOAD_H(Kh, Vh, AT_KBASE(1)); }
    AT_SBAR(); qkt<0>(pA0, pA1, K_lds, r32, hi, S.qr);
    mask_bits(pA0, pA1, mw, hi); partialSM(pA0, pA1, m_reg, mnA, alA);
    if (NT > 1) { AT_VMW(); AT_SWRITE_H(1); }
    __syncthreads();
#define AT_HALF_STEP(PX0, PX1, mnX, alX, PY0, PY1, alY, t, KB, VB, SB) do {                                                      \
        AT_SBAR(); mw = mrow[(t)]; qkt<KB>(PX0, PX1, K_lds, r32, hi, S.qr);                                             \
        finishSM(PY0, PY1, alY, l_reg, pa0, pa1, pa2, pa3); AT_SBAR();                                                           \
        if ((t) + 1 < NT) { AT_SLOAD_H(Kh, Vh, AT_KBASE((t) + 1)); AT_SBAR(); }                                               \
        pv_tile<VB>(o, vb0, pa0, pa1, pa2, pa3); mask_bits(PX0, PX1, mw, hi); partialSM(PX0, PX1, m_reg, mnX, alX);                                        \
        __syncthreads();                                                                                                      \
        if ((t) + 1 < NT) { AT_VMW(); AT_SWRITE_H(SB); }                                                                          \
        AT_RESC(alX); __syncthreads(); } while (0)
    for (int t = 1; t + 1 < NT; t += 2) {
        AT_HALF_STEP(pB0, pB1, mnB, alB, pA0, pA1, alA, t, 1, 0, 0);
        AT_HALF_STEP(pA0, pA1, mnA, alA, pB0, pB1, alB, t + 1, 0, 1, 1);
    }
    const bool even = (NT & 1) == 0;
    if (even) { AT_SBAR(); mw = mrow[NT - 1]; qkt<1>(pB0, pB1, K_lds, r32, hi, S.qr); AT_SBAR(); }
    AT_SLOAD_H(nxt.K, nxt.V, 0); AT_SBAR();
#pragma unroll
    for (int d0 = 0; d0 < 8; ++d0) S.qr[d0] = load8(nxt.Q + (size_t)(wid * QBLK + r32) * QS + d0 * 16 + hi * 8);
    AT_SBAR();
    finishSM(pA0, pA1, alA, l_reg, pa0, pa1, pa2, pa3); AT_SBAR();
    pv_tile<0>(o, vb0, pa0, pa1, pa2, pa3);
    if (even) { mask_bits(pB0, pB1, mw, hi); partialSM(pB0, pB1, m_reg, mnB, alB); __syncthreads(); AT_RESC(alB);
        finishSM(pB0, pB1, alB, l_reg, pa0, pa1, pa2, pa3); AT_SBAR(); pv_tile<1>(o, vb0, pa0, pa1, pa2, pa3); }
    AT_SBAR(); AT_SEAM_K0();
    if (hi == 0) li_l[r32] = l_reg; asm volatile("s_waitcnt lgkmcnt(0)" ::: "memory");
    float rli[16];
#pragma unroll
    for (int r = 0; r < 16; ++r) rli[r] = __builtin_amdgcn_rcpf(li_l[crow(r, hi)]);
    f16* Ow = cur.O + (size_t)(wid * QBLK) * QS;
#pragma unroll
    for (int r = 0; r < 16; ++r) { const int orow = crow(r, hi);
#pragma unroll
        for (int d0 = 0; d0 < 4; ++d0) { const float v = o[d0][r] * rli[r];
            const float vn = __shfl_xor(v, 1);
            if ((r32 & 1) == 0) *(unsigned*)(Ow + (size_t)orow * QS + d0 * 32 + r32) = pk2h(v, vn); } }
    __syncthreads();
#undef AT_RESC
#undef AT_KBASE
#undef AT_SEAM_K0
#undef AT_HALF_STEP
}
#undef AT_ROW
#undef AT_VMW
#undef AT_VMWN
#undef AT_SLOAD_H
#undef AT_SWRITE_HK
#undef AT_SWRITE_HV
#undef AT_SWRITE_H
}
__device__ __forceinline__ att::BlockRef att_unit(const f16* Q16, const f16* K16, const f16* V16, const unsigned long long* MASK, f16* O16, int b, int h, int x) {
    att::BlockRef r; const size_t row0 = (size_t)b * SEQ + 256 * x; const int kvh = h >> 2;
    r.Q = Q16 + row0 * D + h * 128; r.K = K16 + (size_t)b * TP * 512 + kvh * 128; r.V = V16 + (size_t)b * TP * 512 + kvh * 128;
    r.O = O16 + row0 * D + h * 128; r.M = MASK + row0 * 33; r.NT = 4 * x + 5; return r;
}
__device__ __forceinline__ void attn_phase(LAS unsigned char* lds, const f16* Q16, const f16* K16, const f16* V16, const unsigned long long* MASK, f16* O16) {
    const int bid = obid();
    if (bid < 256) {
        const int xcd = bid & 7, j = bid >> 3, combo = xcd * 2 + (j & 1), item = j >> 1, hl = item >> 2, pp = item & 3;
        const int b = combo >> 2, kvh = combo & 3, h = kvh * 4 + hl;
        const att::BlockRef u0 = att_unit(Q16, K16, V16, MASK, O16, b, h, 7 - pp), u1 = att_unit(Q16, K16, V16, MASK, O16, b, h, pp);
        att::Seam S;
        att::prime(u0, lds, S);
        att::block(u0, u1, lds, S);
        att::block(u1, u1, lds, S);
    }
}

template <class F>
__device__ __forceinline__ void gemm(LAS unsigned char* lds, const f16* A, int lda, const f16* Bt, int ldb, int M, int N, int K, int cu, F f) {
    pg8::Gemm g{A, Bt, M, N, K, lda, ldb};
    pg8::StaticOrder S; S.init(M, N, (int)gridDim.x, cu);
    pg8::EpiRow8<F> E{f};
    pg8::gemm_phase<pg8::EpiRow8<F>, pg8::StaticOrder, true, true>(lds, g, S, E);
}

template <class F>
__device__ __forceinline__ void skinny_group(LAS unsigned char* lds, const f16* A, int lda, const f16* Bt, int ldb, int K, int n0, F f) {
    const int tid = otid(), lane = tid & 63, wv = __builtin_amdgcn_readfirstlane(tid >> 6), l15 = lane & 15, g2 = lane >> 4;
    const f16* ap = A + (size_t)l15 * lda + 8 * g2;
    const f16* bp = Bt + (size_t)(n0 + 16 * wv + l15) * ldb + 8 * g2;
    f32x4 acc0 = {0.f, 0.f, 0.f, 0.f}, acc1 = {0.f, 0.f, 0.f, 0.f};
#pragma unroll 4
    for (int k = 0; k < K; k += 64) {
        const f16x8 a0 = *(const f16x8*)(ap + k), b0 = *(const f16x8*)(bp + k), a1 = *(const f16x8*)(ap + k + 32), b1 = *(const f16x8*)(bp + k + 32);
        acc0 = __builtin_amdgcn_mfma_f32_16x16x32_f16(a0, b0, acc0, 0, 0, 0);
        acc1 = __builtin_amdgcn_mfma_f32_16x16x32_f16(a1, b1, acc1, 0, 0, 0);
    }
    __builtin_amdgcn_sched_barrier(0);
    asm volatile("s_nop 15\n\ts_nop 15" ::: "memory");
    __builtin_amdgcn_sched_barrier(0);
    const f32x4 acc = acc0 + acc1;
    LAS float* Tl = (LAS float*)lds;
#pragma unroll
    for (int j = 0; j < 4; ++j) Tl[(4 * g2 + j) * 132 + 16 * wv + l15] = acc[j];
    __syncthreads();
    const int row = tid >> 5, c4 = (tid & 31) * 4;
    const f32x4 v = *(const LAS f32x4*)(Tl + row * 132 + c4);
    f(row, n0 + c4, v, (const LAS float*)Tl);
    __syncthreads();
}
__device__ __forceinline__ void st4hv(f16* p, f32x4 v) { uint2 r; r.x = pk2h(v[0], v[1]); r.y = pk2h(v[2], v[3]); *(uint2*)p = r; }

#define XB_TMO      128
#define XB_XCNT(j)  (256  + 64 * (j))
#define XB_XSUB(j)  (1280 + 64 * (j))
#define XB_XGEN(j)  (2304 + 64 * (j))
#define XB_TOP      3328
#define XB_TOPGEN   3392
#define XCD_BAR_WORDS 3456
#define XB_SPIN_CAP (1u << 18)

__device__ __forceinline__ unsigned xb_ld(unsigned* p)              { return __hip_atomic_load(p, __ATOMIC_RELAXED, __HIP_MEMORY_SCOPE_AGENT); }
__device__ __forceinline__ unsigned xb_add(unsigned* p, unsigned v) { return __hip_atomic_fetch_add(p, v, __ATOMIC_RELAXED, __HIP_MEMORY_SCOPE_AGENT); }
__device__ __forceinline__ unsigned xb_xcc_id() { return (unsigned)__builtin_amdgcn_s_getreg((3 << 11) | 20) & 0xFu; }
#define XB_SPIN(cond, bar) do { unsigned _sp = 0; while (cond) { __builtin_amdgcn_s_sleep(1); \
    if ((++_sp & 255u) == 0u) { if (xb_ld(&(bar)[XB_TMO])) break; if (_sp > XB_SPIN_CAP) { atomicAdd(&(bar)[XB_TMO], 1u); break; } } } } while (0)

struct XcdBarrier {
    unsigned* bar; unsigned x;
    volatile LAS unsigned* st;
};

__device__ __forceinline__ XcdBarrier xcd_barrier_post(unsigned* bar, volatile LAS unsigned* st) {
    XcdBarrier b; b.bar = bar; b.x = xb_xcc_id(); b.st = st;
    if (threadIdx.x == 0) (void)xb_add(&bar[XB_XCNT(b.x)], 1u);
    return b;
}
__device__ __forceinline__ void xcd_barrier_complete(unsigned* bar, unsigned x, unsigned& nloc, unsigned& nx) {
    const unsigned G = gridDim.x * gridDim.y * gridDim.z;
    unsigned sum, cnt, mine, sp = 0u;
    for (;;) {
        sum = 0u; cnt = 0u; mine = 0u;
#pragma unroll
        for (unsigned j = 0; j < 16; ++j) { const unsigned c = xb_ld(&bar[XB_XCNT(j)]); sum += c; cnt += (c > 0u) ? 1u : 0u; mine = (j == x) ? c : mine; }
        if (sum == G) break;
        __builtin_amdgcn_s_sleep(1);
        if ((++sp & 255u) == 0u) { if (xb_ld(&bar[XB_TMO])) break; if (sp > XB_SPIN_CAP) { atomicAdd(&bar[XB_TMO], 1u); break; } }
    }
    nloc = mine > 0u ? mine : 1u; nx = cnt > 0u ? cnt : 1u;
}

__device__ __forceinline__ void xcd_barrier(const XcdBarrier& b) {
    asm volatile("s_waitcnt vmcnt(0)" ::: "memory");
    __syncthreads();
    if (threadIdx.x == 0) {
        unsigned* bar = b.bar;
        __builtin_amdgcn_s_waitcnt(0);
        unsigned nloc = b.st[0], nx = b.st[1];
        if (nloc == 0u) { xcd_barrier_complete(bar, b.x, nloc, nx); b.st[0] = nloc; b.st[1] = nx; }
        const unsigned old = xb_add(&bar[XB_XSUB(b.x)], 1u);
        const unsigned gen = old / nloc;
        if (old + 1u == (gen + 1u) * nloc) {
            __builtin_amdgcn_fence(__ATOMIC_RELEASE, "agent");
            asm volatile("s_waitcnt vmcnt(0)" ::: "memory");
            const unsigned og = xb_add(&bar[XB_TOP], 1u);
            const unsigned tg = og / nx;
            if (og + 1u == (tg + 1u) * nx) xb_add(&bar[XB_TOPGEN], 1u);
            else XB_SPIN(xb_ld(&bar[XB_TOPGEN]) == tg, bar);
            __builtin_amdgcn_fence(__ATOMIC_ACQUIRE, "agent");
            xb_add(&bar[XB_XGEN(b.x)], 1u);
            asm volatile("s_waitcnt vmcnt(0)" ::: "memory");
        } else {
            XB_SPIN(xb_ld(&bar[XB_XGEN(b.x)]) == gen, bar);
            __builtin_amdgcn_fence(__ATOMIC_ACQUIRE, "agent");
            asm volatile("s_waitcnt vmcnt(0)" ::: "memory");
        }
    }
    __syncthreads();
}

__global__ void __launch_bounds__(NTHREADS, 2) fwd(Params p) {
    cg::grid_group grid = cg::this_grid();
    extern __shared__ __attribute__((aligned(16))) unsigned char smem[];
    LAS unsigned char* lds = (LAS unsigned char*)smem;
    float* ldsf = (float*)smem;
    unsigned char* ws = p.ws;
    float* H = (float*)(ws + OFF_H); f16* A16 = (f16*)(ws + OFF_A16); f16* U16 = (f16*)(ws + OFF_U16);
    f16* DY16 = (f16*)(ws + OFF_DY16); f16* CAT16 = (f16*)(ws + OFF_CAT16);
    f16* HID16 = (f16*)(ws + OFF_BIG);
    CinOut co{(f16*)(ws + OFF_Q16), (f16*)(ws + OFF_K16), (f16*)(ws + OFF_V16), (f16*)(ws + OFF_QI16), (f16*)(ws + OFF_KI16), (float*)(ws + OFF_WI), (const float2*)(ws + OFF_ROPE16), (const float2*)(ws + OFF_ROPE8)};
    float* SCORE = (float*)(ws + OFF_SCORE); unsigned long long* MASK = (unsigned long long*)(ws + OFF_MASK); f16* O16 = (f16*)(ws + OFF_O16);
    const float* ng = p.in[I_NORMG];
    const int bid = (int)blockIdx.x, G = (int)gridDim.x;
    volatile LAS unsigned* bst = (volatile LAS unsigned*)(lds + LDS_BYTES - 64);
    if (threadIdx.x < 16) bst[threadIdx.x] = 0u;
    __syncthreads();
    const XcdBarrier xbar = xcd_barrier_post((unsigned*)(ws + OFF_BAR), bst);

    convert_weights(p, ldsf);
    init_rows(p, H, A16);
    build_rope((float2*)(ws + OFF_ROPE16), (float2*)(ws + OFF_ROPE8));
    grid.sync();
    const f16* A16m = A16 + (size_t)MMAIN * D; f16* U16m = U16 + (size_t)MMAIN * D; const f16* DY16m = DY16 + (size_t)MMAIN * D; f16* CAT16m = CAT16 + (size_t)MMAIN * D; f16* HID16m = HID16 + (size_t)MMAIN * DFF;
    for (int gi = bid; gi < 16; gi += G)
        skinny_group(lds, A16m, D, (const f16*)(ws + W_IN), D, D, 128 * gi, [=](int r, int c, f32x4 v, const LAS float*) { st4hv(U16m + (size_t)r * D + c, v); });
    gemm(lds, A16, D, (const f16*)(ws + W_IN), D, MMAIN, D, D, bid, [=](int r, int c, f32x4 v0, f32x4 v1) { st8h(U16 + (size_t)r * D + c, v0, v1); });
    xcd_barrier(xbar);
    pool_diff(U16, DY16);
    ssm_phase(p, U16, DY16, lds);
    xcd_barrier(xbar);
    for (int gi = bid; gi < 16; gi += G) {
        if (gi < 8) { const int g = gi >> 1, n0 = 128 * (gi & 1); const float* ps = p.in[I_POOLS] + g * 256;
            skinny_group(lds, DY16m + g * 256, D, (const f16*)(ws + W_POOL) + (size_t)g * 65536, 256, 256, n0,
                         [=](int r, int c, f32x4 v, const LAS float*) { st4hv(CAT16m + (size_t)r * D + g * 256 + c, v * *(const f32x4*)(ps + c)); });
        } else {
            skinny_group(lds, DY16m + 1024, D, (const f16*)(ws + W_GLU), 1024, 1024, 128 * (gi - 8), [=](int r, int c, f32x4 v, const LAS float*) {
                const float4 y = ld4(DY16m + (size_t)r * D + 1024 + c);
                f32x4 o; o[0] = y.x / (1.f + __expf(-v[0])); o[1] = y.y / (1.f + __expf(-v[1])); o[2] = y.z / (1.f + __expf(-v[2])); o[3] = y.w / (1.f + __expf(-v[3]));
                st4hv(CAT16m + (size_t)r * D + 1024 + c, o); });
        }
    }
    for (int g = 0; g < 4; ++g) {
        const float* ps = p.in[I_POOLS] + g * 256;
        gemm(lds, DY16 + g * 256, D, (const f16*)(ws + W_POOL) + (size_t)g * 65536, 256, MMAIN, 256, 256, (bid + G - 32 * g) % G,
             [=](int r, int c, f32x4 v0, f32x4 v1) { const f32x4 s0 = *(const f32x4*)(ps + c), s1 = *(const f32x4*)(ps + c + 4); st8h(CAT16 + (size_t)r * D + g * 256 + c, v0 * s0, v1 * s1); });
    }
    gemm(lds, DY16 + 1024, D, (const f16*)(ws + W_GLU), 1024, MMAIN, 1024, 1024, (bid + G - 128) % G,
         [=](int r, int c, f32x4 v0, f32x4 v1) {
             const f16* yp = DY16 + (size_t)r * D + 1024 + c; const float4 y0 = ld4(yp), y1 = ld4(yp + 4);
             f32x4 o0, o1;
             o0[0] = y0.x / (1.f + __expf(-v0[0])); o0[1] = y0.y / (1.f + __expf(-v0[1])); o0[2] = y0.z / (1.f + __expf(-v0[2])); o0[3] = y0.w / (1.f + __expf(-v0[3]));
             o1[0] = y1.x / (1.f + __expf(-v1[0])); o1[1] = y1.y / (1.f + __expf(-v1[1])); o1[2] = y1.z / (1.f + __expf(-v1[2])); o1[3] = y1.w / (1.f + __expf(-v1[3]));
             st8h(CAT16 + (size_t)r * D + 1024 + c, o0, o1); });
    xcd_barrier(xbar);
    for (int gi = bid; gi < 16; gi += G)
        skinny_group(lds, CAT16m, D, (const f16*)(ws + W_OUT), D, D, 128 * gi, [=](int r, int c, f32x4 v, const LAS float*) { st4hv(U16m + (size_t)r * D + c, v); });
    gemm(lds, CAT16, D, (const f16*)(ws + W_OUT), D, MMAIN, D, D, bid, [=](int r, int c, f32x4 v0, f32x4 v1) { st8h(U16 + (size_t)r * D + c, v0, v1); });
    xcd_barrier(xbar);
    rowpass(U16, ng + 1 * D, ng + 2 * D, H, A16, nullptr, MREAL);
    xcd_barrier(xbar);
    for (int gi = bid; gi < 64; gi += G)
        skinny_group(lds, A16m, D, (const f16*)(ws + W_1), D, D, 128 * gi, [=](int r, int c, f32x4 v, const LAS float*) {
            const f32x4 z = __builtin_elementwise_max(v, (f32x4){0.f, 0.f, 0.f, 0.f}); st4hv(HID16m + (size_t)r * DFF + c, z * z); });
    gemm(lds, A16, D, (const f16*)(ws + W_1), D, MMAIN, DFF, D, bid, [=](int r, int c, f32x4 v0, f32x4 v1) {
        f32x4 z0 = __builtin_elementwise_max(v0, (f32x4){0.f, 0.f, 0.f, 0.f}), z1 = __builtin_elementwise_max(v1, (f32x4){0.f, 0.f, 0.f, 0.f}); st8h(HID16 + (size_t)r * DFF + c, z0 * z0, z1 * z1); });
    xcd_barrier(xbar);
    for (int gi = bid; gi < 16; gi += G)
        skinny_group(lds, HID16m, DFF, (const f16*)(ws + W_2), DFF, DFF, 128 * gi, [=](int r, int c, f32x4 v, const LAS float*) { st4hv(U16m + (size_t)r * D + c, v); });
    gemm(lds, HID16, DFF, (const f16*)(ws + W_2), DFF, MMAIN, D, DFF, bid, [=](int r, int c, f32x4 v0, f32x4 v1) { st8h(U16 + (size_t)r * D + c, v0, v1); });
    xcd_barrier(xbar);
    rowpass(U16, ng + 3 * D, ng + 4 * D, H, A16, nullptr, MREAL);
    zero_kv_pads(co.K16, co.V16, co.KI16);
    xcd_barrier(xbar);
    gemm(lds, A16, D, (const f16*)(ws + W_CIN), D, MP, CINP, D, bid, [=](int r, int c, f32x4 v0, f32x4 v1) { cin_epilogue(co, r, c, v0, v1); });
    xcd_barrier(xbar);
#ifdef IDX_NAIVE
    idx_scores(co.QI16, co.KI16, co.WI, SCORE);
    xcd_barrier(xbar);
    select_topk(SCORE, MASK);
#else
    index_select(co.QI16, co.KI16, co.WI, MASK, lds);
#endif
    xcd_barrier(xbar);
#ifdef ATT_NAIVE
    attn_naive(ldsf, co.Q16, co.K16, co.V16, MASK, O16);
#else
    attn_phase(lds, co.Q16, co.K16, co.V16, MASK, O16);
#endif
    xcd_barrier(xbar);
    gemm(lds, O16, D, (const f16*)(ws + W_COUT), D, MMAIN, D, D, bid, [=](int r, int c, f32x4 v0, f32x4 v1) { st8h(U16 + (size_t)r * D + c, v0, v1); });
    xcd_barrier(xbar);
    rowpass(U16, ng + 5 * D, ng + 6 * D, H, A16, nullptr, MMAIN);
    xcd_barrier(xbar);
    gemm(lds, A16, D, (const f16*)(ws + W_1) + (size_t)D * DFF, D, MMAIN, DFF, D, bid, [=](int r, int c, f32x4 v0, f32x4 v1) {
        f32x4 z0 = __builtin_elementwise_max(v0, (f32x4){0.f, 0.f, 0.f, 0.f}), z1 = __builtin_elementwise_max(v1, (f32x4){0.f, 0.f, 0.f, 0.f}); st8h(HID16 + (size_t)r * DFF + c, z0 * z0, z1 * z1); });
    xcd_barrier(xbar);
    gemm(lds, HID16, DFF, (const f16*)(ws + W_2) + (size_t)D * DFF, DFF, MMAIN, D, DFF, bid, [=](int r, int c, f32x4 v0, f32x4 v1) { st8h(U16 + (size_t)r * D + c, v0, v1); });
    xcd_barrier(xbar);
    rowpass(U16, ng + 7 * D, nullptr, H, nullptr, p.out, MMAIN);
}

extern "C" void kernel_launch(void* const* d_in, const int* in_sizes, int n_in, void* d_out, int out_size, void* d_ws, size_t ws_size, hipStream_t stream) {
    static int grid_blocks = 0;
    if (!grid_blocks) {
        if (n_in != 20 || out_size != MMAIN * D || ws_size < WS_NEED) { fprintf(stderr, "kernel_launch: unexpected shapes n_in %d out %d ws %zu (need %zu)\n", n_in, out_size, ws_size, (size_t)WS_NEED); grid_blocks = -1; return; }
        int dev = 0, cus = 0, per_cu = 0;
        (void)hipGetDevice(&dev);
        (void)hipDeviceGetAttribute(&cus, hipDeviceAttributeMultiprocessorCount, dev);
        if (hipFuncSetAttribute((const void*)fwd, hipFuncAttributeMaxDynamicSharedMemorySize, LDS_BYTES) != hipSuccess) { fprintf(stderr, "kernel_launch: hipFuncSetAttribute failed\n"); grid_blocks = -1; return; }
        (void)hipOccupancyMaxActiveBlocksPerMultiprocessor(&per_cu, fwd, NTHREADS, LDS_BYTES);
        if (per_cu < 1) { fprintf(stderr, "kernel_launch: occupancy query says %d blocks per CU\n", per_cu); per_cu = 1; }
        grid_blocks = cus;
    }
    if (grid_blocks < 0) return;
    Params p{};
    for (int i = 0; i < 20; ++i) p.in[i] = (const float*)d_in[i];
    p.out = (float*)d_out; p.ws = (unsigned char*)d_ws;
    if (hipMemsetAsync((char*)d_ws + OFF_BAR, 0, SZ_BAR, stream) != hipSuccess) { fprintf(stderr, "kernel_launch: hipMemsetAsync failed\n"); return; }
    void* args[] = {&p};
    hipError_t e = hipLaunchCooperativeKernel((void*)fwd, dim3(grid_blocks), dim3(NTHREADS), args, LDS_BYTES, stream);
    if (e != hipSuccess) fprintf(stderr, "cooperative launch failed: %s (grid %d)\n", hipGetErrorString(e), grid_blocks);
}
```

```cpp
#ifndef PROBE_MASK
#define PROBE_MASK 0
#endif
#include <hip/hip_runtime.h>
#include <hip/hip_fp16.h>
#include <hip/hip_cooperative_groups.h>
#include <cstdio>
#include <cstdint>
#include <cmath>
namespace cg = cooperative_groups;
__device__ __forceinline__ int otid() { int t = threadIdx.x; asm volatile("" : "+v"(t)); return t; }
__device__ __forceinline__ int obid() { int t = blockIdx.x; asm volatile("" : "+s"(t)); return t; }

namespace pg8 {
#define PG8_LAS __attribute__((address_space(3)))
typedef _Float16 f16_t;
typedef _Float16 f16x8 __attribute__((ext_vector_type(8)));
typedef float f32x4 __attribute__((ext_vector_type(4)));
typedef unsigned u32x4 __attribute__((ext_vector_type(4)));
constexpr int BM = 256, BK = 64, HALF = 128, HTB = HALF * BK * 2  , STAGE_BYTES = 8 * HTB, NXCD = 8, WGM = 8;

__host__ __device__ __forceinline__ int lds_byte(int r, int c) { const int st = (r >> 4) * 2 + (c >> 5), rr = r & 15, cc = c & 31, ob = rr * 64 + cc * 2; return st * 1024 + (ob ^ (((ob >> 9) & 1) << 5)); }
__host__ __device__ __forceinline__ void stage_rc(int b, int& R, int& C) { const int st = b / 1024, sb = b % 1024, swz = sb ^ (((sb >> 9) & 1) << 5); R = (st >> 1) * 16 + swz / 64; C = (st & 1) * 32 + (swz % 64) / 2; }
__host__ __device__ __forceinline__ int perm32(int rho) { const int n = rho >> 4, i = rho & 15; return 8 * (i >> 2) + 4 * n + (i & 3); }

struct Unit { int pm, pn; };
struct Gemm { const f16_t* A; const f16_t* Bt; int M, N, K, lda, ldb; };

struct StaticOrder {
    int nM, nN, nwg, G, c;
    __host__ __device__ void init(int M, int N, int G_, int c_) { nM = M / BM; nN = N / BM; nwg = nM * nN; G = G_; c = c_; }
    __host__ __device__ bool next(int i, Unit& u) const {
        const long L = (long)i * G + c; if (L >= nwg) return false;
        int wgid = (int)L; { const int q = nwg / NXCD, r = nwg % NXCD, xcd = wgid % NXCD, off = wgid / NXCD; wgid = (xcd < r ? xcd * (q + 1) : r * (q + 1) + (xcd - r) * q) + off; }
        const int nig = WGM * nN, gid = wgid / nig, fm = gid * WGM, gsz = (nM - fm) < WGM ? (nM - fm) : WGM;
        u.pm = fm + ((wgid % nig) % gsz); u.pn = (wgid % nig) / gsz; return true;
    }
    __device__ __forceinline__ void a_ready(const Unit&) const {}
    __device__ __forceinline__ void done(const Unit&) const {}
};


template <class Epi, class Sched, bool ALIGN_EPI = false, bool SP2 = false>
__device__ __forceinline__ void gemm_phase(PG8_LAS unsigned char* lds, const Gemm g, const Sched& S, const Epi& E) {
    const int tid = otid(), wid = __builtin_amdgcn_readfirstlane(tid >> 6), lane = tid & 63, wr = wid >> 2, wc = wid & 3, fr = lane & 15, fq = lane >> 4;
    const int K = g.K, nt = K / BK;
    unsigned voffA[2], voffB[2];
#pragma unroll
    for (int i = 0; i < 2; ++i) { int R, C; stage_rc(tid * 16 + i * 8192, R, C); const int Rb = Epi::PERM ? ((R & ~31) + perm32(R & 31)) : R;
        voffA[i] = (unsigned)(R * g.lda + C) * 2u; voffB[i] = (unsigned)(Rb * g.ldb + C) * 2u; }
    const size_t kstep = (size_t)(BK * 2);
    const size_t hstepA = (size_t)HALF * g.lda * 2, hstepB = (size_t)HALF * g.ldb * 2;
    const size_t tstepA = 2 * hstepA, tstepB = 2 * hstepB;
    const unsigned ldsw = (unsigned)wid * 1024u;
    const int aoff = lds_byte(wr * 64 + fr, fq * 8), boff = lds_byte(wc * 32 + fr, fq * 8);
#define PG8_SA(b, h) (((b) * 2 + (h)) * HTB)
#define PG8_SB(b, h) ((4 + (b) * 2 + (h)) * HTB)
#define PG8_STAGE(bufoff, gbase, voff) do { _Pragma("unroll") for (int _i = 0; _i < 2; ++_i) \
        __builtin_amdgcn_global_load_lds((const unsigned*)((const char*)(gbase) + (voff)[_i]), (PG8_LAS unsigned*)(lds + (bufoff) + ldsw + _i * 8192), 16, 0, 0); } while (0)
#define PG8_LDA(dst, b, h) do { _Pragma("unroll") for (int m = 0; m < 4; ++m) _Pragma("unroll") for (int k = 0; k < 2; ++k) dst[m][k] = *(const PG8_LAS f16x8*)(lds + PG8_SA(b, h) + aoff + m * 2048 + k * 1024); } while (0)
#define PG8_LDB(dst, b, h) do { _Pragma("unroll") for (int n = 0; n < 2; ++n) _Pragma("unroll") for (int k = 0; k < 2; ++k) dst[n][k] = *(const PG8_LAS f16x8*)(lds + PG8_SB(b, h) + boff + n * 2048 + k * 1024); } while (0)
#define PG8_MMA(ai, bj, At, Bt) do { __builtin_amdgcn_s_setprio(1); _Pragma("unroll") for (int m = 0; m < 4; ++m) _Pragma("unroll") for (int n = 0; n < 2; ++n) _Pragma("unroll") for (int k = 0; k < 2; ++k) \
        acc[ai][bj][m][n] = __builtin_amdgcn_mfma_f32_16x16x32_f16(Bt[n][k], At[m][k], acc[ai][bj][m][n], 0, 0, 0); __builtin_amdgcn_s_setprio(0); } while (0)
#define PG8_WAIT_V(n) asm volatile("s_waitcnt vmcnt(" #n ")" ::: "memory")
#define PG8_WAIT_L(n) asm volatile("s_waitcnt lgkmcnt(" #n ")" ::: "memory")
#define PG8_BAR __builtin_amdgcn_s_barrier()
#define PG8_SCHED __builtin_amdgcn_sched_barrier(0)
    Unit cur, nxt; int ui = 0;
    if (!S.next(0, cur)) return;
    f32x4 acc[2][2][4][2];
#pragma unroll
    for (int a = 0; a < 2; ++a)
#pragma unroll
        for (int b = 0; b < 2; ++b)
#pragma unroll
            for (int m = 0; m < 4; ++m)
#pragma unroll
                for (int n = 0; n < 2; ++n) acc[a][b][m][n] = (f32x4){0.f, 0.f, 0.f, 0.f};
    f16x8 At[4][2], B0[2][2], B1[2][2];
    const char* cA = (const char*)g.A + (size_t)cur.pm * tstepA; const char* cB = (const char*)g.Bt + (size_t)cur.pn * tstepB;
    S.a_ready(cur);
    if constexpr (SP2) {
        PG8_STAGE(PG8_SB(0, 0), cB, voffB); PG8_STAGE(PG8_SB(0, 1), cB + hstepB, voffB); PG8_STAGE(PG8_SA(0, 0), cA, voffA); PG8_STAGE(PG8_SA(0, 1), cA + hstepA, voffA);
        if (wr == 1) PG8_BAR;
        PG8_WAIT_V(2); PG8_BAR;
        PG8_STAGE(PG8_SB(1, 0), cB + kstep, voffB); PG8_STAGE(PG8_SA(1, 0), cA + kstep, voffA); PG8_STAGE(PG8_SB(1, 1), cB + hstepB + kstep, voffB);
        PG8_WAIT_V(6); PG8_BAR;
    } else {
        PG8_STAGE(PG8_SB(0, 0), cB, voffB); PG8_STAGE(PG8_SA(0, 0), cA, voffA); PG8_STAGE(PG8_SB(0, 1), cB + hstepB, voffB); PG8_STAGE(PG8_SA(0, 1), cA + hstepA, voffA);
        if (wr == 1) PG8_BAR;
        PG8_WAIT_V(4); PG8_BAR;
        PG8_STAGE(PG8_SB(1, 0), cB + kstep, voffB); PG8_STAGE(PG8_SA(1, 0), cA + kstep, voffA); PG8_STAGE(PG8_SB(1, 1), cB + hstepB + kstep, voffB);
        PG8_WAIT_V(6); PG8_BAR;
    }
    for (;;) {
        const bool has_next = S.next(ui + 1, nxt);
        const char* nA = has_next ? (const char*)g.A + (size_t)nxt.pm * tstepA : cA; const char* nB = has_next ? (const char*)g.Bt + (size_t)nxt.pn * tstepB : cB;
        for (int t = 0; t < nt; t += 2) {
            const bool last = (t == nt - 2);
            const char* a1 = cA + (size_t)(t + 1) * kstep;
            const char* a2 = last ? nA : cA + (size_t)(t + 2) * kstep; const char* b2 = last ? nB : cB + (size_t)(t + 2) * kstep;
            const char* a3 = a2 + kstep; const char* b3 = b2 + kstep;
            if (last && has_next) S.a_ready(nxt);
            if constexpr (SP2) {
            PG8_LDB(B0, 0, 0); PG8_LDB(B1, 0, 1); PG8_SCHED; PG8_LDA(At, 0, 0); PG8_STAGE(PG8_SA(1, 1), a1 + hstepA, voffA);
            PG8_WAIT_V(8); PG8_WAIT_L(0); PG8_BAR; PG8_MMA(0, 0, At, B0); PG8_MMA(0, 1, At, B1); PG8_BAR; PG8_SCHED;
            PG8_LDA(At, 0, 1); PG8_STAGE(PG8_SB(0, 0), b2, voffB); PG8_STAGE(PG8_SB(0, 1), b2 + hstepB, voffB); PG8_STAGE(PG8_SA(0, 0), a2, voffA);
            PG8_WAIT_V(8); PG8_WAIT_L(0); PG8_BAR; PG8_MMA(1, 0, At, B0); PG8_MMA(1, 1, At, B1); PG8_BAR; PG8_SCHED;
            PG8_LDB(B0, 1, 0); PG8_LDB(B1, 1, 1); PG8_SCHED; PG8_LDA(At, 1, 0); PG8_STAGE(PG8_SA(0, 1), a2 + hstepA, voffA);
            PG8_WAIT_V(8); PG8_WAIT_L(0); PG8_BAR; PG8_MMA(0, 0, At, B0); PG8_MMA(0, 1, At, B1); PG8_BAR; PG8_SCHED;
            PG8_LDA(At, 1, 1); PG8_STAGE(PG8_SB(1, 0), b3, voffB); PG8_STAGE(PG8_SB(1, 1), b3 + hstepB, voffB); PG8_STAGE(PG8_SA(1, 0), a3, voffA);
            PG8_WAIT_V(8); PG8_WAIT_L(0); PG8_BAR; PG8_MMA(1, 0, At, B0); PG8_MMA(1, 1, At, B1); PG8_BAR; PG8_SCHED;
            } else {
            PG8_LDB(B0, 0, 0); PG8_SCHED; PG8_LDA(At, 0, 0); PG8_STAGE(PG8_SA(1, 1), a1 + hstepA, voffA);
            PG8_WAIT_L(8); PG8_BAR; PG8_WAIT_L(0); PG8_MMA(0, 0, At, B0); PG8_BAR; PG8_SCHED;
            PG8_LDB(B1, 0, 1); PG8_STAGE(PG8_SB(0, 0), b2, voffB);
            PG8_BAR; PG8_WAIT_L(0); PG8_MMA(0, 1, At, B1); PG8_BAR;
            PG8_LDA(At, 0, 1); PG8_STAGE(PG8_SA(0, 0), a2, voffA);
            PG8_BAR; PG8_WAIT_L(0); PG8_MMA(1, 0, At, B0); PG8_BAR; PG8_SCHED;
            PG8_STAGE(PG8_SB(0, 1), b2 + hstepB, voffB);
            PG8_WAIT_V(6); PG8_BAR; PG8_MMA(1, 1, At, B1); PG8_BAR;
            PG8_LDB(B0, 1, 0); PG8_SCHED; PG8_LDA(At, 1, 0); PG8_STAGE(PG8_SA(0, 1), a2 + hstepA, voffA);
            PG8_WAIT_L(8); PG8_BAR; PG8_WAIT_L(0); PG8_MMA(0, 0, At, B0); PG8_BAR; PG8_SCHED;
            PG8_LDB(B1, 1, 1); PG8_STAGE(PG8_SB(1, 0), b3, voffB);
            PG8_BAR; PG8_WAIT_L(0); PG8_MMA(0, 1, At, B1); PG8_BAR;
            PG8_LDA(At, 1, 1); PG8_STAGE(PG8_SA(1, 0), a3, voffA);
            PG8_BAR; PG8_WAIT_L(0); PG8_MMA(1, 0, At, B0); PG8_BAR; PG8_SCHED;
            PG8_STAGE(PG8_SB(1, 1), b3 + hstepB, voffB);
            PG8_WAIT_V(6); PG8_BAR; PG8_MMA(1, 1, At, B1); PG8_BAR;
            }
        }
        if constexpr (ALIGN_EPI) { if (wr == 0) PG8_BAR; }
        if constexpr (!Epi::AFTER_DRAIN) { E(acc, cur, wr, wc, fr, fq); S.done(cur); }
        if (!has_next) break;
#pragma unroll
        for (int a = 0; a < 2; ++a)
#pragma unroll
            for (int b = 0; b < 2; ++b)
#pragma unroll
                for (int m = 0; m < 4; ++m)
#pragma unroll
                    for (int n = 0; n < 2; ++n) acc[a][b][m][n] = (f32x4){0.f, 0.f, 0.f, 0.f};
        cur = nxt; cA = nA; cB = nB; ++ui;
        if constexpr (ALIGN_EPI) { if (wr == 1) PG8_BAR; }
    }
    PG8_WAIT_V(0);
    if constexpr (!ALIGN_EPI) { if (wr == 0) PG8_BAR; }
    PG8_BAR;
    if constexpr (Epi::AFTER_DRAIN) { E.fused(acc, cur, wr, wc, fr, fq, lds, wid, lane); S.done(cur); }
#undef PG8_SA
#undef PG8_SB
#undef PG8_STAGE
#undef PG8_LDA
#undef PG8_LDB
#undef PG8_MMA
#undef PG8_WAIT_V
#undef PG8_WAIT_L
#undef PG8_BAR
#undef PG8_SCHED
}

template <class F> struct EpiRow8 {
    static constexpr bool PERM = true, AFTER_DRAIN = false;
    F f;
    __device__ __forceinline__ void operator()(const f32x4 (&acc)[2][2][4][2], const Unit& u, int wr, int wc, int fr, int fq) const {
        const int row0 = u.pm * BM + wr * 64 + fr, col0 = u.pn * BM + wc * 32 + 8 * fq;
#pragma unroll
        for (int ai = 0; ai < 2; ++ai)
#pragma unroll
            for (int m = 0; m < 4; ++m)
#pragma unroll
                for (int bj = 0; bj < 2; ++bj) f(row0 + ai * HALF + m * 16, col0 + bj * HALF, acc[ai][bj][m][0], acc[ai][bj][m][1]);
    }
};
}

#define LAS __attribute__((address_space(3)))
typedef _Float16 f16;
typedef float f32x4 __attribute__((ext_vector_type(4)));
typedef unsigned u32x4 __attribute__((ext_vector_type(4)));
typedef _Float16 h2v __attribute__((ext_vector_type(2)));

constexpr int D = 2048, NMETA = 16, SEQ = 2048, T = 2064, DFF = 8192;
constexpr int MMAIN = 8192;
constexpr int MREAL = 8208;
constexpr int MP = 8448;
constexpr int CIN = 4176, CINP = 4352;
constexpr int QOFF = 0, KOFF = 2048, VOFF = 2560, QIOFF = 3072, KIOFF = 4096, WIOFF = 4160;
constexpr int SROW = 2112;
constexpr float EPS = 1e-6f;
constexpr int NTHREADS = 512;
constexpr int LDS_BYTES = 147456;

struct Params { const float* in[20]; float* out; unsigned char* ws; };
enum { I_X = 0, I_META, I_NORMG, I_ABWIN, I_POOLW, I_POOLS, I_LRE, I_LIM, I_LOGDT, I_BRE, I_BIM, I_CRE, I_CIM, I_S5D, I_WGLU, I_ABWOUT, I_CWIN, I_CWOUT, I_W1, I_W2 };

constexpr int TP = 2112;
constexpr size_t SZ4 = (size_t)MP * D * 4, SZ2 = (size_t)MP * D * 2;
constexpr size_t OFF_H = 0, OFF_A16 = OFF_H + SZ4, OFF_U16 = OFF_A16 + SZ2, OFF_DY16 = OFF_U16 + SZ2, OFF_CAT16 = OFF_DY16 + SZ2, OFF_BIG = OFF_CAT16 + SZ2;
constexpr size_t SZ_BIG = (size_t)MP * DFF * 2;
constexpr size_t OFF_Q16 = OFF_BIG, OFF_K16 = OFF_Q16 + (size_t)MMAIN * D * 2, OFF_V16 = OFF_K16 + (size_t)4 * TP * 512 * 2, OFF_QI16 = OFF_V16 + (size_t)4 * TP * 512 * 2,
                 OFF_KI16 = OFF_QI16 + (size_t)MMAIN * 1024 * 2, OFF_WI = OFF_KI16 + (size_t)4 * TP * 64 * 2, OFF_ATT_END = OFF_WI + (size_t)MMAIN * 16 * 4;
static_assert(OFF_ATT_END <= OFF_BIG + SZ_BIG, "attention buffers fit the BIG region");
constexpr size_t OFF_MASK = OFF_BIG + SZ_BIG, SZ_MASK = (size_t)MMAIN * 33 * 8;
constexpr size_t OFF_ROPE16 = OFF_MASK + SZ_MASK, OFF_ROPE8 = OFF_ROPE16 + (size_t)T * 16 * 8;
constexpr size_t OFF_BAR = OFF_ROPE8 + (size_t)T * 8 * 8, SZ_BAR = 16384;
constexpr size_t OFF_W = OFF_BAR + SZ_BAR;
constexpr size_t OFF_SCORE = OFF_DY16, OFF_O16 = OFF_A16;
constexpr size_t W_IN = OFF_W, W_POOL = W_IN + (size_t)D * D * 2, W_GLU = W_POOL + (size_t)4 * 256 * 256 * 2, W_OUT = W_GLU + (size_t)1024 * 1024 * 2,
                 W_CIN = W_OUT + (size_t)D * D * 2, W_COUT = W_CIN + (size_t)CINP * D * 2, W_1 = W_COUT + (size_t)D * D * 2, W_2 = W_1 + (size_t)2 * D * DFF * 2,
                 WS_NEED = W_2 + (size_t)2 * D * DFF * 2;
static_assert((size_t)MMAIN * SROW * 4 <= 2 * SZ2, "SCORE fits DY16+CAT16");
static_assert(OFF_W % 256 == 0, "alignment");

__device__ __forceinline__ int row_of(int b, int t) { return t < NMETA ? MMAIN + t : b * SEQ + (t - NMETA); }
__device__ __forceinline__ float wave_sum(float v) {
#pragma unroll
    for (int o = 1; o < 64; o <<= 1) v += __shfl_xor(v, o);
    return v;
}
__device__ __forceinline__ float wave_max(float v) {
#pragma unroll
    for (int o = 1; o < 64; o <<= 1) v = fmaxf(v, __shfl_xor(v, o));
    return v;
}
__device__ __forceinline__ float4 ld4(const float* p) { return *(const float4*)p; }
__device__ __forceinline__ unsigned pk2h(float a, float b) { h2v r; r.x = (_Float16)a; r.y = (_Float16)b; return __builtin_bit_cast(unsigned, r); }
__device__ __forceinline__ float2 up2h(unsigned u) { const h2v r = __builtin_bit_cast(h2v, u); return make_float2((float)r.x, (float)r.y); }
__device__ __forceinline__ float4 ld4(const f16* p) { const uint2 r = *(const uint2*)p; const float2 a = up2h(r.x), b = up2h(r.y); return make_float4(a.x, a.y, b.x, b.y); }
__device__ __forceinline__ void st4h(f16* p, float4 v) { uint2 r; r.x = pk2h(v.x, v.y); r.y = pk2h(v.z, v.w); *(uint2*)p = r; }
__device__ __forceinline__ void st8h(f16* p, f32x4 a, f32x4 b) { u32x4 w; w.x = pk2h(a[0], a[1]); w.y = pk2h(a[2], a[3]); w.z = pk2h(b[0], b[1]); w.w = pk2h(b[2], b[3]); *(u32x4*)p = w; }

__device__ __forceinline__ void sincos_d(double x, double& sn, double& cs) {
    const double q = rint(x * 0.6366197723675814);
    double r = fma(-q, 1.5707963267948966, x); r = fma(-q, 6.123233995736766e-17, r);
    const double r2 = r * r;
    double sp = -1.0 / 6227020800.0; sp = fma(sp, r2, 1.0 / 39916800.0); sp = fma(sp, r2, -1.0 / 362880.0); sp = fma(sp, r2, 1.0 / 5040.0); sp = fma(sp, r2, -1.0 / 120.0); sp = fma(sp, r2, 1.0 / 6.0); sp = fma(sp, r2, -1.0); sp = -sp * r;
    double cp = 1.0 / 87178291200.0; cp = fma(cp, r2, -1.0 / 479001600.0); cp = fma(cp, r2, 1.0 / 3628800.0); cp = fma(cp, r2, -1.0 / 40320.0); cp = fma(cp, r2, 1.0 / 720.0); cp = fma(cp, r2, -1.0 / 24.0); cp = fma(cp, r2, 0.5); cp = fma(-cp, r2, 1.0);
    const int n = ((int)q) & 3;
    sn = (n == 0) ? sp : (n == 1) ? cp : (n == 2) ? -sp : -cp;
    cs = (n == 0) ? cp : (n == 1) ? -sp : (n == 2) ? -cp : sp;
}
__device__ __forceinline__ float rope_inv16(int idx) {
    const double r = 1.0 / sqrt(sqrt(sqrt(sqrt(500000.0))));
    double v = 1.0;
    for (int i = 0; i < idx; ++i) v *= r;
    return (float)v;
}

__device__ __forceinline__ void cvt_item(const float* W, int K, int N, int NPAD, f16* WT, float* scr, int item, int lane) {
    const int nblk = NPAD / 32, kb = item / nblk, nb = item % nblk, k0 = 64 * kb, n0 = 32 * nb;
    const int n = n0 + (lane & 31);
    float wv_[32];
#pragma unroll
    for (int i = 0; i < 32; ++i) { const int kk = 2 * i + (lane >> 5); wv_[i] = (n < N) ? W[(size_t)(k0 + kk) * N + n] : 0.f; }
#pragma unroll
    for (int i = 0; i < 32; ++i) { const int kk = 2 * i + (lane >> 5); scr[kk * 33 + (lane & 31)] = wv_[i]; }
    const int c = lane & 7;
#pragma unroll
    for (int j = 0; j < 4; ++j) { const int nn = (lane >> 3) + 8 * j; const float* s = scr + (8 * c) * 33 + nn;
        u32x4 o; o.x = pk2h(s[0 * 33], s[1 * 33]); o.y = pk2h(s[2 * 33], s[3 * 33]); o.z = pk2h(s[4 * 33], s[5 * 33]); o.w = pk2h(s[6 * 33], s[7 * 33]);
        *(u32x4*)(WT + (size_t)(n0 + nn) * K + k0 + 8 * c) = o; }
}
__device__ __forceinline__ void convert_weights(const Params& p, float* ldsf) {
    const int tid_ = otid(), lane = tid_ & 63, wv = tid_ >> 6, gw = obid() * (NTHREADS / 64) + wv, ngw = gridDim.x * (NTHREADS / 64);
    float* scr = ldsf + wv * (64 * 33);
    unsigned char* ws = p.ws;
    constexpr int I_IN = 32 * 64, I_PG = 4 * 8, I_GLU = 16 * 32, I_OUT = 32 * 64, I_CI = 32 * (CINP / 32), I_CO = 32 * 64, I_M1 = 32 * 256, I_M2 = 128 * 64;
    constexpr int NITEMS = I_IN + 4 * I_PG + I_GLU + I_OUT + I_CI + I_CO + 2 * I_M1 + 2 * I_M2;
    for (int it = gw; it < NITEMS; it += ngw) {
        int r = it;
        if (r < I_IN) { cvt_item(p.in[I_ABWIN], D, D, D, (f16*)(ws + W_IN), scr, r, lane); continue; } r -= I_IN;
        if (r < 4 * I_PG) { const int g = r / I_PG; cvt_item(p.in[I_POOLW] + (size_t)g * 65536, 256, 256, 256, (f16*)(ws + W_POOL) + (size_t)g * 65536, scr, r % I_PG, lane); continue; } r -= 4 * I_PG;
        if (r < I_GLU) { cvt_item(p.in[I_WGLU], 1024, 1024, 1024, (f16*)(ws + W_GLU), scr, r, lane); continue; } r -= I_GLU;
        if (r < I_OUT) { cvt_item(p.in[I_ABWOUT], D, D, D, (f16*)(ws + W_OUT), scr, r, lane); continue; } r -= I_OUT;
        if (r < I_CI) { cvt_item(p.in[I_CWIN], D, CIN, CINP, (f16*)(ws + W_CIN), scr, r, lane); continue; } r -= I_CI;
        if (r < I_CO) { cvt_item(p.in[I_CWOUT], D, D, D, (f16*)(ws + W_COUT), scr, r, lane); continue; } r -= I_CO;
        if (r < 2 * I_M1) { const int l = r / I_M1; cvt_item(p.in[I_W1] + (size_t)l * D * DFF, D, DFF, DFF, (f16*)(ws + W_1) + (size_t)l * D * DFF, scr, r % I_M1, lane); continue; } r -= 2 * I_M1;
        { const int l = r / I_M2; cvt_item(p.in[I_W2] + (size_t)l * D * DFF, DFF, D, D, (f16*)(ws + W_2) + (size_t)l * D * DFF, scr, r % I_M2, lane); }
    }
}

__device__ __forceinline__ void init_rows(const Params& p, float* H, f16* A) {
    const int tid_ = otid(), lane = tid_ & 63, gw = obid() * (NTHREADS / 64) + (tid_ >> 6), ngw = gridDim.x * (NTHREADS / 64);
    const float* g = p.in[I_NORMG];
    for (int row = gw; row < MP; row += ngw) {
        float4 h[8]; float ss = 0.f;
#pragma unroll
        for (int j = 0; j < 8; ++j) {
            const int c = 4 * lane + 256 * j;
            if (row < MMAIN) h[j] = ld4(p.in[I_X] + (size_t)row * D + c);
            else if (row < MREAL) h[j] = ld4(p.in[I_META] + (size_t)(row - MMAIN) * D + c);
            else h[j] = make_float4(0.f, 0.f, 0.f, 0.f);
            ss += h[j].x * h[j].x + h[j].y * h[j].y + h[j].z * h[j].z + h[j].w * h[j].w;
        }
        const float r = rsqrtf(wave_sum(ss) * (1.f / D) + EPS);
#pragma unroll
        for (int j = 0; j < 8; ++j) {
            const int c = 4 * lane + 256 * j; const float4 gg = ld4(g + c);
            *(float4*)(H + (size_t)row * D + c) = h[j];
            st4h(A + (size_t)row * D + c, make_float4(h[j].x * r * gg.x, h[j].y * r * gg.y, h[j].z * r * gg.z, h[j].w * r * gg.w));
        }
    }
}
__device__ __forceinline__ void rowpass(const f16* MIX, const float* ga, const float* gb, float* H, f16* A, float* OUT, int nrows) {
    const int tid_ = otid(), lane = tid_ & 63, gw = obid() * (NTHREADS / 64) + (tid_ >> 6), ngw = gridDim.x * (NTHREADS / 64);
    for (int row = gw; row < nrows; row += ngw) {
        float4 m[8], h[8]; float ss = 0.f;
#pragma unroll
        for (int j = 0; j < 8; ++j) {
            const int c = 4 * lane + 256 * j;
            m[j] = ld4(MIX + (size_t)row * D + c); h[j] = ld4(H + (size_t)row * D + c);
            ss += m[j].x * m[j].x + m[j].y * m[j].y + m[j].z * m[j].z + m[j].w * m[j].w;
        }
        const float r = rsqrtf(wave_sum(ss) * (1.f / D) + EPS);
        float s2 = 0.f;
#pragma unroll
        for (int j = 0; j < 8; ++j) {
            const int c = 4 * lane + 256 * j; const float4 gg = ld4(ga + c);
            h[j].x += m[j].x * r * gg.x; h[j].y += m[j].y * r * gg.y; h[j].z += m[j].z * r * gg.z; h[j].w += m[j].w * r * gg.w;
            s2 += h[j].x * h[j].x + h[j].y * h[j].y + h[j].z * h[j].z + h[j].w * h[j].w;
        }
        if (OUT) {
#pragma unroll
            for (int j = 0; j < 8; ++j) *(float4*)(OUT + (size_t)row * D + 4 * lane + 256 * j) = h[j];
        } else {
            const float r2 = rsqrtf(wave_sum(s2) * (1.f / D) + EPS);
#pragma unroll
            for (int j = 0; j < 8; ++j) {
                const int c = 4 * lane + 256 * j; const float4 gg = ld4(gb + c);
                *(float4*)(H + (size_t)row * D + c) = h[j];
                st4h(A + (size_t)row * D + c, make_float4(h[j].x * r2 * gg.x, h[j].y * r2 * gg.y, h[j].z * r2 * gg.z, h[j].w * r2 * gg.w));
            }
        }
    }
}

__device__ __forceinline__ void pool_diff(const f16* U, f16* DY) {
    const int total = MREAL * 128, stride = (int)gridDim.x * NTHREADS;
    for (int i = obid() * NTHREADS + otid(); i < total; i += stride) {
        const int row = i >> 7, c = (i & 127) * 8;
        const int b = row < MMAIN ? row >> 11 : 0, t = row < MMAIN ? (row & 2047) + NMETA : row - MMAIN;
        const int win = 2 << (c >> 8);
        const int cnt = (t + 1) < win ? (t + 1) : win;
        const float4 ua = ld4(U + (size_t)row * D + c), ub = ld4(U + (size_t)row * D + c + 4);
        float4 sa = ua, sb = ub;
        for (int j = 1; j < cnt; ++j) {
            const f16* up = U + (size_t)row_of(b, t - j) * D + c; const float4 a = ld4(up), bb = ld4(up + 4);
            sa.x += a.x; sa.y += a.y; sa.z += a.z; sa.w += a.w; sb.x += bb.x; sb.y += bb.y; sb.z += bb.z; sb.w += bb.w;
        }
        const float ic = 1.f / (float)cnt;
        f32x4 o0 = {sa.x * ic - ua.x, sa.y * ic - ua.y, sa.z * ic - ua.z, sa.w * ic - ua.w}, o1 = {sb.x * ic - ub.x, sb.y * ic - ub.y, sb.z * ic - ub.z, sb.w * ic - ub.w};
        st8h(DY + (size_t)row * D + c, o0, o1);
    }
}

__device__ __forceinline__ void pool_diff_old(const f16* U, f16* DY) {
    const size_t total = (size_t)MREAL * 1024, stride = (size_t)gridDim.x * NTHREADS;
    for (size_t i = (size_t)obid() * NTHREADS + otid(); i < total; i += stride) {
        const int row = (int)(i >> 10), c = (int)(i & 1023);
        const int b = row < MMAIN ? row >> 11 : 0, t = row < MMAIN ? (row & 2047) + NMETA : row - MMAIN;
        const int win = 2 << (c >> 8);
        const int cnt = (t + 1) < win ? (t + 1) : win;
        float s = 0.f;
        for (int j = 0; j < cnt; ++j) s += (float)U[(size_t)row_of(b, t - j) * D + c];
        DY[(size_t)row * D + c] = (f16)(s / (float)cnt - (float)U[(size_t)row * D + c]);
    }
}

__device__ __forceinline__ float gelu_tanh(float x) {
    const float k0 = 0.7978845608028654f, k1 = 0.044715f;
    const float u = k0 * (x + k1 * x * x * x);
    return x * __builtin_amdgcn_rcpf(1.f + __expf(-2.f * u));
}

typedef _Float16 f16x8 __attribute__((ext_vector_type(8)));
constexpr int SSM_WAVE_LDS = 128 * 20 * 4 + 16 * 136 * 2;
constexpr int SSM_CARRY_OFF = 8 * SSM_WAVE_LDS;
__device__ __forceinline__ void ssm_phase(const Params& p, const f16* U, f16* DY, LAS unsigned char* lds) {
    const int tid_ = otid(), lane = tid_ & 63, wv = __builtin_amdgcn_readfirstlane(tid_ >> 6), l15 = lane & 15, g2 = lane >> 4;
    LAS float* BUT = (LAS float*)(lds + wv * SSM_WAVE_LDS);
    LAS f16* HT = (LAS f16*)(lds + wv * SSM_WAVE_LDS + 128 * 20 * 4);
    typedef float f32x2_t __attribute__((ext_vector_type(2)));
    LAS f32x2_t* CARRY = (LAS f32x2_t*)(lds + SSM_CARRY_OFF);
    for (int item = obid(); item < 256; item += gridDim.x) {
        const int b = item >> 6, g = item & 63, n = lane;
        const float dt = expf(p.in[I_LOGDT][g]);
        const float ar = p.in[I_LRE][g * 64 + n], ai = p.in[I_LIM][g * 64 + n];
        float are, aim, pw0r, pw0i, pw1r, pw1i;
        { const float mag = expf(dt * ar); double sd, cd; sincos_d((double)(dt * ai), sd, cd); are = mag * (float)cd; aim = mag * (float)sd; }
        { const float mag = expf(272.f * dt * ar); double sd, cd; sincos_d(272.0 * (double)(dt * ai), sd, cd); pw0r = mag * (float)cd; pw0i = mag * (float)sd; }
        { const float mag = expf(256.f * dt * ar); double sd, cd; sincos_d(256.0 * (double)(dt * ai), sd, cd); pw1r = mag * (float)cd; pw1i = mag * (float)sd; }
        {
            const float den = ar * ar + ai * ai, zr = are - 1.f, zi = aim;
            const float fre = (zr * ar + zi * ai) / (den * dt), fim = (zi * ar - zr * ai) / (den * dt);
            LAS f16* TB = (LAS f16*)BUT;
#pragma unroll
            for (int c = 0; c < 16; ++c) {
                const float br = p.in[I_BRE][(g * 64 + n) * 16 + c], bi = p.in[I_BIM][(g * 64 + n) * 16 + c];
                TB[n * 16 + c] = (f16)(fre * br - fim * bi); TB[(64 + n) * 16 + c] = (f16)(fre * bi + fim * br);
            }
        }
        asm volatile("" ::: "memory");
        f16x8 bbf[8];
#pragma unroll
        for (int nt = 0; nt < 8; ++nt) {
            const f16x8 z = {0, 0, 0, 0, 0, 0, 0, 0};
            bbf[nt] = (g2 < 2) ? *(const LAS f16x8*)((const LAS f16*)BUT + (16 * nt + l15) * 16 + 8 * g2) : z;
        }
        asm volatile("" ::: "memory");
        f16x8 cf[4];
#pragma unroll
        for (int ks = 0; ks < 4; ++ks) {
            const int k = 32 * ks + 8 * g2;
            const float* src = (k < 64) ? (p.in[I_CRE] + (g * 16 + l15) * 64 + k) : (p.in[I_CIM] + (g * 16 + l15) * 64 + (k - 64));
            const float sg = (k < 64) ? 1.f : -1.f;
            const float4 x0 = ld4(src), x1 = ld4(src + 4);
            f16x8 v; v[0] = (f16)(sg * x0.x); v[1] = (f16)(sg * x0.y); v[2] = (f16)(sg * x0.z); v[3] = (f16)(sg * x0.w); v[4] = (f16)(sg * x1.x); v[5] = (f16)(sg * x1.y); v[6] = (f16)(sg * x1.z); v[7] = (f16)(sg * x1.w);
            cf[ks] = v;
        }
        float dd[4];
#pragma unroll
        for (int j = 0; j < 4; ++j) dd[j] = p.in[I_S5D][g * 16 + 4 * g2 + j];
        const int blk0 = (wv == 0) ? 0 : 17 + 16 * (wv - 1), nblk = (wv == 0) ? 17 : 16;
        float hr = 0.f, hi = 0.f;
#pragma unroll 1
        for (int pass = 0; pass < 2; ++pass) {
            if (pass == 1) {
                CARRY[wv * 64 + n] = (f32x2_t){hr, hi};
                __syncthreads();
                float cr = 0.f, ci = 0.f;
                for (int j = 0; j < wv; ++j) {
                    const f32x2_t e = CARRY[j * 64 + n]; const float pr = (j == 0) ? pw0r : pw1r, pi = (j == 0) ? pw0i : pw1i;
                    const float nr = pr * cr - pi * ci + e.x, ni = pr * ci + pi * cr + e.y; cr = nr; ci = ni;
                }
                hr = cr; hi = ci;
                __syncthreads();
            }
            f16x8 ua_n = {0, 0, 0, 0, 0, 0, 0, 0}; uint2 uu_n = {0u, 0u};
            { const int r0 = row_of(b, blk0 * 16 + l15); if (g2 < 2) ua_n = *(const f16x8*)(U + (size_t)r0 * D + 1024 + g * 16 + 8 * g2); uu_n = *(const uint2*)(U + (size_t)r0 * D + 1024 + g * 16 + 4 * g2); }
#pragma unroll 1
            for (int kb = 0; kb < nblk; ++kb) {
                const int t0 = (blk0 + kb) * 16;
                const int rowa = row_of(b, t0 + l15);
                const f16x8 ua = ua_n; const uint2 uu_c = uu_n;
                { const int tn = (kb + 1 < nblk) ? t0 + 16 : t0; const int rn = row_of(b, tn + l15);
                  if (g2 < 2) ua_n = *(const f16x8*)(U + (size_t)rn * D + 1024 + g * 16 + 8 * g2); uu_n = *(const uint2*)(U + (size_t)rn * D + 1024 + g * 16 + 4 * g2); }
                f32x4 bacc[8];
#pragma unroll
                for (int nt = 0; nt < 8; ++nt) bacc[nt] = __builtin_amdgcn_mfma_f32_16x16x32_f16(ua, bbf[nt], (f32x4){0.f, 0.f, 0.f, 0.f}, 0, 0, 0);
                __builtin_amdgcn_sched_barrier(0);
                asm volatile("s_nop 15\n\ts_nop 15" ::: "memory");
                __builtin_amdgcn_sched_barrier(0);
#pragma unroll
                for (int nt = 0; nt < 8; ++nt) *(LAS f32x4*)(BUT + (16 * nt + l15) * 20 + 4 * g2) = bacc[nt];
                asm volatile("" ::: "memory");
                float bre[16], bim[16];
#pragma unroll
                for (int q4 = 0; q4 < 4; ++q4) {
                    const f32x4 x = *(const LAS f32x4*)(BUT + n * 20 + 4 * q4), y = *(const LAS f32x4*)(BUT + (64 + n) * 20 + 4 * q4);
                    bre[4 * q4] = x[0]; bre[4 * q4 + 1] = x[1]; bre[4 * q4 + 2] = x[2]; bre[4 * q4 + 3] = x[3];
                    bim[4 * q4] = y[0]; bim[4 * q4 + 1] = y[1]; bim[4 * q4 + 2] = y[2]; bim[4 * q4 + 3] = y[3];
                }
#pragma unroll
                for (int tt = 0; tt < 16; ++tt) {
                    const float nr = fmaf(are, hr, fmaf(-aim, hi, bre[tt])), ni = fmaf(are, hi, fmaf(aim, hr, bim[tt]));
                    hr = nr; hi = ni;
                    if (pass == 1) { HT[tt * 136 + n] = (f16)hr; HT[tt * 136 + 64 + n] = (f16)hi; }
                }
                asm volatile("" ::: "memory");
                if (pass == 1) {
                    f32x4 ya = {0.f, 0.f, 0.f, 0.f};
#pragma unroll
                    for (int ks = 0; ks < 4; ++ks) {
                        const f16x8 hb = *(const LAS f16x8*)(HT + l15 * 136 + 32 * ks + 8 * g2);
                        ya = __builtin_amdgcn_mfma_f32_16x16x32_f16(cf[ks], hb, ya, 0, 0, 0);
                    }
                    __builtin_amdgcn_sched_barrier(0);
                    asm volatile("s_nop 15\n\ts_nop 15" ::: "memory");
                    __builtin_amdgcn_sched_barrier(0);
                    if (t0 >= NMETA || b == 0) {
                        const float2 uua = up2h(uu_c.x), uub = up2h(uu_c.y); const float4 uu = make_float4(uua.x, uua.y, uub.x, uub.y);
                        const float4 o = make_float4(gelu_tanh(dt * ya[0] + dd[0] * uu.x), gelu_tanh(dt * ya[1] + dd[1] * uu.y), gelu_tanh(dt * ya[2] + dd[2] * uu.z), gelu_tanh(dt * ya[3] + dd[3] * uu.w));
                        st4h(DY + (size_t)rowa * D + 1024 + g * 16 + 4 * g2, o);
                    }
                }
            }
        }
        __syncthreads();
    }
}

__device__ __forceinline__ void ssm_naive(const Params& p, const f16* U, f16* DY) {
    const int tid_ = otid(), lane = tid_ & 63, gw = obid() * (NTHREADS / 64) + (tid_ >> 6), ngw = gridDim.x * (NTHREADS / 64);
    for (int item = gw; item < 256; item += ngw) {
        const int b = item >> 6, g = item & 63, n = lane;
        const float dt = expf(p.in[I_LOGDT][g]);
        const float ar = p.in[I_LRE][g * 64 + n], ai = p.in[I_LIM][g * 64 + n];
        const float mag = expf(dt * ar); double sd, cd; sincos_d((double)(dt * ai), sd, cd); const float sn = (float)sd, cs = (float)cd;
        const float are = mag * cs, aim = mag * sn;
        const float den = ar * ar + ai * ai, zr = are - 1.f, zi = aim;
        const float fre = (zr * ar + zi * ai) / den, fim = (zi * ar - zr * ai) / den;
        float bbr[16], bbi[16], cr[16], ci[16];
#pragma unroll
        for (int c = 0; c < 16; ++c) {
            const float br = p.in[I_BRE][(g * 64 + n) * 16 + c], bi = p.in[I_BIM][(g * 64 + n) * 16 + c];
            bbr[c] = fre * br - fim * bi; bbi[c] = fre * bi + fim * br;
            cr[c] = p.in[I_CRE][(g * 16 + c) * 64 + n]; ci[c] = p.in[I_CIM][(g * 16 + c) * 64 + n];
        }
        const float dd = p.in[I_S5D][g * 16 + (lane & 15)];
        float hr = 0.f, hi = 0.f;
#pragma unroll 1
        for (int t = 0; t < T; ++t) {
            const int row = row_of(b, t);
            const f16* ur = U + (size_t)row * D + 1024 + g * 16;
            const float4 u0 = ld4(ur), u1 = ld4(ur + 4), u2 = ld4(ur + 8), u3 = ld4(ur + 12);
            const float uu[16] = {u0.x, u0.y, u0.z, u0.w, u1.x, u1.y, u1.z, u1.w, u2.x, u2.y, u2.z, u2.w, u3.x, u3.y, u3.z, u3.w};
            float bur = 0.f, bui = 0.f;
#pragma unroll
            for (int c = 0; c < 16; ++c) { bur = fmaf(bbr[c], uu[c], bur); bui = fmaf(bbi[c], uu[c], bui); }
            const float nhr = are * hr - aim * hi + bur, nhi = are * hi + aim * hr + bui;
            hr = nhr; hi = nhi;
            float myy = 0.f;
#pragma unroll
            for (int c = 0; c < 16; ++c) { const float v = wave_sum(cr[c] * hr - ci[c] * hi); if (lane == c) myy = v; }
            if (lane < 16 && (t >= NMETA || b == 0)) {
                const float y = myy + dd * (float)ur[lane];
                DY[(size_t)row * D + 1024 + g * 16 + lane] = (f16)gelu_tanh(y);
            }
        }
    }
}

__device__ __forceinline__ void build_rope(float2* R16, float2* R8) {
    const int total = T * 16, stride = (int)gridDim.x * NTHREADS;
    for (int i = obid() * NTHREADS + otid(); i < total; i += stride) {
        const int t = i >> 4, idx = i & 15;
        const float ang = (float)t * rope_inv16(idx);
        double sd, cd; sincos_d((double)ang, sd, cd);
        const float2 v = make_float2((float)cd, (float)sd);
        R16[i] = v; if ((idx & 1) == 0) R8[t * 8 + (idx >> 1)] = v;
    }
}
__device__ __forceinline__ void zero_kv_pads(f16* K16, f16* V16, f16* KI16) {
    const int per_b = (TP - T) * (512 + 512 + 64) / 8, total = 4 * per_b, stride = (int)gridDim.x * NTHREADS;
    for (int i = obid() * NTHREADS + otid(); i < total; i += stride) {
        const int b = i / per_b, r = i % per_b; const u32x4 z = {0u, 0u, 0u, 0u};
        if (r < (TP - T) * 64) *(u32x4*)(K16 + ((size_t)b * TP + T) * 512 + (size_t)r * 8) = z;
        else if (r < (TP - T) * 128) *(u32x4*)(V16 + ((size_t)b * TP + T) * 512 + (size_t)(r - (TP - T) * 64) * 8) = z;
        else *(u32x4*)(KI16 + ((size_t)b * TP + T) * 64 + (size_t)(r - (TP - T) * 128) * 8) = z;
    }
}
struct CinOut { f16* Q16; f16* K16; f16* V16; f16* QI16; f16* KI16; float* WI; const float2* R16; const float2* R8; };
__device__ __forceinline__ void rope_lanes(f32x4& v0, f32x4& v1, const float2* tab, int xr, bool active, bool second) {
    const float4 t0 = *(const float4*)(tab), t1 = *(const float4*)(tab + 2), t2 = *(const float4*)(tab + 4), t3 = *(const float4*)(tab + 6);
    const float cs[8] = {t0.x, t0.z, t1.x, t1.z, t2.x, t2.z, t3.x, t3.z}, sn[8] = {t0.y, t0.w, t1.y, t1.w, t2.y, t2.w, t3.y, t3.w};
    const float sg = second ? 1.f : -1.f;
#pragma unroll
    for (int e = 0; e < 4; ++e) {
        const float o0 = __shfl_xor(v0[e], xr), o1 = __shfl_xor(v1[e], xr);
        if (active) { v0[e] = v0[e] * cs[e] + sg * o0 * sn[e]; v1[e] = v1[e] * cs[4 + e] + sg * o1 * sn[4 + e]; }
    }
}
__device__ __forceinline__ void cin_epilogue(const CinOut& o, int r, int c, f32x4 v0, f32x4 v1) {
    const int fq = (threadIdx.x & 63) >> 4, cb = c & ~31;
    const bool valid = r < MREAL, mainrow = r < MMAIN;
    const int t = mainrow ? (r & 2047) + NMETA : (valid ? r - MMAIN : 0), b = r >> 11;
    if (cb < 2560) {
        if ((cb & 127) == 0) rope_lanes(v0, v1, o.R16 + t * 16 + 8 * (fq & 1), 32, true, fq >= 2);
        if (cb < 2048) { if (mainrow) st8h(o.Q16 + (size_t)r * D + c, v0, v1); }
        else if (mainrow) st8h(o.K16 + ((size_t)b * TP + t) * 512 + (c - 2048), v0, v1);
        else if (valid) { for (int bb = 0; bb < 4; ++bb) st8h(o.K16 + ((size_t)bb * TP + t) * 512 + (c - 2048), v0, v1); }
    } else if (cb < 3072) {
        if (mainrow) st8h(o.V16 + ((size_t)b * TP + t) * 512 + (c - 2560), v0, v1);
        else if (valid) { for (int bb = 0; bb < 4; ++bb) st8h(o.V16 + ((size_t)bb * TP + t) * 512 + (c - 2560), v0, v1); }
    } else if (cb < 4096) {
        if ((cb & 63) == 0) rope_lanes(v0, v1, o.R8 + t * 8, 16, fq < 2, fq == 1);
        if (mainrow) st8h(o.QI16 + (size_t)r * 1024 + (c - 3072), v0, v1);
    } else if (cb < 4160) {
        if (cb == 4096) rope_lanes(v0, v1, o.R8 + t * 8, 16, fq < 2, fq == 1);
        if (mainrow) st8h(o.KI16 + ((size_t)b * TP + t) * 64 + (c - 4096), v0, v1);
        else if (valid) { for (int bb = 0; bb < 4; ++bb) st8h(o.KI16 + ((size_t)bb * TP + t) * 64 + (c - 4096), v0, v1); }
    } else if (c < CIN) {
        if (mainrow) { float* w = o.WI + (size_t)r * 16 + (c - 4160); *(f32x4*)w = v0 * 0.03125f; *(f32x4*)(w + 4) = v1 * 0.03125f; }
    }
}

__device__ __forceinline__ void idx_scores(const f16* QI16, const f16* KI16, const float* WI, float* SCORE) {
    const int tid_ = otid(), lane = tid_ & 63, gw = obid() * (NTHREADS / 64) + (tid_ >> 6), ngw = gridDim.x * (NTHREADS / 64);
    for (int q = gw; q < MMAIN; q += ngw) {
        const int b = q >> 11, s = q & 2047, nall = 80 + 64 * (s >> 6);
        const f16* qi = QI16 + (size_t)q * 1024;
        const float* wi = WI + (size_t)q * 16;
        for (int t = lane; t < nall; t += 64) {
            const f16* kp = KI16 + ((size_t)b * TP + t) * 64;
            float4 kv[16];
#pragma unroll
            for (int j = 0; j < 16; ++j) kv[j] = ld4(kp + 4 * j);
            float score = 0.f;
#pragma unroll 1
            for (int h = 0; h < 16; ++h) {
                float dot = 0.f;
#pragma unroll
                for (int j = 0; j < 16; ++j) { const float4 qv = ld4(qi + h * 64 + 4 * j); dot += qv.x * kv[j].x + qv.y * kv[j].y + qv.z * kv[j].z + qv.w * kv[j].w; }
                score += wi[h] * fmaxf(dot, 0.f);
            }
            SCORE[(size_t)q * SROW + t] = score;
        }
    }
}

__device__ __forceinline__ unsigned okey(float f) { const unsigned u = __float_as_uint(f); return (u & 0x80000000u) ? ~u : (u | 0x80000000u); }
__device__ __forceinline__ void select_topk(const float* SCORE, unsigned long long* MASK) {
    const int tid_ = otid(), lane = tid_ & 63, gw = obid() * (NTHREADS / 64) + (tid_ >> 6), ngw = gridDim.x * (NTHREADS / 64);
    for (int q = gw; q < MMAIN; q += ngw) {
        const int s = q & 2047, nall = 80 + 64 * (s >> 6);
        unsigned key[33];
#pragma unroll
        for (int i = 0; i < 33; ++i) { const int t = 64 * i + lane; key[i] = (t < nall) ? okey(SCORE[(size_t)q * SROW + t]) : 0u; }
        unsigned long long mymask = 0ull;
        if (nall <= 256) {
#pragma unroll
            for (int i = 0; i < 33; ++i) { const unsigned long long m = __ballot(64 * i + lane < nall); if (lane == i) mymask = m; }
        } else {
            unsigned tau = 0u;
#pragma unroll 1
            for (int bit = 31; bit >= 0; --bit) {
                const unsigned cand = tau | (1u << bit); int cnt = 0;
#pragma unroll
                for (int i = 0; i < 33; ++i) cnt += __popcll(__ballot(key[i] >= cand));
                if (cnt >= 256) tau = cand;
            }
            int ngt = 0;
#pragma unroll
            for (int i = 0; i < 33; ++i) ngt += __popcll(__ballot(key[i] > tau));
            const int need = 256 - ngt; int eqb = 0;
            const unsigned long long lt = (1ull << lane) - 1ull;
#pragma unroll
            for (int i = 0; i < 33; ++i) {
                const unsigned long long gm = __ballot(key[i] > tau), em = __ballot(key[i] == tau);
                const int rank = eqb + __popcll(em & lt);
                const unsigned long long sm = __ballot(key[i] == tau && rank < need);
                if (lane == i) mymask = gm | sm;
                eqb += __popcll(em);
            }
        }
        if (lane < 33) MASK[(size_t)q * 33 + lane] = mymask;
    }
}

constexpr int IDX_WAVE_LDS = 2 * TP * 4;
__device__ __forceinline__ unsigned long long select_row(const LAS float* srow, int nall, int lane) {
    unsigned key[33];
#pragma unroll
    for (int i = 0; i < 33; ++i) { const int t = 64 * i + lane; key[i] = (t < nall) ? okey(srow[t]) : 0u; }
    unsigned long long mymask = 0ull;
    unsigned tau = 0u;
#pragma unroll 1
    for (int bit = 31; bit >= 0; --bit) {
        const unsigned cand = tau | (1u << bit); int cnt = 0;
#pragma unroll
        for (int i = 0; i < 33; ++i) cnt += __popcll(__ballot(key[i] >= cand));
        if (cnt >= 256) tau = cand;
        if (cnt == 256) break;
    }
    int ngt = 0;
#pragma unroll
    for (int i = 0; i < 33; ++i) ngt += __popcll(__ballot(key[i] > tau));
    const int need = 256 - ngt; int eqb = 0;
    const unsigned long long lt = (1ull << lane) - 1ull;
#pragma unroll
    for (int i = 0; i < 33; ++i) {
        const unsigned long long gm = __ballot(key[i] > tau), em = __ballot(key[i] == tau);
        const int rank = eqb + __popcll(em & lt);
        const unsigned long long sm = __ballot(key[i] == tau && rank < need);
        if (lane == i) mymask = gm | sm;
        eqb += __popcll(em);
    }
    return mymask;
}
__device__ __forceinline__ void index_select(const f16* QI16, const f16* KI16, const float* WI, unsigned long long* MASK, LAS unsigned char* lds) {
    const int tid_ = otid(), lane = tid_ & 63, wv = __builtin_amdgcn_readfirstlane(tid_ >> 6), l15 = lane & 15, g2 = lane >> 4;
    const int gw = obid() * (NTHREADS / 64) + wv;
    LAS float* SL = (LAS float*)(lds + wv * IDX_WAVE_LDS);
    if (gw >= 2048) return;
    const int b = gw >> 9, wq = gw & 511;
#pragma unroll 1
    for (int it = 0; it < 2; ++it) {
        const int u = (it == 0) ? wq : 1023 - wq, s0 = 2 * u, q0 = b * SEQ + s0, nall = 80 + 64 * (s0 >> 6);
        if (nall <= 256) {
            if (lane < 33) { const int lo = 64 * lane; const unsigned long long m = (nall >= lo + 64) ? ~0ull : (nall > lo ? ((1ull << (nall - lo)) - 1ull) : 0ull);
                MASK[(size_t)q0 * 33 + lane] = m; MASK[(size_t)(q0 + 1) * 33 + lane] = m; }
            continue;
        }
        f16x8 a[2][2]; float w[2][4];
#pragma unroll
        for (int qq = 0; qq < 2; ++qq) {
#pragma unroll
            for (int ks = 0; ks < 2; ++ks) a[qq][ks] = *(const f16x8*)(QI16 + (size_t)(q0 + qq) * 1024 + l15 * 64 + 32 * ks + 8 * g2);
            const float4 ww = ld4(WI + (size_t)(q0 + qq) * 16 + 4 * g2); w[qq][0] = ww.x; w[qq][1] = ww.y; w[qq][2] = ww.z; w[qq][3] = ww.w;
        }
        const int nkb = nall >> 4;
        const f16* kbase = KI16 + (size_t)b * TP * 64 + l15 * 64 + 8 * g2;
        f16x8 bf[2][2];
#pragma unroll
        for (int e = 0; e < 2; ++e)
#pragma unroll
            for (int ks = 0; ks < 2; ++ks) bf[e][ks] = *(const f16x8*)(kbase + (size_t)e * 16 * 64 + 32 * ks);
#pragma unroll 1
        for (int kb = 0; kb < nkb; kb += 2) {
            f16x8 nb[2][2];
#pragma unroll
            for (int e = 0; e < 2; ++e)
#pragma unroll
                for (int ks = 0; ks < 2; ++ks) nb[e][ks] = *(const f16x8*)(kbase + (size_t)(kb + 2 + e) * 16 * 64 + 32 * ks);
            f32x4 acc[2][2];
#pragma unroll
            for (int e = 0; e < 2; ++e)
#pragma unroll
                for (int qq = 0; qq < 2; ++qq) {
                    acc[e][qq] = __builtin_amdgcn_mfma_f32_16x16x32_f16(a[qq][0], bf[e][0], (f32x4){0.f, 0.f, 0.f, 0.f}, 0, 0, 0);
                    acc[e][qq] = __builtin_amdgcn_mfma_f32_16x16x32_f16(a[qq][1], bf[e][1], acc[e][qq], 0, 0, 0);
                }
            __builtin_amdgcn_sched_barrier(0);
            asm volatile("s_nop 15\n\ts_nop 15" ::: "memory");
            __builtin_amdgcn_sched_barrier(0);
#pragma unroll
            for (int e = 0; e < 2; ++e)
#pragma unroll
                for (int qq = 0; qq < 2; ++qq) {
                    const f32x4 c = acc[e][qq];
                    float sc = w[qq][0] * fmaxf(c[0], 0.f) + w[qq][1] * fmaxf(c[1], 0.f) + w[qq][2] * fmaxf(c[2], 0.f) + w[qq][3] * fmaxf(c[3], 0.f);
                    sc += __shfl_xor(sc, 16); sc += __shfl_xor(sc, 32);
                    if (g2 == 0) SL[qq * TP + (kb + e) * 16 + l15] = sc;
                }
#pragma unroll
            for (int e = 0; e < 2; ++e)
#pragma unroll
                for (int ks = 0; ks < 2; ++ks) bf[e][ks] = nb[e][ks];
        }
        asm volatile("" ::: "memory");
#pragma unroll 1
        for (int qq = 0; qq < 2; ++qq) {
            const unsigned long long m = select_row(SL + qq * TP, nall, lane);
            if (lane < 33) MASK[(size_t)(q0 + qq) * 33 + lane] = m;
        }
        asm volatile("" ::: "memory");
    }
}

__device__ __forceinline__ void attn_naive(float* lds, const f16* Q16, const f16* K16, const f16* V16, const unsigned long long* MASK, f16* O) {
    const int tid_ = otid(), lane = tid_ & 63, wv = tid_ >> 6, gw = obid() * (NTHREADS / 64) + wv, ngw = gridDim.x * (NTHREADS / 64);
    int* list = (int*)(lds + wv * 640);
    float* pl = lds + wv * 640 + 256;
    float* ql = lds + wv * 640 + 512;
    for (int item = gw; item < MMAIN * 16; item += ngw) {
        const int q = item >> 4, hq = item & 15, b = q >> 11, kvh = hq >> 2;
        int base = 0;
        for (int i = 0; i < 33; ++i) {
            const unsigned long long w = MASK[(size_t)q * 33 + i];
            if ((w >> lane) & 1ull) list[base + __popcll(w & ((1ull << lane) - 1ull))] = 64 * i + lane;
            base += __popcll(w);
        }
        const int nk = base;
        const f16* qp = Q16 + (size_t)q * D + hq * 128;
        ql[lane] = (float)qp[lane]; ql[64 + lane] = (float)qp[64 + lane];
        __builtin_amdgcn_s_waitcnt(0); __builtin_amdgcn_wave_barrier();
        float lg[4]; float mx = -INFINITY;
#pragma unroll
        for (int j = 0; j < 4; ++j) {
            const int kk = lane + 64 * j; lg[j] = -INFINITY;
            if (kk < nk) {
                const f16* kp = K16 + ((size_t)b * TP + list[kk]) * 512 + kvh * 128;
                float dot = 0.f;
#pragma unroll 4
                for (int d = 0; d < 128; d += 4) { const float4 kv = ld4(kp + d); dot += kv.x * ql[d] + kv.y * ql[d + 1] + kv.z * ql[d + 2] + kv.w * ql[d + 3]; }
                lg[j] = dot * 0.08838834764831845f;
            }
            mx = fmaxf(mx, lg[j]);
        }
        mx = wave_max(mx);
        float sm = 0.f;
#pragma unroll
        for (int j = 0; j < 4; ++j) { const int kk = lane + 64 * j; const float e = (kk < nk) ? expf(lg[j] - mx) : 0.f; sm += e; pl[kk] = e; }
        sm = wave_sum(sm);
        __builtin_amdgcn_s_waitcnt(0); __builtin_amdgcn_wave_barrier();
        float o0 = 0.f, o1 = 0.f;
#pragma unroll 2
        for (int kk = 0; kk < nk; ++kk) {
            const f16* vp = V16 + ((size_t)b * TP + list[kk]) * 512 + kvh * 128;
            const float pw = pl[kk];
            o0 = fmaf(pw, (float)vp[lane], o0); o1 = fmaf(pw, (float)vp[64 + lane], o1);
        }
        const float inv = 1.f / sm;
        O[(size_t)q * D + hq * 128 + lane] = (f16)(o0 * inv); O[(size_t)q * D + hq * 128 + 64 + lane] = (f16)(o1 * inv);
        __builtin_amdgcn_s_waitcnt(0); __builtin_amdgcn_wave_barrier();
    }
}

namespace att {
typedef short s16x4 __attribute__((ext_vector_type(4)));
typedef short s16x8 __attribute__((ext_vector_type(8)));
typedef float f32x16 __attribute__((ext_vector_type(16)));
typedef unsigned long long u64;
constexpr int NW = 8, QBLK = 32, KVBLK = 64, QS = 2048, KS = 512;
constexpr int SHM_V = KVBLK * 128 * 2, SHM_K = KVBLK * 128 * 2;
constexpr int LDS_BYTES = 2 * SHM_V + 2 * SHM_K + NW * 64 * 4;
constexpr float SCALE = 0.08838834764831845f, THR = 8.f;
#define AT_KSWZ(row, colB) ((row) * 256 + ((colB) ^ (((row) & 7) << 4)))
#define AT_SBAR() __builtin_amdgcn_sched_barrier(0)
__device__ __forceinline__ int v_st(int k, int c) { const int kk = (k & ~0xC) | ((k & 4) << 1) | ((k & 8) >> 1); return ((kk >> 3) * 4 + (c >> 5)) * 512 + ((kk & 7) * 32 + (c & 31)) * 2; }
__device__ __forceinline__ int v_rd_base(int lane) { return ((lane & 3) << 3) | (((lane >> 2) & 3) << 6) | (((lane >> 4) & 1) << 5) | (((lane >> 5) & 1) << 8); }
constexpr int v_rd_off(int d0, int ks, int half) { return d0 * 512 + ks * 4096 + half * 2048; }
__device__ __forceinline__ int crow(int r, int hi) { return (r & 3) + 8 * (r >> 2) + 4 * hi; }
__device__ __forceinline__ f16x8 load8(const f16* p) { return *(const f16x8*)p; }
__device__ __forceinline__ void mask_bits(f32x16& p0, f32x16& p1, u64 w, int hi) {
    const float NEG = -__builtin_inff();
    const unsigned lo = (unsigned)w >> (4 * hi), up = (unsigned)(w >> 32) >> (4 * hi);
#pragma unroll
    for (int r = 0; r < 16; ++r) {
        const int c = (r & 3) + 8 * (r >> 2);
        if (!((lo >> c) & 1u)) p0[r] = NEG;
        if (!((up >> c) & 1u)) p1[r] = NEG;
    }
}
__device__ __forceinline__ void partialSM(f32x16& p0, f32x16& p1, float& m_reg, float& mn, float& alpha) {
    float pmax = p0[0];
#pragma unroll
    for (int r = 1; r < 16; ++r) pmax = fmaxf(pmax, p0[r]);
#pragma unroll
    for (int r = 0; r < 16; ++r) pmax = fmaxf(pmax, p1[r]);
    { auto rr = __builtin_amdgcn_permlane32_swap(__float_as_uint(pmax), __float_as_uint(pmax), false, false);
      pmax = fmaxf(__uint_as_float(rr[0]), __uint_as_float(rr[1])); }
    constexpr float C2 = 1.4426950408889634f * SCALE;
    if (__builtin_expect(__all((pmax - m_reg) * SCALE <= THR), 1)) { mn = m_reg; alpha = 1.f; }
    else { mn = fmaxf(m_reg, pmax); alpha = __builtin_amdgcn_exp2f((m_reg - mn) * C2); m_reg = mn; }
    const float mnL = -mn * C2;
#pragma unroll
    for (int r = 0; r < 16; ++r) p0[r] = fmaf(p0[r], C2, mnL);
#pragma unroll
    for (int r = 0; r < 16; ++r) p1[r] = fmaf(p1[r], C2, mnL);
#pragma unroll
    for (int r = 0; r < 16; ++r) p0[r] = __builtin_amdgcn_exp2f(p0[r]);
}
__device__ __forceinline__ void finishSM(f32x16& p0, f32x16& p1, float alpha, float& l_reg, f16x8& pa0, f16x8& pa1, f16x8& pa2, f16x8& pa3) {
#pragma unroll
    for (int r = 0; r < 16; ++r) p1[r] = __builtin_amdgcn_exp2f(p1[r]);
    float ps = 0;
#pragma unroll
    for (int r = 0; r < 16; ++r) ps += p0[r];
#pragma unroll
    for (int r = 0; r < 16; ++r) ps += p1[r];
    { auto rr = __builtin_amdgcn_permlane32_swap(__float_as_uint(ps), __float_as_uint(ps), false, false);
      ps = __uint_as_float(rr[0]) + __uint_as_float(rr[1]); }
    l_reg = l_reg * alpha + ps;
#define AT_PK4(P, B_, OUT) do { unsigned a0 = pk2h(P[B_+0], P[B_+1]), a1 = pk2h(P[B_+2], P[B_+3]);                          \
        unsigned b0 = pk2h(P[B_+4], P[B_+5]), b1 = pk2h(P[B_+6], P[B_+7]);                                             \
        auto r0 = __builtin_amdgcn_permlane32_swap(a0, b0, false, false); auto r1 = __builtin_amdgcn_permlane32_swap(a1, b1, false, false); \
        u32x4 w_ = {r0[0], r1[0], r0[1], r1[1]}; OUT = __builtin_bit_cast(f16x8, w_); } while (0)
    AT_PK4(p0, 0, pa0); AT_PK4(p0, 8, pa1); AT_PK4(p1, 0, pa2); AT_PK4(p1, 8, pa3);
#undef AT_PK4
}
template <int KB>
__device__ __forceinline__ void qkt(f32x16& p0, f32x16& p1, LAS const unsigned char* K_lds, int r32, int hi, const f16x8* qr) {
    p0 = f32x16{}; p1 = f32x16{};
    LAS const unsigned char* kb[4];
#pragma unroll
    for (int dd = 0; dd < 4; ++dd) kb[dd] = K_lds + KB * SHM_K + AT_KSWZ(r32, (dd * 16 + hi * 8) * 2);
#pragma unroll
    for (int d0 = 0; d0 < 8; ++d0) { LAS const unsigned char* a = kb[d0 & 3] + (d0 >> 2) * 128;
        const f16x8 b0 = *(LAS const f16x8*)a;
        const f16x8 b1 = *(LAS const f16x8*)(a + 32 * 256);
        p0 = __builtin_amdgcn_mfma_f32_32x32x16_f16(b0, qr[d0], p0, 0, 0, 0);
        p1 = __builtin_amdgcn_mfma_f32_32x32x16_f16(b1, qr[d0], p1, 0, 0, 0); }
}
template <int VB>
__device__ __forceinline__ void pv_tile(f32x16* o, int vb0, f16x8 pa0, f16x8 pa1, f16x8 pa2, f16x8 pa3) {
#define AT_TRRD(dst, off) asm volatile("ds_read_b64_tr_b16 %0, %1 offset:%2" : "=&v"(dst) : "v"(vb0), "i"(off) : "memory")
#define AT_CAT(l, h) __builtin_bit_cast(f16x8, (s16x8){l[0], l[1], l[2], l[3], h[0], h[1], h[2], h[3]})
#define AT_PV_D0(d0) do { s16x4 l0, l1, l2, l3, h0, h1, h2, h3; constexpr int b_ = VB * SHM_V + v_rd_off(d0, 0, 0); \
        AT_TRRD(l0, b_); AT_TRRD(h0, b_ + 2048); AT_TRRD(l1, b_ + 4096); AT_TRRD(h1, b_ + 6144); AT_TRRD(l2, b_ + 8192); AT_TRRD(h2, b_ + 10240); AT_TRRD(l3, b_ + 12288); AT_TRRD(h3, b_ + 14336); \
        asm volatile("s_waitcnt lgkmcnt(0)" ::: "memory"); AT_SBAR();   \
        o[d0] = __builtin_amdgcn_mfma_f32_32x32x16_f16(pa0, AT_CAT(l0, h0), o[d0], 0, 0, 0);   \
        o[d0] = __builtin_amdgcn_mfma_f32_32x32x16_f16(pa1, AT_CAT(l1, h1), o[d0], 0, 0, 0);   \
        o[d0] = __builtin_amdgcn_mfma_f32_32x32x16_f16(pa2, AT_CAT(l2, h2), o[d0], 0, 0, 0);   \
        o[d0] = __builtin_amdgcn_mfma_f32_32x32x16_f16(pa3, AT_CAT(l3, h3), o[d0], 0, 0, 0); } while (0)
    AT_PV_D0(0); AT_PV_D0(1); AT_PV_D0(2); AT_PV_D0(3);
#undef AT_PV_D0
#undef AT_CAT
#undef AT_TRRD
}
struct BlockRef { const f16* Q; const f16* K; const f16* V; f16* O; const u64* M; int NT; };
struct Seam { f16x8 qr[8]; f16x8 st_v0, st_v1, st_k0, st_k1; };
#define AT_ROW(p, k0, rr) ((p) + (size_t)((k0) + (rr)) * KS + sc)
#define AT_VMW() asm volatile("s_waitcnt vmcnt(0)" ::: "memory")
#define AT_VMWN(n) asm volatile("s_waitcnt vmcnt(%0)" :: "i"(n) : "memory")
#define AT_SLOAD_H(Kp, Vp, k0) do { S.st_v0 = load8(AT_ROW(Vp, k0, sr)); S.st_v1 = load8(AT_ROW(Vp, k0, 32 + sr)); S.st_k0 = load8(AT_ROW(Kp, k0, sr)); S.st_k1 = load8(AT_ROW(Kp, k0, 32 + sr)); } while (0)
#define AT_SWRITE_HK(bf) do { *(LAS f16x8*)(K_lds + (bf) * SHM_K + kws) = S.st_k0; *(LAS f16x8*)(K_lds + (bf) * SHM_K + kws + 32 * 256) = S.st_k1; } while (0)
#define AT_SWRITE_HV(bf) do { *(LAS f16x8*)(V_lds + (bf) * SHM_V + vst0) = S.st_v0; *(LAS f16x8*)(V_lds + (bf) * SHM_V + vst1) = S.st_v1; } while (0)
#define AT_SWRITE_H(bf) do { AT_SWRITE_HV(bf); AT_SWRITE_HK(bf); } while (0)
__device__ __forceinline__ void prime(const BlockRef& cur, LAS unsigned char* lds, Seam& S) {
    const int tid = otid(), wid = __builtin_amdgcn_readfirstlane(tid >> 6), lane = tid & 63, r32 = lane & 31, hi = lane >> 5;
    const int sr = tid >> 4, sc = (tid & 15) * 8, kws = AT_KSWZ(sr, sc * 2); LAS unsigned char* K_lds = lds + 2 * SHM_V;
#pragma unroll
    for (int d0 = 0; d0 < 8; ++d0) S.qr[d0] = load8(cur.Q + (size_t)(wid * QBLK + r32) * QS + d0 * 16 + hi * 8);
    AT_SLOAD_H(cur.K, cur.V, 0); AT_VMW(); AT_SWRITE_HK(0);
    __syncthreads();
}
__device__ __forceinline__ void block(const BlockRef& cur, const BlockRef& nxt, LAS unsigned char* lds, Seam& S) {
    const int tid = otid(), wid = __builtin_amdgcn_readfirstlane(tid >> 6), lane = tid & 63, r32 = lane & 31, hi = lane >> 5;
    const int NT = cur.NT;
    LAS unsigned char* V_lds = lds; LAS unsigned char* K_lds = lds + 2 * SHM_V;
    LAS float* ws = (LAS float*)(lds + 2 * SHM_V + 2 * SHM_K) + wid * 64; LAS float* li_l = ws; LAS float* al_l = ws + 32;
    float m_reg = -1e30f, l_reg = 0; f32x16 o[4] = {};
    const int sr = tid >> 4, sc = (tid & 15) * 8, vst0 = v_st(sr, sc), vst1 = v_st(32 + sr, sc), kws = AT_KSWZ(sr, sc * 2);
    const int vb0 = (int)(unsigned)(size_t)V_lds + v_rd_base(lane);
    const f16* Kh = cur.K; const f16* Vh = cur.V;
    const u64* mrow = cur.M + (size_t)(wid * QBLK + r32) * 33;
    u64 mw;
#define AT_RESC(a) do { if (__any((a) < 1.f)) { if (hi == 0) al_l[r32] = (a); asm volatile("s_waitcnt lgkmcnt(0)" ::: "memory");              \
                     for (int d_ = 0; d_ < 4; ++d_) for (int r = 0; r < 16; ++r) o[d_][r] *= al_l[crow(r, hi)]; } } while (0)
#define AT_KBASE(t) ((t) * KVBLK)
#define AT_SEAM_K0() do { AT_VMWN(8); AT_SWRITE_HK(0); AT_SBAR(); } while (0)
    f32x16 pA0, pA1, pB0, pB1; float mnA, mnB, alA, alB; f16x8 pa0, pa1, pa2, pa3;
    AT_SWRITE_HV(0); AT_SBAR();
    mw = mrow[0];
    if (NT > 1) { AT_SLOAD_H(Kh, Vh, AT_KBASE(1)); }
    AT_SBAR(); qkt<0>(pA0, pA1, K_lds, r32, hi, S.qr);
    mask_bits(pA0, pA1, mw, hi); partialSM(pA0, pA1, m_reg, mnA, alA);
    if (NT > 1) { AT_VMW(); AT_SWRITE_H(1); }
    __syncthreads();
#define AT_HALF_STEP(PX0, PX1, mnX, alX, PY0, PY1, alY, t, KB, VB, SB) do {                                                      \
        AT_SBAR(); mw = mrow[(t)]; qkt<KB>(PX0, PX1, K_lds, r32, hi, S.qr);                                             \
        finishSM(PY0, PY1, alY, l_reg, pa0, pa1, pa2, pa3); AT_SBAR();                                                           \
        if ((t) + 1 < NT) { AT_SLOAD_H(Kh, Vh, AT_KBASE((t) + 1)); AT_SBAR(); }                                               \
        pv_tile<VB>(o, vb0, pa0, pa1, pa2, pa3); mask_bits(PX0, PX1, mw, hi); partialSM(PX0, PX1, m_reg, mnX, alX);                                        \
        __syncthreads();                                                                                                      \
        if ((t) + 1 < NT) { AT_VMW(); AT_SWRITE_H(SB); }                                                                          \
        AT_RESC(alX); __syncthreads(); } while (0)
    for (int t = 1; t + 1 < NT; t += 2) {
        AT_HALF_STEP(pB0, pB1, mnB, alB, pA0, pA1, alA, t, 1, 0, 0);
        AT_HALF_STEP(pA0, pA1, mnA, alA, pB0, pB1, alB, t + 1, 0, 1, 1);
    }
    const bool even = (NT & 1) == 0;
    if (even) { AT_SBAR(); mw = mrow[NT - 1]; qkt<1>(pB0, pB1, K_lds, r32, hi, S.qr); AT_SBAR(); }
    AT_SLOAD_H(nxt.K, nxt.V, 0); AT_SBAR();
#pragma unroll
    for (int d0 = 0; d0 < 8; ++d0) S.qr[d0] = load8(nxt.Q + (size_t)(wid * QBLK + r32) * QS + d0 * 16 + hi * 8);
    AT_SBAR();
    finishSM(pA0, pA1, alA, l_reg, pa0, pa1, pa2, pa3); AT_SBAR();
    pv_tile<0>(o, vb0, pa0, pa1, pa2, pa3);
    if (even) { mask_bits(pB0, pB1, mw, hi); partialSM(pB0, pB1, m_reg, mnB, alB); __syncthreads(); AT_RESC(alB);
        finishSM(pB0, pB1, alB, l_reg, pa0, pa1, pa2, pa3); AT_SBAR(); pv_tile<1>(o, vb0, pa0, pa1, pa2, pa3); }
    AT_SBAR(); AT_SEAM_K0();
    if (hi == 0) li_l[r32] = l_reg; asm volatile("s_waitcnt lgkmcnt(0)" ::: "memory");
    float rli[16];
#pragma unroll
    for (int r = 0; r < 16; ++r) rli[r] = __builtin_amdgcn_rcpf(li_l[crow(r, hi)]);
    f16* Ow = cur.O + (size_t)(wid * QBLK) * QS;
#pragma unroll
    for (int r = 0; r < 16; ++r) { const int orow = crow(r, hi);
#pragma unroll
        for (int d0 = 0; d0 < 4; ++d0) { const float v = o[d0][r] * rli[r];
            const float vn = __shfl_xor(v, 1);
            if ((r32 & 1) == 0) *(unsigned*)(Ow + (size_t)orow * QS + d0 * 32 + r32) = pk2h(v, vn); } }
    __syncthreads();
#undef AT_RESC
#undef AT_KBASE
#undef AT_SEAM_K0
#undef AT_HALF_STEP
}
#undef AT_ROW
#undef AT_VMW
#undef AT_VMWN
#undef AT_SLOAD_H
#undef AT_SWRITE_HK
#undef AT_SWRITE_HV
#undef AT_SWRITE_H
}
__device__ __forceinline__ att::BlockRef att_unit(const f16* Q16, const f16* K16, const f16* V16, const unsigned long long* MASK, f16* O16, int b, int h, int x) {
    att::BlockRef r; const size_t row0 = (size_t)b * SEQ + 256 * x; const int kvh = h >> 2;
    r.Q = Q16 + row0 * D + h * 128; r.K = K16 + (size_t)b * TP * 512 + kvh * 128; r.V = V16 + (size_t)b * TP * 512 + kvh * 128;
    r.O = O16 + row0 * D + h * 128; r.M = MASK + row0 * 33; r.NT = 4 * x + 5; return r;
}
__device__ __forceinline__ void attn_phase(LAS unsigned char* lds, const f16* Q16, const f16* K16, const f16* V16, const unsigned long long* MASK, f16* O16) {
    const int bid = obid();
    if (bid < 256) {
        const int xcd = bid & 7, j = bid >> 3, combo = xcd * 2 + (j & 1), item = j >> 1, hl = item >> 2, pp = item & 3;
        const int b = combo >> 2, kvh = combo & 3, h = kvh * 4 + hl;
        const att::BlockRef u0 = att_unit(Q16, K16, V16, MASK, O16, b, h, 7 - pp), u1 = att_unit(Q16, K16, V16, MASK, O16, b, h, pp);
        att::Seam S;
        att::prime(u0, lds, S);
        att::block(u0, u1, lds, S);
        att::block(u1, u1, lds, S);
    }
}

template <class F>
__device__ __forceinline__ void gemm(LAS unsigned char* lds, const f16* A, int lda, const f16* Bt, int ldb, int M, int N, int K, int cu, F f) {
    pg8::Gemm g{A, Bt, M, N, K, lda, ldb};
    pg8::StaticOrder S; S.init(M, N, (int)gridDim.x, cu);
    pg8::EpiRow8<F> E{f};
    pg8::gemm_phase<pg8::EpiRow8<F>, pg8::StaticOrder, true, true>(lds, g, S, E);
}

template <class F>
__device__ __forceinline__ void skinny_group(LAS unsigned char* lds, const f16* A, int lda, const f16* Bt, int ldb, int K, int n0, F f) {
    const int tid = otid(), lane = tid & 63, wv = __builtin_amdgcn_readfirstlane(tid >> 6), l15 = lane & 15, g2 = lane >> 4;
    const f16* ap = A + (size_t)l15 * lda + 8 * g2;
    const f16* bp = Bt + (size_t)(n0 + 16 * wv + l15) * ldb + 8 * g2;
    f32x4 acc0 = {0.f, 0.f, 0.f, 0.f}, acc1 = {0.f, 0.f, 0.f, 0.f};
#pragma unroll 4
    for (int k = 0; k < K; k += 64) {
        const f16x8 a0 = *(const f16x8*)(ap + k), b0 = *(const f16x8*)(bp + k), a1 = *(const f16x8*)(ap + k + 32), b1 = *(const f16x8*)(bp + k + 32);
        acc0 = __builtin_amdgcn_mfma_f32_16x16x32_f16(a0, b0, acc0, 0, 0, 0);
        acc1 = __builtin_amdgcn_mfma_f32_16x16x32_f16(a1, b1, acc1, 0, 0, 0);
    }
    __builtin_amdgcn_sched_barrier(0);
    asm volatile("s_nop 15\n\ts_nop 15" ::: "memory");
    __builtin_amdgcn_sched_barrier(0);
    const f32x4 acc = acc0 + acc1;
    LAS float* Tl = (LAS float*)lds;
#pragma unroll
    for (int j = 0; j < 4; ++j) Tl[(4 * g2 + j) * 132 + 16 * wv + l15] = acc[j];
    __syncthreads();
    const int row = tid >> 5, c4 = (tid & 31) * 4;
    const f32x4 v = *(const LAS f32x4*)(Tl + row * 132 + c4);
    f(row, n0 + c4, v, (const LAS float*)Tl);
    __syncthreads();
}
__device__ __forceinline__ void st4hv(f16* p, f32x4 v) { uint2 r; r.x = pk2h(v[0], v[1]); r.y = pk2h(v[2], v[3]); *(uint2*)p = r; }

#define XB_TMO      128
#define XB_XCNT(j)  (256  + 64 * (j))
#define XB_XSUB(j)  (1280 + 64 * (j))
#define XB_XGEN(j)  (2304 + 64 * (j))
#define XB_TOP      3328
#define XB_TOPGEN   3392
#define XCD_BAR_WORDS 3456
#define XB_SPIN_CAP (1u << 18)

__device__ __forceinline__ unsigned xb_ld(unsigned* p)              { return __hip_atomic_load(p, __ATOMIC_RELAXED, __HIP_MEMORY_SCOPE_AGENT); }
__device__ __forceinline__ unsigned xb_add(unsigned* p, unsigned v) { return __hip_atomic_fetch_add(p, v, __ATOMIC_RELAXED, __HIP_MEMORY_SCOPE_AGENT); }
__device__ __forceinline__ unsigned xb_xcc_id() { return (unsigned)__builtin_amdgcn_s_getreg((3 << 11) | 20) & 0xFu; }
#define XB_SPIN(cond, bar) do { unsigned _sp = 0; while (cond) { __builtin_amdgcn_s_sleep(1); \
    if ((++_sp & 255u) == 0u) { if (xb_ld(&(bar)[XB_TMO])) break; if (_sp > XB_SPIN_CAP) { atomicAdd(&(bar)[XB_TMO], 1u); break; } } } } while (0)

struct XcdBarrier {
    unsigned* bar; unsigned x;
    volatile LAS unsigned* st;
};

__device__ __forceinline__ XcdBarrier xcd_barrier_post(unsigned* bar, volatile LAS unsigned* st) {
    XcdBarrier b; b.bar = bar; b.x = xb_xcc_id(); b.st = st;
    if (threadIdx.x == 0) (void)xb_add(&bar[XB_XCNT(b.x)], 1u);
    return b;
}
__device__ __forceinline__ void xcd_barrier_complete(unsigned* bar, unsigned x, unsigned& nloc, unsigned& nx) {
    const unsigned G = gridDim.x * gridDim.y * gridDim.z;
    unsigned sum, cnt, mine, sp = 0u;
    for (;;) {
        sum = 0u; cnt = 0u; mine = 0u;
#pragma unroll
        for (unsigned j = 0; j < 16; ++j) { const unsigned c = xb_ld(&bar[XB_XCNT(j)]); sum += c; cnt += (c > 0u) ? 1u : 0u; mine = (j == x) ? c : mine; }
        if (sum == G) break;
        __builtin_amdgcn_s_sleep(1);
        if ((++sp & 255u) == 0u) { if (xb_ld(&bar[XB_TMO])) break; if (sp > XB_SPIN_CAP) { atomicAdd(&bar[XB_TMO], 1u); break; } }
    }
    nloc = mine > 0u ? mine : 1u; nx = cnt > 0u ? cnt : 1u;
}

__device__ __forceinline__ void xcd_barrier(const XcdBarrier& b) {
    asm volatile("s_waitcnt vmcnt(0)" ::: "memory");
    __syncthreads();
    if (threadIdx.x == 0) {
        unsigned* bar = b.bar;
        __builtin_amdgcn_s_waitcnt(0);
        unsigned nloc = b.st[0], nx = b.st[1];
        if (nloc == 0u) { xcd_barrier_complete(bar, b.x, nloc, nx); b.st[0] = nloc; b.st[1] = nx; }
        const unsigned old = xb_add(&bar[XB_XSUB(b.x)], 1u);
        const unsigned gen = old / nloc;
        if (old + 1u == (gen + 1u) * nloc) {
            __builtin_amdgcn_fence(__ATOMIC_RELEASE, "agent");
            asm volatile("s_waitcnt vmcnt(0)" ::: "memory");
            const unsigned og = xb_add(&bar[XB_TOP], 1u);
            const unsigned tg = og / nx;
            if (og + 1u == (tg + 1u) * nx) xb_add(&bar[XB_TOPGEN], 1u);
            else XB_SPIN(xb_ld(&bar[XB_TOPGEN]) == tg, bar);
            __builtin_amdgcn_fence(__ATOMIC_ACQUIRE, "agent");
            xb_add(&bar[XB_XGEN(b.x)], 1u);
            asm volatile("s_waitcnt vmcnt(0)" ::: "memory");
        } else {
            XB_SPIN(xb_ld(&bar[XB_XGEN(b.x)]) == gen, bar);
            __builtin_amdgcn_fence(__ATOMIC_ACQUIRE, "agent");
            asm volatile("s_waitcnt vmcnt(0)" ::: "memory");
        }
    }
    __syncthreads();
}

__global__ void __launch_bounds__(NTHREADS, 2) fwd(Params p) {
    cg::grid_group grid = cg::this_grid();
    extern __shared__ __attribute__((aligned(16))) unsigned char smem[];
    LAS unsigned char* lds = (LAS unsigned char*)smem;
    float* ldsf = (float*)smem;
    unsigned char* ws = p.ws;
    float* H = (float*)(ws + OFF_H); f16* A16 = (f16*)(ws + OFF_A16); f16* U16 = (f16*)(ws + OFF_U16);
    f16* DY16 = (f16*)(ws + OFF_DY16); f16* CAT16 = (f16*)(ws + OFF_CAT16);
    f16* HID16 = (f16*)(ws + OFF_BIG);
    CinOut co{(f16*)(ws + OFF_Q16), (f16*)(ws + OFF_K16), (f16*)(ws + OFF_V16), (f16*)(ws + OFF_QI16), (f16*)(ws + OFF_KI16), (float*)(ws + OFF_WI), (const float2*)(ws + OFF_ROPE16), (const float2*)(ws + OFF_ROPE8)};
    float* SCORE = (float*)(ws + OFF_SCORE); unsigned long long* MASK = (unsigned long long*)(ws + OFF_MASK); f16* O16 = (f16*)(ws + OFF_O16);
    const float* ng = p.in[I_NORMG];
    const int bid = (int)blockIdx.x, G = (int)gridDim.x;
    volatile LAS unsigned* bst = (volatile LAS unsigned*)(lds + LDS_BYTES - 64);
    if (threadIdx.x < 16) bst[threadIdx.x] = 0u;
    __syncthreads();
    const XcdBarrier xbar = xcd_barrier_post((unsigned*)(ws + OFF_BAR), bst);

    const f16* A16m = A16 + (size_t)MMAIN * D; f16* U16m = U16 + (size_t)MMAIN * D; const f16* DY16m = DY16 + (size_t)MMAIN * D; f16* CAT16m = CAT16 + (size_t)MMAIN * D; f16* HID16m = HID16 + (size_t)MMAIN * DFF;
    for (int rep_ = 0; rep_ < (((PROBE_MASK >> 0) & 1) ? 2 : 1); ++rep_) {
    convert_weights(p, ldsf);
    init_rows(p, H, A16);
    build_rope((float2*)(ws + OFF_ROPE16), (float2*)(ws + OFF_ROPE8));
    grid.sync();
    }
    for (int rep_ = 0; rep_ < (((PROBE_MASK >> 1) & 1) ? 2 : 1); ++rep_) {
    for (int gi = bid; gi < 16; gi += G)
        skinny_group(lds, A16m, D, (const f16*)(ws + W_IN), D, D, 128 * gi, [=](int r, int c, f32x4 v, const LAS float*) { st4hv(U16m + (size_t)r * D + c, v); });
    gemm(lds, A16, D, (const f16*)(ws + W_IN), D, MMAIN, D, D, bid, [=](int r, int c, f32x4 v0, f32x4 v1) { st8h(U16 + (size_t)r * D + c, v0, v1); });
    xcd_barrier(xbar);
    }
    for (int rep_ = 0; rep_ < (((PROBE_MASK >> 2) & 1) ? 2 : 1); ++rep_) {
    pool_diff(U16, DY16);
    ssm_phase(p, U16, DY16, lds);
    xcd_barrier(xbar);
    }
    for (int rep_ = 0; rep_ < (((PROBE_MASK >> 3) & 1) ? 2 : 1); ++rep_) {
    for (int gi = bid; gi < 16; gi += G) {
        if (gi < 8) { const int g = gi >> 1, n0 = 128 * (gi & 1); const float* ps = p.in[I_POOLS] + g * 256;
            skinny_group(lds, DY16m + g * 256, D, (const f16*)(ws + W_POOL) + (size_t)g * 65536, 256, 256, n0,
                         [=](int r, int c, f32x4 v, const LAS float*) { st4hv(CAT16m + (size_t)r * D + g * 256 + c, v * *(const f32x4*)(ps + c)); });
        } else {
            skinny_group(lds, DY16m + 1024, D, (const f16*)(ws + W_GLU), 1024, 1024, 128 * (gi - 8), [=](int r, int c, f32x4 v, const LAS float*) {
                const float4 y = ld4(DY16m + (size_t)r * D + 1024 + c);
                f32x4 o; o[0] = y.x / (1.f + __expf(-v[0])); o[1] = y.y / (1.f + __expf(-v[1])); o[2] = y.z / (1.f + __expf(-v[2])); o[3] = y.w / (1.f + __expf(-v[3]));
                st4hv(CAT16m + (size_t)r * D + 1024 + c, o); });
        }
    }
    for (int g = 0; g < 4; ++g) {
        const float* ps = p.in[I_POOLS] + g * 256;
        gemm(lds, DY16 + g * 256, D, (const f16*)(ws + W_POOL) + (size_t)g * 65536, 256, MMAIN, 256, 256, (bid + G - 32 * g) % G,
             [=](int r, int c, f32x4 v0, f32x4 v1) { const f32x4 s0 = *(const f32x4*)(ps + c), s1 = *(const f32x4*)(ps + c + 4); st8h(CAT16 + (size_t)r * D + g * 256 + c, v0 * s0, v1 * s1); });
    }
    gemm(lds, DY16 + 1024, D, (const f16*)(ws + W_GLU), 1024, MMAIN, 1024, 1024, (bid + G - 128) % G,
         [=](int r, int c, f32x4 v0, f32x4 v1) {
             const f16* yp = DY16 + (size_t)r * D + 1024 + c; const float4 y0 = ld4(yp), y1 = ld4(yp + 4);
             f32x4 o0, o1;
             o0[0] = y0.x / (1.f + __expf(-v0[0])); o0[1] = y0.y / (1.f + __expf(-v0[1])); o0[2] = y0.z / (1.f + __expf(-v0[2])); o0[3] = y0.w / (1.f + __expf(-v0[3]));
             o1[0] = y1.x / (1.f + __expf(-v1[0])); o1[1] = y1.y / (1.f + __expf(-v1[1])); o1[2] = y1.z / (1.f + __expf(-v1[2])); o1[3] = y1.w / (1.f + __expf(-v1[3]));
             st8h(CAT16 + (size_t)r * D + 1024 + c, o0, o1); });
    xcd_barrier(xbar);
    }
    for (int rep_ = 0; rep_ < (((PROBE_MASK >> 4) & 1) ? 2 : 1); ++rep_) {
    for (int gi = bid; gi < 16; gi += G)
        skinny_group(lds, CAT16m, D, (const f16*)(ws + W_OUT), D, D, 128 * gi, [=](int r, int c, f32x4 v, const LAS float*) { st4hv(U16m + (size_t)r * D + c, v); });
    gemm(lds, CAT16, D, (const f16*)(ws + W_OUT), D, MMAIN, D, D, bid, [=](int r, int c, f32x4 v0, f32x4 v1) { st8h(U16 + (size_t)r * D + c, v0, v1); });
    xcd_barrier(xbar);
    }
    rowpass(U16, ng + 1 * D, ng + 2 * D, H, A16, nullptr, MREAL);
    xcd_barrier(xbar);
    for (int rep_ = 0; rep_ < (((PROBE_MASK >> 6) & 1) ? 2 : 1); ++rep_) {
    for (int gi = bid; gi < 64; gi += G)
        skinny_group(lds, A16m, D, (const f16*)(ws + W_1), D, D, 128 * gi, [=](int r, int c, f32x4 v, const LAS float*) {
            const f32x4 z = __builtin_elementwise_max(v, (f32x4){0.f, 0.f, 0.f, 0.f}); st4hv(HID16m + (size_t)r * DFF + c, z * z); });
    gemm(lds, A16, D, (const f16*)(ws + W_1), D, MMAIN, DFF, D, bid, [=](int r, int c, f32x4 v0, f32x4 v1) {
        f32x4 z0 = __builtin_elementwise_max(v0, (f32x4){0.f, 0.f, 0.f, 0.f}), z1 = __builtin_elementwise_max(v1, (f32x4){0.f, 0.f, 0.f, 0.f}); st8h(HID16 + (size_t)r * DFF + c, z0 * z0, z1 * z1); });
    xcd_barrier(xbar);
    }
    for (int rep_ = 0; rep_ < (((PROBE_MASK >> 7) & 1) ? 2 : 1); ++rep_) {
    for (int gi = bid; gi < 16; gi += G)
        skinny_group(lds, HID16m, DFF, (const f16*)(ws + W_2), DFF, DFF, 128 * gi, [=](int r, int c, f32x4 v, const LAS float*) { st4hv(U16m + (size_t)r * D + c, v); });
    gemm(lds, HID16, DFF, (const f16*)(ws + W_2), DFF, MMAIN, D, DFF, bid, [=](int r, int c, f32x4 v0, f32x4 v1) { st8h(U16 + (size_t)r * D + c, v0, v1); });
    xcd_barrier(xbar);
    }
    rowpass(U16, ng + 3 * D, ng + 4 * D, H, A16, nullptr, MREAL);
    zero_kv_pads(co.K16, co.V16, co.KI16);
    xcd_barrier(xbar);
    for (int rep_ = 0; rep_ < (((PROBE_MASK >> 9) & 1) ? 2 : 1); ++rep_) {
    gemm(lds, A16, D, (const f16*)(ws + W_CIN), D, MP, CINP, D, bid, [=](int r, int c, f32x4 v0, f32x4 v1) { cin_epilogue(co, r, c, v0, v1); });
    xcd_barrier(xbar);
    }
    for (int rep_ = 0; rep_ < (((PROBE_MASK >> 10) & 1) ? 2 : 1); ++rep_) {
    index_select(co.QI16, co.KI16, co.WI, MASK, lds);
    xcd_barrier(xbar);
    }
    for (int rep_ = 0; rep_ < (((PROBE_MASK >> 12) & 1) ? 2 : 1); ++rep_) {
    attn_phase(lds, co.Q16, co.K16, co.V16, MASK, O16);
    xcd_barrier(xbar);
    }
    for (int rep_ = 0; rep_ < (((PROBE_MASK >> 13) & 1) ? 2 : 1); ++rep_) {
    gemm(lds, O16, D, (const f16*)(ws + W_COUT), D, MMAIN, D, D, bid, [=](int r, int c, f32x4 v0, f32x4 v1) { st8h(U16 + (size_t)r * D + c, v0, v1); });
    xcd_barrier(xbar);
    }
    rowpass(U16, ng + 5 * D, ng + 6 * D, H, A16, nullptr, MMAIN);
    xcd_barrier(xbar);
    for (int rep_ = 0; rep_ < (((PROBE_MASK >> 15) & 1) ? 2 : 1); ++rep_) {
    gemm(lds, A16, D, (const f16*)(ws + W_1) + (size_t)D * DFF, D, MMAIN, DFF, D, bid, [=](int r, int c, f32x4 v0, f32x4 v1) {
        f32x4 z0 = __builtin_elementwise_max(v0, (f32x4){0.f, 0.f, 0.f, 0.f}), z1 = __builtin_elementwise_max(v1, (f32x4){0.f, 0.f, 0.f, 0.f}); st8h(HID16 + (size_t)r * DFF + c, z0 * z0, z1 * z1); });
    xcd_barrier(xbar);
    }
    for (int rep_ = 0; rep_ < (((PROBE_MASK >> 16) & 1) ? 2 : 1); ++rep_) {
    gemm(lds, HID16, DFF, (const f16*)(ws + W_2) + (size_t)D * DFF, DFF, MMAIN, D, DFF, bid, [=](int r, int c, f32x4 v0, f32x4 v1) { st8h(U16 + (size_t)r * D + c, v0, v1); });
    xcd_barrier(xbar);
    }
    rowpass(U16, ng + 7 * D, nullptr, H, nullptr, p.out, MMAIN);
}

extern "C" void kernel_launch(void* const* d_in, const int* in_sizes, int n_in, void* d_out, int out_size, void* d_ws, size_t ws_size, hipStream_t stream) {
    static int grid_blocks = 0;
    if (!grid_blocks) {
        if (n_in != 20 || out_size != MMAIN * D || ws_size < WS_NEED) { fprintf(stderr, "kernel_launch: unexpected shapes n_in %d out %d ws %zu (need %zu)\n", n_in, out_size, ws_size, (size_t)WS_NEED); grid_blocks = -1; return; }
        int dev = 0, cus = 0, per_cu = 0;
        (void)hipGetDevice(&dev);
        (void)hipDeviceGetAttribute(&cus, hipDeviceAttributeMultiprocessorCount, dev);
        if (hipFuncSetAttribute((const void*)fwd, hipFuncAttributeMaxDynamicSharedMemorySize, LDS_BYTES) != hipSuccess) { fprintf(stderr, "kernel_launch: hipFuncSetAttribute failed\n"); grid_blocks = -1; return; }
        (void)hipOccupancyMaxActiveBlocksPerMultiprocessor(&per_cu, fwd, NTHREADS, LDS_BYTES);
        if (per_cu < 1) { fprintf(stderr, "kernel_launch: occupancy query says %d blocks per CU\n", per_cu); per_cu = 1; }
        grid_blocks = cus;
    }
    if (grid_blocks < 0) return;
    Params p{};
    for (int i = 0; i < 20; ++i) p.in[i] = (const float*)d_in[i];
    p.out = (float*)d_out; p.ws = (unsigned char*)d_ws;
    if (hipMemsetAsync((char*)d_ws + OFF_BAR, 0, SZ_BAR, stream) != hipSuccess) { fprintf(stderr, "kernel_launch: hipMemsetAsync failed\n"); return; }
    void* args[] = {&p};
    hipError_t e = hipLaunchCooperativeKernel((void*)fwd, dim3(grid_blocks), dim3(NTHREADS), args, LDS_BYTES, stream);
    if (e != hipSuccess) fprintf(stderr, "cooperative launch failed: %s (grid %d)\n", hipGetErrorString(e), grid_blocks);
}
```

```cpp
#ifndef PROBE_MASK
#define PROBE_MASK 0
#endif
#include <hip/hip_runtime.h>
#include <hip/hip_fp16.h>
#include <hip/hip_cooperative_groups.h>
#include <cstdio>
#include <cstdint>
#include <cmath>
namespace cg = cooperative_groups;
__device__ __forceinline__ int otid() { int t = threadIdx.x; asm volatile("" : "+v"(t)); return t; }
__device__ __forceinline__ int obid() { int t = blockIdx.x; asm volatile("" : "+s"(t)); return t; }

namespace pg8 {
#define PG8_LAS __attribute__((address_space(3)))
typedef _Float16 f16_t;
typedef _Float16 f16x8 __attribute__((ext_vector_type(8)));
typedef float f32x4 __attribute__((ext_vector_type(4)));
typedef unsigned u32x4 __attribute__((ext_vector_type(4)));
constexpr int BM = 256, BK = 64, HALF = 128, HTB = HALF * BK * 2  , STAGE_BYTES = 8 * HTB, NXCD = 8, WGM = 8;

__host__ __device__ __forceinline__ int lds_byte(int r, int c) { const int st = (r >> 4) * 2 + (c >> 5), rr = r & 15, cc = c & 31, ob = rr * 64 + cc * 2; return st * 1024 + (ob ^ (((ob >> 9) & 1) << 5)); }
__host__ __device__ __forceinline__ void stage_rc(int b, int& R, int& C) { const int st = b / 1024, sb = b % 1024, swz = sb ^ (((sb >> 9) & 1) << 5); R = (st >> 1) * 16 + swz / 64; C = (st & 1) * 32 + (swz % 64) / 2; }
__host__ __device__ __forceinline__ int perm32(int rho) { const int n = rho >> 4, i = rho & 15; return 8 * (i >> 2) + 4 * n + (i & 3); }

struct Unit { int pm, pn; };
struct Gemm { const f16_t* A; const f16_t* Bt; int M, N, K, lda, ldb; };

struct StaticOrder {
    int nM, nN, nwg, G, c;
    __host__ __device__ void init(int M, int N, int G_, int c_) { nM = M / BM; nN = N / BM; nwg = nM * nN; G = G_; c = c_; }
    __host__ __device__ bool next(int i, Unit& u) const {
        const long L = (long)i * G + c; if (L >= nwg) return false;
        int wgid = (int)L; { const int q = nwg / NXCD, r = nwg % NXCD, xcd = wgid % NXCD, off = wgid / NXCD; wgid = (xcd < r ? xcd * (q + 1) : r * (q + 1) + (xcd - r) * q) + off; }
        const int nig = WGM * nN, gid = wgid / nig, fm = gid * WGM, gsz = (nM - fm) < WGM ? (nM - fm) : WGM;
        u.pm = fm + ((wgid % nig) % gsz); u.pn = (wgid % nig) / gsz; return true;
    }
    __device__ __forceinline__ void a_ready(const Unit&) const {}
    __device__ __forceinline__ void done(const Unit&) const {}
};


template <class Epi, class Sched, bool ALIGN_EPI = false, bool SP2 = false>
__device__ __forceinline__ void gemm_phase(PG8_LAS unsigned char* lds, const Gemm g, const Sched& S, const Epi& E) {
    const int tid = otid(), wid = __builtin_amdgcn_readfirstlane(tid >> 6), lane = tid & 63, wr = wid >> 2, wc = wid & 3, fr = lane & 15, fq = lane >> 4;
    const int K = g.K, nt = K / BK;
    unsigned voffA[2], voffB[2];
#pragma unroll
    for (int i = 0; i < 2; ++i) { int R, C; stage_rc(tid * 16 + i * 8192, R, C); const int Rb = Epi::PERM ? ((R & ~31) + perm32(R & 31)) : R;
        voffA[i] = (unsigned)(R * g.lda + C) * 2u; voffB[i] = (unsigned)(Rb * g.ldb + C) * 2u; }
    const size_t kstep = (size_t)(BK * 2);
    const size_t hstepA = (size_t)HALF * g.lda * 2, hstepB = (size_t)HALF * g.ldb * 2;
    const size_t tstepA = 2 * hstepA, tstepB = 2 * hstepB;
    const unsigned ldsw = (unsigned)wid * 1024u;
    const int aoff = lds_byte(wr * 64 + fr, fq * 8), boff = lds_byte(wc * 32 + fr, fq * 8);
#define PG8_SA(b, h) (((b) * 2 + (h)) * HTB)
#define PG8_SB(b, h) ((4 + (b) * 2 + (h)) * HTB)
#define PG8_STAGE(bufoff, gbase, voff) do { _Pragma("unroll") for (int _i = 0; _i < 2; ++_i) \
        __builtin_amdgcn_global_load_lds((const unsigned*)((const char*)(gbase) + (voff)[_i]), (PG8_LAS unsigned*)(lds + (bufoff) + ldsw + _i * 8192), 16, 0, 0); } while (0)
#define PG8_LDA(dst, b, h) do { _Pragma("unroll") for (int m = 0; m < 4; ++m) _Pragma("unroll") for (int k = 0; k < 2; ++k) dst[m][k] = *(const PG8_LAS f16x8*)(lds + PG8_SA(b, h) + aoff + m * 2048 + k * 1024); } while (0)
#define PG8_LDB(dst, b, h) do { _Pragma("unroll") for (int n = 0; n < 2; ++n) _Pragma("unroll") for (int k = 0; k < 2; ++k) dst[n][k] = *(const PG8_LAS f16x8*)(lds + PG8_SB(b, h) + boff + n * 2048 + k * 1024); } while (0)
#define PG8_MMA(ai, bj, At, Bt) do { __builtin_amdgcn_s_setprio(1); _Pragma("unroll") for (int m = 0; m < 4; ++m) _Pragma("unroll") for (int n = 0; n < 2; ++n) _Pragma("unroll") for (int k = 0; k < 2; ++k) \
        acc[ai][bj][m][n] = __builtin_amdgcn_mfma_f32_16x16x32_f16(Bt[n][k], At[m][k], acc[ai][bj][m][n], 0, 0, 0); __builtin_amdgcn_s_setprio(0); } while (0)
#define PG8_WAIT_V(n) asm volatile("s_waitcnt vmcnt(" #n ")" ::: "memory")
#define PG8_WAIT_L(n) asm volatile("s_waitcnt lgkmcnt(" #n ")" ::: "memory")
#define PG8_BAR __builtin_amdgcn_s_barrier()
#define PG8_SCHED __builtin_amdgcn_sched_barrier(0)
    Unit cur, nxt; int ui = 0;
    if (!S.next(0, cur)) return;
    f32x4 acc[2][2][4][2];
#pragma unroll
    for (int a = 0; a < 2; ++a)
#pragma unroll
        for (int b = 0; b < 2; ++b)
#pragma unroll
            for (int m = 0; m < 4; ++m)
#pragma unroll
                for (int n = 0; n < 2; ++n) acc[a][b][m][n] = (f32x4){0.f, 0.f, 0.f, 0.f};
    f16x8 At[4][2], B0[2][2], B1[2][2];
    const char* cA = (const char*)g.A + (size_t)cur.pm * tstepA; const char* cB = (const char*)g.Bt + (size_t)cur.pn * tstepB;
    S.a_ready(cur);
    if constexpr (SP2) {
        PG8_STAGE(PG8_SB(0, 0), cB, voffB); PG8_STAGE(PG8_SB(0, 1), cB + hstepB, voffB); PG8_STAGE(PG8_SA(0, 0), cA, voffA); PG8_STAGE(PG8_SA(0, 1), cA + hstepA, voffA);
        if (wr == 1) PG8_BAR;
        PG8_WAIT_V(2); PG8_BAR;
        PG8_STAGE(PG8_SB(1, 0), cB + kstep, voffB); PG8_STAGE(PG8_SA(1, 0), cA + kstep, voffA); PG8_STAGE(PG8_SB(1, 1), cB + hstepB + kstep, voffB);
        PG8_WAIT_V(6); PG8_BAR;
    } else {
        PG8_STAGE(PG8_SB(0, 0), cB, voffB); PG8_STAGE(PG8_SA(0, 0), cA, voffA); PG8_STAGE(PG8_SB(0, 1), cB + hstepB, voffB); PG8_STAGE(PG8_SA(0, 1), cA + hstepA, voffA);
        if (wr == 1) PG8_BAR;
        PG8_WAIT_V(4); PG8_BAR;
        PG8_STAGE(PG8_SB(1, 0), cB + kstep, voffB); PG8_STAGE(PG8_SA(1, 0), cA + kstep, voffA); PG8_STAGE(PG8_SB(1, 1), cB + hstepB + kstep, voffB);
        PG8_WAIT_V(6); PG8_BAR;
    }
    for (;;) {
        const bool has_next = S.next(ui + 1, nxt);
        const char* nA = has_next ? (const char*)g.A + (size_t)nxt.pm * tstepA : cA; const char* nB = has_next ? (const char*)g.Bt + (size_t)nxt.pn * tstepB : cB;
        for (int t = 0; t < nt; t += 2) {
            const bool last = (t == nt - 2);
            const char* a1 = cA + (size_t)(t + 1) * kstep;
            const char* a2 = last ? nA : cA + (size_t)(t + 2) * kstep; const char* b2 = last ? nB : cB + (size_t)(t + 2) * kstep;
            const char* a3 = a2 + kstep; const char* b3 = b2 + kstep;
            if (last && has_next) S.a_ready(nxt);
            if constexpr (SP2) {
            PG8_LDB(B0, 0, 0); PG8_LDB(B1, 0, 1); PG8_SCHED; PG8_LDA(At, 0, 0); PG8_STAGE(PG8_SA(1, 1), a1 + hstepA, voffA);
            PG8_WAIT_V(8); PG8_WAIT_L(0); PG8_BAR; PG8_MMA(0, 0, At, B0); PG8_MMA(0, 1, At, B1); PG8_BAR; PG8_SCHED;
            PG8_LDA(At, 0, 1); PG8_STAGE(PG8_SB(0, 0), b2, voffB); PG8_STAGE(PG8_SB(0, 1), b2 + hstepB, voffB); PG8_STAGE(PG8_SA(0, 0), a2, voffA);
            PG8_WAIT_V(8); PG8_WAIT_L(0); PG8_BAR; PG8_MMA(1, 0, At, B0); PG8_MMA(1, 1, At, B1); PG8_BAR; PG8_SCHED;
            PG8_LDB(B0, 1, 0); PG8_LDB(B1, 1, 1); PG8_SCHED; PG8_LDA(At, 1, 0); PG8_STAGE(PG8_SA(0, 1), a2 + hstepA, voffA);
            PG8_WAIT_V(8); PG8_WAIT_L(0); PG8_BAR; PG8_MMA(0, 0, At, B0); PG8_MMA(0, 1, At, B1); PG8_BAR; PG8_SCHED;
            PG8_LDA(At, 1, 1); PG8_STAGE(PG8_SB(1, 0), b3, voffB); PG8_STAGE(PG8_SB(1, 1), b3 + hstepB, voffB); PG8_STAGE(PG8_SA(1, 0), a3, voffA);
            PG8_WAIT_V(8); PG8_WAIT_L(0); PG8_BAR; PG8_MMA(1, 0, At, B0); PG8_MMA(1, 1, At, B1); PG8_BAR; PG8_SCHED;
            } else {
            PG8_LDB(B0, 0, 0); PG8_SCHED; PG8_LDA(At, 0, 0); PG8_STAGE(PG8_SA(1, 1), a1 + hstepA, voffA);
            PG8_WAIT_L(8); PG8_BAR; PG8_WAIT_L(0); PG8_MMA(0, 0, At, B0); PG8_BAR; PG8_SCHED;
            PG8_LDB(B1, 0, 1); PG8_STAGE(PG8_SB(0, 0), b2, voffB);
            PG8_BAR; PG8_WAIT_L(0); PG8_MMA(0, 1, At, B1); PG8_BAR;
            PG8_LDA(At, 0, 1); PG8_STAGE(PG8_SA(0, 0), a2, voffA);
            PG8_BAR; PG8_WAIT_L(0); PG8_MMA(1, 0, At, B0); PG8_BAR; PG8_SCHED;
            PG8_STAGE(PG8_SB(0, 1), b2 + hstepB, voffB);
            PG8_WAIT_V(6); PG8_BAR; PG8_MMA(1, 1, At, B1); PG8_BAR;
            PG8_LDB(B0, 1, 0); PG8_SCHED; PG8_LDA(At, 1, 0); PG8_STAGE(PG8_SA(0, 1), a2 + hstepA, voffA);
            PG8_WAIT_L(8); PG8_BAR; PG8_WAIT_L(0); PG8_MMA(0, 0, At, B0); PG8_BAR; PG8_SCHED;
            PG8_LDB(B1, 1, 1); PG8_STAGE(PG8_SB(1, 0), b3, voffB);
            PG8_BAR; PG8_WAIT_L(0); PG8_MMA(0, 1, At, B1); PG8_BAR;
            PG8_LDA(At, 1, 1); PG8_STAGE(PG8_SA(1, 0), a3, voffA);
            PG8_BAR; PG8_WAIT_L(0); PG8_MMA(1, 0, At, B0); PG8_BAR; PG8_SCHED;
            PG8_STAGE(PG8_SB(1, 1), b3 + hstepB, voffB);
            PG8_WAIT_V(6); PG8_BAR; PG8_MMA(1, 1, At, B1); PG8_BAR;
            }
        }
        if constexpr (ALIGN_EPI) { if (wr == 0) PG8_BAR; }
        if constexpr (!Epi::AFTER_DRAIN) { E(acc, cur, wr, wc, fr, fq); S.done(cur); }
        if (!has_next) break;
#pragma unroll
        for (int a = 0; a < 2; ++a)
#pragma unroll
            for (int b = 0; b < 2; ++b)
#pragma unroll
                for (int m = 0; m < 4; ++m)
#pragma unroll
                    for (int n = 0; n < 2; ++n) acc[a][b][m][n] = (f32x4){0.f, 0.f, 0.f, 0.f};
        cur = nxt; cA = nA; cB = nB; ++ui;
        if constexpr (ALIGN_EPI) { if (wr == 1) PG8_BAR; }
    }
    PG8_WAIT_V(0);
    if constexpr (!ALIGN_EPI) { if (wr == 0) PG8_BAR; }
    PG8_BAR;
    if constexpr (Epi::AFTER_DRAIN) { E.fused(acc, cur, wr, wc, fr, fq, lds, wid, lane); S.done(cur); }
#undef PG8_SA
#undef PG8_SB
#undef PG8_STAGE
#undef PG8_LDA
#undef PG8_LDB
#undef PG8_MMA
#undef PG8_WAIT_V
#undef PG8_WAIT_L
#undef PG8_BAR
#undef PG8_SCHED
}

template <class F> struct EpiRow8 {
    static constexpr bool PERM = true, AFTER_DRAIN = false;
    F f;
    __device__ __forceinline__ void operator()(const f32x4 (&acc)[2][2][4][2], const Unit& u, int wr, int wc, int fr, int fq) const {
        const int row0 = u.pm * BM + wr * 64 + fr, col0 = u.pn * BM + wc * 32 + 8 * fq;
#pragma unroll
        for (int ai = 0; ai < 2; ++ai)
#pragma unroll
            for (int m = 0; m < 4; ++m)
#pragma unroll
                for (int bj = 0; bj < 2; ++bj) f(row0 + ai * HALF + m * 16, col0 + bj * HALF, acc[ai][bj][m][0], acc[ai][bj][m][1]);
    }
};
}

#define LAS __attribute__((address_space(3)))
typedef _Float16 f16;
typedef float f32x4 __attribute__((ext_vector_type(4)));
typedef unsigned u32x4 __attribute__((ext_vector_type(4)));
typedef _Float16 h2v __attribute__((ext_vector_type(2)));

constexpr int D = 2048, NMETA = 16, SEQ = 2048, T = 2064, DFF = 8192;
constexpr int MMAIN = 8192;
constexpr int MREAL = 8208;
constexpr int MP = 8448;
constexpr int CIN = 4176, CINP = 4352;
constexpr int QOFF = 0, KOFF = 2048, VOFF = 2560, QIOFF = 3072, KIOFF = 4096, WIOFF = 4160;
constexpr int SROW = 2112;
constexpr float EPS = 1e-6f;
constexpr int NTHREADS = 512;
constexpr int LDS_BYTES = 147456;

struct Params { const float* in[20]; float* out; unsigned char* ws; };
enum { I_X = 0, I_META, I_NORMG, I_ABWIN, I_POOLW, I_POOLS, I_LRE, I_LIM, I_LOGDT, I_BRE, I_BIM, I_CRE, I_CIM, I_S5D, I_WGLU, I_ABWOUT, I_CWIN, I_CWOUT, I_W1, I_W2 };

constexpr int TP = 2112;
constexpr size_t SZ4 = (size_t)MP * D * 4, SZ2 = (size_t)MP * D * 2;
constexpr size_t OFF_H = 0, OFF_A16 = OFF_H + SZ4, OFF_U16 = OFF_A16 + SZ2, OFF_DY16 = OFF_U16 + SZ2, OFF_CAT16 = OFF_DY16 + SZ2, OFF_BIG = OFF_CAT16 + SZ2;
constexpr size_t SZ_BIG = (size_t)MP * DFF * 2;
constexpr size_t OFF_Q16 = OFF_BIG, OFF_K16 = OFF_Q16 + (size_t)MMAIN * D * 2, OFF_V16 = OFF_K16 + (size_t)4 * TP * 512 * 2, OFF_QI16 = OFF_V16 + (size_t)4 * TP * 512 * 2,
                 OFF_KI16 = OFF_QI16 + (size_t)MMAIN * 1024 * 2, OFF_WI = OFF_KI16 + (size_t)4 * TP * 64 * 2, OFF_ATT_END = OFF_WI + (size_t)MMAIN * 16 * 4;
static_assert(OFF_ATT_END <= OFF_BIG + SZ_BIG, "attention buffers fit the BIG region");
constexpr size_t OFF_MASK = OFF_BIG + SZ_BIG, SZ_MASK = (size_t)MMAIN * 33 * 8;
constexpr size_t OFF_ROPE16 = OFF_MASK + SZ_MASK, OFF_ROPE8 = OFF_ROPE16 + (size_t)T * 16 * 8;
constexpr size_t OFF_BAR = OFF_ROPE8 + (size_t)T * 8 * 8, SZ_BAR = 16384;
constexpr size_t OFF_W = OFF_BAR + SZ_BAR;
constexpr size_t OFF_SCORE = OFF_DY16, OFF_O16 = OFF_A16;
constexpr size_t W_IN = OFF_W, W_POOL = W_IN + (size_t)D * D * 2, W_GLU = W_POOL + (size_t)4 * 256 * 256 * 2, W_OUT = W_GLU + (size_t)1024 * 1024 * 2,
                 W_CIN = W_OUT + (size_t)D * D * 2, W_COUT = W_CIN + (size_t)CINP * D * 2, W_1 = W_COUT + (size_t)D * D * 2, W_2 = W_1 + (size_t)2 * D * DFF * 2,
                 WS_NEED = W_2 + (size_t)2 * D * DFF * 2;
static_assert((size_t)MMAIN * SROW * 4 <= 2 * SZ2, "SCORE fits DY16+CAT16");
static_assert(OFF_W % 256 == 0, "alignment");

__device__ __forceinline__ int row_of(int b, int t) { return t < NMETA ? MMAIN + t : b * SEQ + (t - NMETA); }
__device__ __forceinline__ float wave_sum(float v) {
#pragma unroll
    for (int o = 1; o < 64; o <<= 1) v += __shfl_xor(v, o);
    return v;
}
__device__ __forceinline__ float wave_max(float v) {
#pragma unroll
    for (int o = 1; o < 64; o <<= 1) v = fmaxf(v, __shfl_xor(v, o));
    return v;
}
__device__ __forceinline__ float4 ld4(const float* p) { return *(const float4*)p; }
__device__ __forceinline__ unsigned pk2h(float a, float b) { h2v r; r.x = (_Float16)a; r.y = (_Float16)b; return __builtin_bit_cast(unsigned, r); }
__device__ __forceinline__ float2 up2h(unsigned u) { const h2v r = __builtin_bit_cast(h2v, u); return make_float2((float)r.x, (float)r.y); }
__device__ __forceinline__ float4 ld4(const f16* p) { const uint2 r = *(const uint2*)p; const float2 a = up2h(r.x), b = up2h(r.y); return make_float4(a.x, a.y, b.x, b.y); }
__device__ __forceinline__ void st4h(f16* p, float4 v) { uint2 r; r.x = pk2h(v.x, v.y); r.y = pk2h(v.z, v.w); *(uint2*)p = r; }
__device__ __forceinline__ void st8h(f16* p, f32x4 a, f32x4 b) { u32x4 w; w.x = pk2h(a[0], a[1]); w.y = pk2h(a[2], a[3]); w.z = pk2h(b[0], b[1]); w.w = pk2h(b[2], b[3]); *(u32x4*)p = w; }

__device__ __forceinline__ void sincos_d(double x, double& sn, double& cs) {
    const double q = rint(x * 0.6366197723675814);
    double r = fma(-q, 1.5707963267948966, x); r = fma(-q, 6.123233995736766e-17, r);
    const double r2 = r * r;
    double sp = -1.0 / 6227020800.0; sp = fma(sp, r2, 1.0 / 39916800.0); sp = fma(sp, r2, -1.0 / 362880.0); sp = fma(sp, r2, 1.0 / 5040.0); sp = fma(sp, r2, -1.0 / 120.0); sp = fma(sp, r2, 1.0 / 6.0); sp = fma(sp, r2, -1.0); sp = -sp * r;
    double cp = 1.0 / 87178291200.0; cp = fma(cp, r2, -1.0 / 479001600.0); cp = fma(cp, r2, 1.0 / 3628800.0); cp = fma(cp, r2, -1.0 / 40320.0); cp = fma(cp, r2, 1.0 / 720.0); cp = fma(cp, r2, -1.0 / 24.0); cp = fma(cp, r2, 0.5); cp = fma(-cp, r2, 1.0);
    const int n = ((int)q) & 3;
    sn = (n == 0) ? sp : (n == 1) ? cp : (n == 2) ? -sp : -cp;
    cs = (n == 0) ? cp : (n == 1) ? -sp : (n == 2) ? -cp : sp;
}
__device__ __forceinline__ float rope_inv16(int idx) {
    const double r = 1.0 / sqrt(sqrt(sqrt(sqrt(500000.0))));
    double v = 1.0;
    for (int i = 0; i < idx; ++i) v *= r;
    return (float)v;
}

__device__ __forceinline__ void cvt_item(const float* W, int K, int N, int NPAD, f16* WT, float* scr, int item, int lane) {
    const int nblk = NPAD / 32, kb = item / nblk, nb = item % nblk, k0 = 64 * kb, n0 = 32 * nb;
    const int n = n0 + (lane & 31);
    float wv_[32];
#pragma unroll
    for (int i = 0; i < 32; ++i) { const int kk = 2 * i + (lane >> 5); wv_[i] = (n < N) ? W[(size_t)(k0 + kk) * N + n] : 0.f; }
#pragma unroll
    for (int i = 0; i < 32; ++i) { const int kk = 2 * i + (lane >> 5); scr[kk * 33 + (lane & 31)] = wv_[i]; }
    const int c = lane & 7;
#pragma unroll
    for (int j = 0; j < 4; ++j) { const int nn = (lane >> 3) + 8 * j; const float* s = scr + (8 * c) * 33 + nn;
        u32x4 o; o.x = pk2h(s[0 * 33], s[1 * 33]); o.y = pk2h(s[2 * 33], s[3 * 33]); o.z = pk2h(s[4 * 33], s[5 * 33]); o.w = pk2h(s[6 * 33], s[7 * 33]);
        *(u32x4*)(WT + (size_t)(n0 + nn) * K + k0 + 8 * c) = o; }
}
__device__ __forceinline__ void convert_weights(const Params& p, float* ldsf) {
    const int tid_ = otid(), lane = tid_ & 63, wv = tid_ >> 6, gw = obid() * (NTHREADS / 64) + wv, ngw = gridDim.x * (NTHREADS / 64);
    float* scr = ldsf + wv * (64 * 33);
    unsigned char* ws = p.ws;
    constexpr int I_IN = 32 * 64, I_PG = 4 * 8, I_GLU = 16 * 32, I_OUT = 32 * 64, I_CI = 32 * (CINP / 32), I_CO = 32 * 64, I_M1 = 32 * 256, I_M2 = 128 * 64;
    constexpr int NITEMS = I_IN + 4 * I_PG + I_GLU + I_OUT + I_CI + I_CO + 2 * I_M1 + 2 * I_M2;
    for (int it = gw; it < NITEMS; it += ngw) {
        int r = it;
        if (r < I_IN) { cvt_item(p.in[I_ABWIN], D, D, D, (f16*)(ws + W_IN), scr, r, lane); continue; } r -= I_IN;
        if (r < 4 * I_PG) { const int g = r / I_PG; cvt_item(p.in[I_POOLW] + (size_t)g * 65536, 256, 256, 256, (f16*)(ws + W_POOL) + (size_t)g * 65536, scr, r % I_PG, lane); continue; } r -= 4 * I_PG;
        if (r < I_GLU) { cvt_item(p.in[I_WGLU], 1024, 1024, 1024, (f16*)(ws + W_GLU), scr, r, lane); continue; } r -= I_GLU;
        if (r < I_OUT) { cvt_item(p.in[I_ABWOUT], D, D, D, (f16*)(ws + W_OUT), scr, r, lane); continue; } r -= I_OUT;
        if (r < I_CI) { cvt_item(p.in[I_CWIN], D, CIN, CINP, (f16*)(ws + W_CIN), scr, r, lane); continue; } r -= I_CI;
        if (r < I_CO) { cvt_item(p.in[I_CWOUT], D, D, D, (f16*)(ws + W_COUT), scr, r, lane); continue; } r -= I_CO;
        if (r < 2 * I_M1) { const int l = r / I_M1; cvt_item(p.in[I_W1] + (size_t)l * D * DFF, D, DFF, DFF, (f16*)(ws + W_1) + (size_t)l * D * DFF, scr, r % I_M1, lane); continue; } r -= 2 * I_M1;
        { const int l = r / I_M2; cvt_item(p.in[I_W2] + (size_t)l * D * DFF, DFF, D, D, (f16*)(ws + W_2) + (size_t)l * D * DFF, scr, r % I_M2, lane); }
    }
}

__device__ __forceinline__ void init_rows(const Params& p, float* H, f16* A) {
    const int tid_ = otid(), lane = tid_ & 63, gw = obid() * (NTHREADS / 64) + (tid_ >> 6), ngw = gridDim.x * (NTHREADS / 64);
    const float* g = p.in[I_NORMG];
    for (int row = gw; row < MP; row += ngw) {
        float4 h[8]; float ss = 0.f;
#pragma unroll
        for (int j = 0; j < 8; ++j) {
            const int c = 4 * lane + 256 * j;
            if (row < MMAIN) h[j] = ld4(p.in[I_X] + (size_t)row * D + c);
            else if (row < MREAL) h[j] = ld4(p.in[I_META] + (size_t)(row - MMAIN) * D + c);
            else h[j] = make_float4(0.f, 0.f, 0.f, 0.f);
            ss += h[j].x * h[j].x + h[j].y * h[j].y + h[j].z * h[j].z + h[j].w * h[j].w;
        }
        const float r = rsqrtf(wave_sum(ss) * (1.f / D) + EPS);
#pragma unroll
        for (int j = 0; j < 8; ++j) {
            const int c = 4 * lane + 256 * j; const float4 gg = ld4(g + c);
            *(float4*)(H + (size_t)row * D + c) = h[j];
            st4h(A + (size_t)row * D + c, make_float4(h[j].x * r * gg.x, h[j].y * r * gg.y, h[j].z * r * gg.z, h[j].w * r * gg.w));
        }
    }
}
__device__ __forceinline__ void rowpass(const f16* MIX, const float* ga, const float* gb, float* H, f16* A, float* OUT, int nrows) {
    const int tid_ = otid(), lane = tid_ & 63, gw = obid() * (NTHREADS / 64) + (tid_ >> 6), ngw = gridDim.x * (NTHREADS / 64);
    for (int row = gw; row < nrows; row += ngw) {
        float4 m[8], h[8]; float ss = 0.f;
#pragma unroll
        for (int j = 0; j < 8; ++j) {
            const int c = 4 * lane + 256 * j;
            m[j] = ld4(MIX + (size_t)row * D + c); h[j] = ld4(H + (size_t)row * D + c);
            ss += m[j].x * m[j].x + m[j].y * m[j].y + m[j].z * m[j].z + m[j].w * m[j].w;
        }
        const float r = rsqrtf(wave_sum(ss) * (1.f / D) + EPS);
        float s2 = 0.f;
#pragma unroll
        for (int j = 0; j < 8; ++j) {
            const int c = 4 * lane + 256 * j; const float4 gg = ld4(ga + c);
            h[j].x += m[j].x * r * gg.x; h[j].y += m[j].y * r * gg.y; h[j].z += m[j].z * r * gg.z; h[j].w += m[j].w * r * gg.w;
            s2 += h[j].x * h[j].x + h[j].y * h[j].y + h[j].z * h[j].z + h[j].w * h[j].w;
        }
        if (OUT) {
#pragma unroll
            for (int j = 0; j < 8; ++j) *(float4*)(OUT + (size_t)row * D + 4 * lane + 256 * j) = h[j];
        } else {
            const float r2 = rsqrtf(wave_sum(s2) * (1.f / D) + EPS);
#pragma unroll
            for (int j = 0; j < 8; ++j) {
                const int c = 4 * lane + 256 * j; const float4 gg = ld4(gb + c);
                *(float4*)(H + (size_t)row * D + c) = h[j];
                st4h(A + (size_t)row * D + c, make_float4(h[j].x * r2 * gg.x, h[j].y * r2 * gg.y, h[j].z * r2 * gg.z, h[j].w * r2 * gg.w));
            }
        }
    }
}

template <int WIN>
__device__ __forceinline__ void pool_item(const f16* U, f16* DY, int b, int t0, int c) {
    constexpr int NR = 8 + WIN - 1;
    u32x4 raw[NR];
#pragma unroll
    for (int i = 0; i < NR; ++i) { const int t = t0 - (WIN - 1) + i; const u32x4 z = {0u, 0u, 0u, 0u}; raw[i] = (t >= 0) ? *(const u32x4*)(U + (size_t)row_of(b, t) * D + c) : z; }
    float v[NR][8];
#pragma unroll
    for (int i = 0; i < NR; ++i) { const float2 a0 = up2h(raw[i][0]), a1 = up2h(raw[i][1]), a2 = up2h(raw[i][2]), a3 = up2h(raw[i][3]);
        v[i][0] = a0.x; v[i][1] = a0.y; v[i][2] = a1.x; v[i][3] = a1.y; v[i][4] = a2.x; v[i][5] = a2.y; v[i][6] = a3.x; v[i][7] = a3.y; }
#pragma unroll
    for (int r = 0; r < 8; ++r) {
        const int t = t0 + r; if (t < NMETA && b != 0) continue;
        float sacc[8];
#pragma unroll
        for (int e = 0; e < 8; ++e) sacc[e] = 0.f;
#pragma unroll
        for (int j = 0; j < WIN; ++j)
#pragma unroll
            for (int e = 0; e < 8; ++e) sacc[e] += v[r + WIN - 1 - j][e];
        const float ic = 1.f / (float)((t + 1) < WIN ? (t + 1) : WIN);
        f32x4 o0, o1;
#pragma unroll
        for (int e = 0; e < 4; ++e) { o0[e] = sacc[e] * ic - v[r + WIN - 1][e]; o1[e] = sacc[4 + e] * ic - v[r + WIN - 1][4 + e]; }
        st8h(DY + (size_t)row_of(b, t) * D + c, o0, o1);
    }
}
__device__ __forceinline__ void pool_diff(const f16* U, f16* DY) {
    const int total = 4 * 258 * 128, stride = (int)gridDim.x * NTHREADS;
    for (int i = obid() * NTHREADS + otid(); i < total; i += stride) {
        const int cg = i & 127, tb = (i >> 7) % 258, b = (i >> 7) / 258, c = cg * 8, t0 = tb * 8;
        switch (c >> 8) { case 0: pool_item<2>(U, DY, b, t0, c); break; case 1: pool_item<4>(U, DY, b, t0, c); break; case 2: pool_item<8>(U, DY, b, t0, c); break; default: pool_item<16>(U, DY, b, t0, c); break; }
    }
}

__device__ __forceinline__ float gelu_tanh(float x) {
    const float k0 = 0.7978845608028654f, k1 = 0.044715f;
    const float u = k0 * (x + k1 * x * x * x);
    return x * __builtin_amdgcn_rcpf(1.f + __expf(-2.f * u));
}

typedef _Float16 f16x8 __attribute__((ext_vector_type(8)));
constexpr int SSM_WAVE_LDS = 128 * 20 * 4 + 16 * 136 * 2;
constexpr int SSM_CARRY_OFF = 8 * SSM_WAVE_LDS;
__device__ __forceinline__ void ssm_phase(const Params& p, const f16* U, f16* DY, LAS unsigned char* lds) {
    const int tid_ = otid(), lane = tid_ & 63, wv = __builtin_amdgcn_readfirstlane(tid_ >> 6), l15 = lane & 15, g2 = lane >> 4;
    LAS float* BUT = (LAS float*)(lds + wv * SSM_WAVE_LDS);
    LAS f16* HT = (LAS f16*)(lds + wv * SSM_WAVE_LDS + 128 * 20 * 4);
    typedef float f32x2_t __attribute__((ext_vector_type(2)));
    LAS f32x2_t* CARRY = (LAS f32x2_t*)(lds + SSM_CARRY_OFF);
    for (int item = obid(); item < 256; item += gridDim.x) {
        const int b = item >> 6, g = item & 63, n = lane;
        const float dt = expf(p.in[I_LOGDT][g]);
        const float ar = p.in[I_LRE][g * 64 + n], ai = p.in[I_LIM][g * 64 + n];
        float are, aim, pw0r, pw0i, pw1r, pw1i;
        { const float mag = expf(dt * ar); double sd, cd; sincos_d((double)(dt * ai), sd, cd); are = mag * (float)cd; aim = mag * (float)sd; }
        { const float mag = expf(272.f * dt * ar); double sd, cd; sincos_d(272.0 * (double)(dt * ai), sd, cd); pw0r = mag * (float)cd; pw0i = mag * (float)sd; }
        { const float mag = expf(256.f * dt * ar); double sd, cd; sincos_d(256.0 * (double)(dt * ai), sd, cd); pw1r = mag * (float)cd; pw1i = mag * (float)sd; }
        {
            const float den = ar * ar + ai * ai, zr = are - 1.f, zi = aim;
            const float fre = (zr * ar + zi * ai) / (den * dt), fim = (zi * ar - zr * ai) / (den * dt);
            LAS f16* TB = (LAS f16*)BUT;
#pragma unroll
            for (int c = 0; c < 16; ++c) {
                const float br = p.in[I_BRE][(g * 64 + n) * 16 + c], bi = p.in[I_BIM][(g * 64 + n) * 16 + c];
                TB[n * 16 + c] = (f16)(fre * br - fim * bi); TB[(64 + n) * 16 + c] = (f16)(fre * bi + fim * br);
            }
        }
        asm volatile("" ::: "memory");
        f16x8 bbf[8];
#pragma unroll
        for (int nt = 0; nt < 8; ++nt) {
            const f16x8 z = {0, 0, 0, 0, 0, 0, 0, 0};
            bbf[nt] = (g2 < 2) ? *(const LAS f16x8*)((const LAS f16*)BUT + (16 * nt + l15) * 16 + 8 * g2) : z;
        }
        asm volatile("" ::: "memory");
        f16x8 cf[4];
#pragma unroll
        for (int ks = 0; ks < 4; ++ks) {
            const int k = 32 * ks + 8 * g2;
            const float* src = (k < 64) ? (p.in[I_CRE] + (g * 16 + l15) * 64 + k) : (p.in[I_CIM] + (g * 16 + l15) * 64 + (k - 64));
            const float sg = (k < 64) ? 1.f : -1.f;
            const float4 x0 = ld4(src), x1 = ld4(src + 4);
            f16x8 v; v[0] = (f16)(sg * x0.x); v[1] = (f16)(sg * x0.y); v[2] = (f16)(sg * x0.z); v[3] = (f16)(sg * x0.w); v[4] = (f16)(sg * x1.x); v[5] = (f16)(sg * x1.y); v[6] = (f16)(sg * x1.z); v[7] = (f16)(sg * x1.w);
            cf[ks] = v;
        }
        float dd[4];
#pragma unroll
        for (int j = 0; j < 4; ++j) dd[j] = p.in[I_S5D][g * 16 + 4 * g2 + j];
        const int blk0 = (wv == 0) ? 0 : 17 + 16 * (wv - 1), nblk = (wv == 0) ? 17 : 16;
        float hr = 0.f, hi = 0.f;
#pragma unroll 1
        for (int pass = 0; pass < 2; ++pass) {
            if (pass == 1) {
                CARRY[wv * 64 + n] = (f32x2_t){hr, hi};
                __syncthreads();
                float cr = 0.f, ci = 0.f;
                for (int j = 0; j < wv; ++j) {
                    const f32x2_t e = CARRY[j * 64 + n]; const float pr = (j == 0) ? pw0r : pw1r, pi = (j == 0) ? pw0i : pw1i;
                    const float nr = pr * cr - pi * ci + e.x, ni = pr * ci + pi * cr + e.y; cr = nr; ci = ni;
                }
                hr = cr; hi = ci;
                __syncthreads();
            }
            f16x8 ua_n = {0, 0, 0, 0, 0, 0, 0, 0}; uint2 uu_n = {0u, 0u};
            { const int r0 = row_of(b, blk0 * 16 + l15); if (g2 < 2) ua_n = *(const f16x8*)(U + (size_t)r0 * D + 1024 + g * 16 + 8 * g2); uu_n = *(const uint2*)(U + (size_t)r0 * D + 1024 + g * 16 + 4 * g2); }
#pragma unroll 1
            for (int kb = 0; kb < nblk; ++kb) {
                const int t0 = (blk0 + kb) * 16;
                const int rowa = row_of(b, t0 + l15);
                const f16x8 ua = ua_n; const uint2 uu_c = uu_n;
                { const int tn = (kb + 1 < nblk) ? t0 + 16 : t0; const int rn = row_of(b, tn + l15);
                  if (g2 < 2) ua_n = *(const f16x8*)(U + (size_t)rn * D + 1024 + g * 16 + 8 * g2); uu_n = *(const uint2*)(U + (size_t)rn * D + 1024 + g * 16 + 4 * g2); }
                f32x4 bacc[8];
#pragma unroll
                for (int nt = 0; nt < 8; ++nt) bacc[nt] = __builtin_amdgcn_mfma_f32_16x16x32_f16(ua, bbf[nt], (f32x4){0.f, 0.f, 0.f, 0.f}, 0, 0, 0);
                __builtin_amdgcn_sched_barrier(0);
                asm volatile("s_nop 15\n\ts_nop 15" ::: "memory");
                __builtin_amdgcn_sched_barrier(0);
#pragma unroll
                for (int nt = 0; nt < 8; ++nt) *(LAS f32x4*)(BUT + (16 * nt + l15) * 20 + 4 * g2) = bacc[nt];
                asm volatile("" ::: "memory");
                float bre[16], bim[16];
#pragma unroll
                for (int q4 = 0; q4 < 4; ++q4) {
                    const f32x4 x = *(const LAS f32x4*)(BUT + n * 20 + 4 * q4), y = *(const LAS f32x4*)(BUT + (64 + n) * 20 + 4 * q4);
                    bre[4 * q4] = x[0]; bre[4 * q4 + 1] = x[1]; bre[4 * q4 + 2] = x[2]; bre[4 * q4 + 3] = x[3];
                    bim[4 * q4] = y[0]; bim[4 * q4 + 1] = y[1]; bim[4 * q4 + 2] = y[2]; bim[4 * q4 + 3] = y[3];
                }
#pragma unroll
                for (int tt = 0; tt < 16; ++tt) {
                    const float nr = fmaf(are, hr, fmaf(-aim, hi, bre[tt])), ni = fmaf(are, hi, fmaf(aim, hr, bim[tt]));
                    hr = nr; hi = ni;
                    if (pass == 1) { HT[tt * 136 + n] = (f16)hr; HT[tt * 136 + 64 + n] = (f16)hi; }
                }
                asm volatile("" ::: "memory");
                if (pass == 1) {
                    f32x4 ya = {0.f, 0.f, 0.f, 0.f};
#pragma unroll
                    for (int ks = 0; ks < 4; ++ks) {
                        const f16x8 hb = *(const LAS f16x8*)(HT + l15 * 136 + 32 * ks + 8 * g2);
                        ya = __builtin_amdgcn_mfma_f32_16x16x32_f16(cf[ks], hb, ya, 0, 0, 0);
                    }
                    __builtin_amdgcn_sched_barrier(0);
                    asm volatile("s_nop 15\n\ts_nop 15" ::: "memory");
                    __builtin_amdgcn_sched_barrier(0);
                    if (t0 >= NMETA || b == 0) {
                        const float2 uua = up2h(uu_c.x), uub = up2h(uu_c.y); const float4 uu = make_float4(uua.x, uua.y, uub.x, uub.y);
                        const float4 o = make_float4(gelu_tanh(dt * ya[0] + dd[0] * uu.x), gelu_tanh(dt * ya[1] + dd[1] * uu.y), gelu_tanh(dt * ya[2] + dd[2] * uu.z), gelu_tanh(dt * ya[3] + dd[3] * uu.w));
                        st4h(DY + (size_t)rowa * D + 1024 + g * 16 + 4 * g2, o);
                    }
                }
            }
        }
        __syncthreads();
    }
}

__device__ __forceinline__ void ssm_naive(const Params& p, const f16* U, f16* DY) {
    const int tid_ = otid(), lane = tid_ & 63, gw = obid() * (NTHREADS / 64) + (tid_ >> 6), ngw = gridDim.x * (NTHREADS / 64);
    for (int item = gw; item < 256; item += ngw) {
        const int b = item >> 6, g = item & 63, n = lane;
        const float dt = expf(p.in[I_LOGDT][g]);
        const float ar = p.in[I_LRE][g * 64 + n], ai = p.in[I_LIM][g * 64 + n];
        const float mag = expf(dt * ar); double sd, cd; sincos_d((double)(dt * ai), sd, cd); const float sn = (float)sd, cs = (float)cd;
        const float are = mag * cs, aim = mag * sn;
        const float den = ar * ar + ai * ai, zr = are - 1.f, zi = aim;
        const float fre = (zr * ar + zi * ai) / den, fim = (zi * ar - zr * ai) / den;
        float bbr[16], bbi[16], cr[16], ci[16];
#pragma unroll
        for (int c = 0; c < 16; ++c) {
            const float br = p.in[I_BRE][(g * 64 + n) * 16 + c], bi = p.in[I_BIM][(g * 64 + n) * 16 + c];
            bbr[c] = fre * br - fim * bi; bbi[c] = fre * bi + fim * br;
            cr[c] = p.in[I_CRE][(g * 16 + c) * 64 + n]; ci[c] = p.in[I_CIM][(g * 16 + c) * 64 + n];
        }
        const float dd = p.in[I_S5D][g * 16 + (lane & 15)];
        float hr = 0.f, hi = 0.f;
#pragma unroll 1
        for (int t = 0; t < T; ++t) {
            const int row = row_of(b, t);
            const f16* ur = U + (size_t)row * D + 1024 + g * 16;
            const float4 u0 = ld4(ur), u1 = ld4(ur + 4), u2 = ld4(ur + 8), u3 = ld4(ur + 12);
            const float uu[16] = {u0.x, u0.y, u0.z, u0.w, u1.x, u1.y, u1.z, u1.w, u2.x, u2.y, u2.z, u2.w, u3.x, u3.y, u3.z, u3.w};
            float bur = 0.f, bui = 0.f;
#pragma unroll
            for (int c = 0; c < 16; ++c) { bur = fmaf(bbr[c], uu[c], bur); bui = fmaf(bbi[c], uu[c], bui); }
            const float nhr = are * hr - aim * hi + bur, nhi = are * hi + aim * hr + bui;
            hr = nhr; hi = nhi;
            float myy = 0.f;
#pragma unroll
            for (int c = 0; c < 16; ++c) { const float v = wave_sum(cr[c] * hr - ci[c] * hi); if (lane == c) myy = v; }
            if (lane < 16 && (t >= NMETA || b == 0)) {
                const float y = myy + dd * (float)ur[lane];
                DY[(size_t)row * D + 1024 + g * 16 + lane] = (f16)gelu_tanh(y);
            }
        }
    }
}

__device__ __forceinline__ void build_rope(float2* R16, float2* R8) {
    const int total = T * 16, stride = (int)gridDim.x * NTHREADS;
    for (int i = obid() * NTHREADS + otid(); i < total; i += stride) {
        const int t = i >> 4, idx = i & 15;
        const float ang = (float)t * rope_inv16(idx);
        double sd, cd; sincos_d((double)ang, sd, cd);
        const float2 v = make_float2((float)cd, (float)sd);
        R16[i] = v; if ((idx & 1) == 0) R8[t * 8 + (idx >> 1)] = v;
    }
}
__device__ __forceinline__ void zero_kv_pads(f16* K16, f16* V16, f16* KI16) {
    const int per_b = (TP - T) * (512 + 512 + 64) / 8, total = 4 * per_b, stride = (int)gridDim.x * NTHREADS;
    for (int i = obid() * NTHREADS + otid(); i < total; i += stride) {
        const int b = i / per_b, r = i % per_b; const u32x4 z = {0u, 0u, 0u, 0u};
        if (r < (TP - T) * 64) *(u32x4*)(K16 + ((size_t)b * TP + T) * 512 + (size_t)r * 8) = z;
        else if (r < (TP - T) * 128) *(u32x4*)(V16 + ((size_t)b * TP + T) * 512 + (size_t)(r - (TP - T) * 64) * 8) = z;
        else *(u32x4*)(KI16 + ((size_t)b * TP + T) * 64 + (size_t)(r - (TP - T) * 128) * 8) = z;
    }
}
struct CinOut { f16* Q16; f16* K16; f16* V16; f16* QI16; f16* KI16; float* WI; const float2* R16; const float2* R8; };
__device__ __forceinline__ void rope_lanes(f32x4& v0, f32x4& v1, const float2* tab, int xr, bool active, bool second) {
    const float4 t0 = *(const float4*)(tab), t1 = *(const float4*)(tab + 2), t2 = *(const float4*)(tab + 4), t3 = *(const float4*)(tab + 6);
    const float cs[8] = {t0.x, t0.z, t1.x, t1.z, t2.x, t2.z, t3.x, t3.z}, sn[8] = {t0.y, t0.w, t1.y, t1.w, t2.y, t2.w, t3.y, t3.w};
    const float sg = second ? 1.f : -1.f;
#pragma unroll
    for (int e = 0; e < 4; ++e) {
        const float o0 = __shfl_xor(v0[e], xr), o1 = __shfl_xor(v1[e], xr);
        if (active) { v0[e] = v0[e] * cs[e] + sg * o0 * sn[e]; v1[e] = v1[e] * cs[4 + e] + sg * o1 * sn[4 + e]; }
    }
}
__device__ __forceinline__ void cin_epilogue(const CinOut& o, int r, int c, f32x4 v0, f32x4 v1) {
    const int fq = (threadIdx.x & 63) >> 4, cb = c & ~31;
    const bool valid = r < MREAL, mainrow = r < MMAIN;
    const int t = mainrow ? (r & 2047) + NMETA : (valid ? r - MMAIN : 0), b = r >> 11;
    if (cb < 2560) {
        if ((cb & 127) == 0) rope_lanes(v0, v1, o.R16 + t * 16 + 8 * (fq & 1), 32, true, fq >= 2);
        if (cb < 2048) { if (mainrow) st8h(o.Q16 + (size_t)r * D + c, v0, v1); }
        else if (mainrow) st8h(o.K16 + ((size_t)b * TP + t) * 512 + (c - 2048), v0, v1);
        else if (valid) { for (int bb = 0; bb < 4; ++bb) st8h(o.K16 + ((size_t)bb * TP + t) * 512 + (c - 2048), v0, v1); }
    } else if (cb < 3072) {
        if (mainrow) st8h(o.V16 + ((size_t)b * TP + t) * 512 + (c - 2560), v0, v1);
        else if (valid) { for (int bb = 0; bb < 4; ++bb) st8h(o.V16 + ((size_t)bb * TP + t) * 512 + (c - 2560), v0, v1); }
    } else if (cb < 4096) {
        if ((cb & 63) == 0) rope_lanes(v0, v1, o.R8 + t * 8, 16, fq < 2, fq == 1);
        if (mainrow) st8h(o.QI16 + (size_t)r * 1024 + (c - 3072), v0, v1);
    } else if (cb < 4160) {
        if (cb == 4096) rope_lanes(v0, v1, o.R8 + t * 8, 16, fq < 2, fq == 1);
        if (mainrow) st8h(o.KI16 + ((size_t)b * TP + t) * 64 + (c - 4096), v0, v1);
        else if (valid) { for (int bb = 0; bb < 4; ++bb) st8h(o.KI16 + ((size_t)bb * TP + t) * 64 + (c - 4096), v0, v1); }
    } else if (c < CIN) {
        if (mainrow) { float* w = o.WI + (size_t)r * 16 + (c - 4160); *(f32x4*)w = v0 * 0.03125f; *(f32x4*)(w + 4) = v1 * 0.03125f; }
    }
}

__device__ __forceinline__ void idx_scores(const f16* QI16, const f16* KI16, const float* WI, float* SCORE) {
    const int tid_ = otid(), lane = tid_ & 63, gw = obid() * (NTHREADS / 64) + (tid_ >> 6), ngw = gridDim.x * (NTHREADS / 64);
    for (int q = gw; q < MMAIN; q += ngw) {
        const int b = q >> 11, s = q & 2047, nall = 80 + 64 * (s >> 6);
        const f16* qi = QI16 + (size_t)q * 1024;
        const float* wi = WI + (size_t)q * 16;
        for (int t = lane; t < nall; t += 64) {
            const f16* kp = KI16 + ((size_t)b * TP + t) * 64;
            float4 kv[16];
#pragma unroll
            for (int j = 0; j < 16; ++j) kv[j] = ld4(kp + 4 * j);
            float score = 0.f;
#pragma unroll 1
            for (int h = 0; h < 16; ++h) {
                float dot = 0.f;
#pragma unroll
                for (int j = 0; j < 16; ++j) { const float4 qv = ld4(qi + h * 64 + 4 * j); dot += qv.x * kv[j].x + qv.y * kv[j].y + qv.z * kv[j].z + qv.w * kv[j].w; }
                score += wi[h] * fmaxf(dot, 0.f);
            }
            SCORE[(size_t)q * SROW + t] = score;
        }
    }
}

__device__ __forceinline__ unsigned okey(float f) { const unsigned u = __float_as_uint(f); return (u & 0x80000000u) ? ~u : (u | 0x80000000u); }
__device__ __forceinline__ void select_topk(const float* SCORE, unsigned long long* MASK) {
    const int tid_ = otid(), lane = tid_ & 63, gw = obid() * (NTHREADS / 64) + (tid_ >> 6), ngw = gridDim.x * (NTHREADS / 64);
    for (int q = gw; q < MMAIN; q += ngw) {
        const int s = q & 2047, nall = 80 + 64 * (s >> 6);
        unsigned key[33];
#pragma unroll
        for (int i = 0; i < 33; ++i) { const int t = 64 * i + lane; key[i] = (t < nall) ? okey(SCORE[(size_t)q * SROW + t]) : 0u; }
        unsigned long long mymask = 0ull;
        if (nall <= 256) {
#pragma unroll
            for (int i = 0; i < 33; ++i) { const unsigned long long m = __ballot(64 * i + lane < nall); if (lane == i) mymask = m; }
        } else {
            unsigned tau = 0u;
#pragma unroll 1
            for (int bit = 31; bit >= 0; --bit) {
                const unsigned cand = tau | (1u << bit); int cnt = 0;
#pragma unroll
                for (int i = 0; i < 33; ++i) cnt += __popcll(__ballot(key[i] >= cand));
                if (cnt >= 256) tau = cand;
            }
            int ngt = 0;
#pragma unroll
            for (int i = 0; i < 33; ++i) ngt += __popcll(__ballot(key[i] > tau));
            const int need = 256 - ngt; int eqb = 0;
            const unsigned long long lt = (1ull << lane) - 1ull;
#pragma unroll
            for (int i = 0; i < 33; ++i) {
                const unsigned long long gm = __ballot(key[i] > tau), em = __ballot(key[i] == tau);
                const int rank = eqb + __popcll(em & lt);
                const unsigned long long sm = __ballot(key[i] == tau && rank < need);
                if (lane == i) mymask = gm | sm;
                eqb += __popcll(em);
            }
        }
        if (lane < 33) MASK[(size_t)q * 33 + lane] = mymask;
    }
}

__device__ __forceinline__ float xsum16_32(float x) {
    { auto rr = __builtin_amdgcn_permlane16_swap(__float_as_uint(x), __float_as_uint(x), false, false); x = __uint_as_float(rr[0]) + __uint_as_float(rr[1]); }
    { auto rr = __builtin_amdgcn_permlane32_swap(__float_as_uint(x), __float_as_uint(x), false, false); x = __uint_as_float(rr[0]) + __uint_as_float(rr[1]); }
    return x;
}
__device__ __forceinline__ int wave_isum(int x) {
    x += __builtin_amdgcn_update_dpp(0, x, 0xB1, 0xF, 0xF, true);
    x += __builtin_amdgcn_update_dpp(0, x, 0x4E, 0xF, 0xF, true);
    x += __builtin_amdgcn_update_dpp(0, x, 0x141, 0xF, 0xF, true);
    x += __builtin_amdgcn_update_dpp(0, x, 0x140, 0xF, 0xF, true);
    { auto rr = __builtin_amdgcn_permlane16_swap((unsigned)x, (unsigned)x, false, false); x = (int)(rr[0] + rr[1]); }
    { auto rr = __builtin_amdgcn_permlane32_swap((unsigned)x, (unsigned)x, false, false); x = (int)(rr[0] + rr[1]); }
    return x;
}
constexpr int IDX_WAVE_LDS = 2 * TP * 4;
__device__ __forceinline__ unsigned long long select_row(const LAS float* srow, int nall, int lane) {
    unsigned key[33];
#pragma unroll
    for (int i = 0; i < 33; ++i) { const int t = 64 * i + lane; key[i] = (t < nall) ? okey(srow[t]) : 0u; }
    unsigned long long mymask = 0ull;
    unsigned tau = 0u;
#pragma unroll 1
    for (int bit = 31; bit >= 0; --bit) {
        const unsigned cand = tau | (1u << bit); int cl = 0;
#pragma unroll
        for (int i = 0; i < 33; ++i) cl += (key[i] >= cand) ? 1 : 0;
        const int cnt = __builtin_amdgcn_readfirstlane(wave_isum(cl));
        if (cnt >= 256) tau = cand;
        if (cnt == 256) break;
    }
    int ngt = 0;
#pragma unroll
    for (int i = 0; i < 33; ++i) ngt += __popcll(__ballot(key[i] > tau));
    const int need = 256 - ngt; int eqb = 0;
    const unsigned long long lt = (1ull << lane) - 1ull;
#pragma unroll
    for (int i = 0; i < 33; ++i) {
        const unsigned long long gm = __ballot(key[i] > tau), em = __ballot(key[i] == tau);
        const int rank = eqb + __popcll(em & lt);
        const unsigned long long sm = __ballot(key[i] == tau && rank < need);
        if (lane == i) mymask = gm | sm;
        eqb += __popcll(em);
    }
    return mymask;
}
__device__ __forceinline__ void index_select(const f16* QI16, const f16* KI16, const float* WI, unsigned long long* MASK, LAS unsigned char* lds) {
    const int tid_ = otid(), lane = tid_ & 63, wv = __builtin_amdgcn_readfirstlane(tid_ >> 6), l15 = lane & 15, g2 = lane >> 4;
    const int gw = obid() * (NTHREADS / 64) + wv;
    LAS float* SL = (LAS float*)(lds + wv * IDX_WAVE_LDS);
    if (gw >= 2048) return;
    const int b = gw >> 9, wq = gw & 511;
#pragma unroll 1
    for (int it = 0; it < 2; ++it) {
        const int u = (it == 0) ? wq : 1023 - wq, s0 = 2 * u, q0 = b * SEQ + s0, nall = 80 + 64 * (s0 >> 6);
        if (nall <= 256) {
            if (lane < 33) { const int lo = 64 * lane; const unsigned long long m = (nall >= lo + 64) ? ~0ull : (nall > lo ? ((1ull << (nall - lo)) - 1ull) : 0ull);
                MASK[(size_t)q0 * 33 + lane] = m; MASK[(size_t)(q0 + 1) * 33 + lane] = m; }
            continue;
        }
        f16x8 a[2][2]; float w[2][4];
#pragma unroll
        for (int qq = 0; qq < 2; ++qq) {
#pragma unroll
            for (int ks = 0; ks < 2; ++ks) a[qq][ks] = *(const f16x8*)(QI16 + (size_t)(q0 + qq) * 1024 + l15 * 64 + 32 * ks + 8 * g2);
            const float4 ww = ld4(WI + (size_t)(q0 + qq) * 16 + 4 * g2); w[qq][0] = ww.x; w[qq][1] = ww.y; w[qq][2] = ww.z; w[qq][3] = ww.w;
        }
        const int nkb = nall >> 4;
        const f16* kbase = KI16 + (size_t)b * TP * 64 + l15 * 64 + 8 * g2;
        f16x8 bf[2][2];
#pragma unroll
        for (int e = 0; e < 2; ++e)
#pragma unroll
            for (int ks = 0; ks < 2; ++ks) bf[e][ks] = *(const f16x8*)(kbase + (size_t)e * 16 * 64 + 32 * ks);
#pragma unroll 1
        for (int kb = 0; kb < nkb; kb += 2) {
            f16x8 nb[2][2];
#pragma unroll
            for (int e = 0; e < 2; ++e)
#pragma unroll
                for (int ks = 0; ks < 2; ++ks) nb[e][ks] = *(const f16x8*)(kbase + (size_t)(kb + 2 + e) * 16 * 64 + 32 * ks);
            f32x4 acc[2][2];
#pragma unroll
            for (int e = 0; e < 2; ++e)
#pragma unroll
                for (int qq = 0; qq < 2; ++qq) {
                    acc[e][qq] = __builtin_amdgcn_mfma_f32_16x16x32_f16(a[qq][0], bf[e][0], (f32x4){0.f, 0.f, 0.f, 0.f}, 0, 0, 0);
                    acc[e][qq] = __builtin_amdgcn_mfma_f32_16x16x32_f16(a[qq][1], bf[e][1], acc[e][qq], 0, 0, 0);
                }
            __builtin_amdgcn_sched_barrier(0);
            asm volatile("s_nop 15\n\ts_nop 15" ::: "memory");
            __builtin_amdgcn_sched_barrier(0);
#pragma unroll
            for (int e = 0; e < 2; ++e)
#pragma unroll
                for (int qq = 0; qq < 2; ++qq) {
                    const f32x4 c = acc[e][qq];
                    float sc = w[qq][0] * fmaxf(c[0], 0.f) + w[qq][1] * fmaxf(c[1], 0.f) + w[qq][2] * fmaxf(c[2], 0.f) + w[qq][3] * fmaxf(c[3], 0.f);
                    sc = xsum16_32(sc);
                    if (g2 == 0) SL[qq * TP + (kb + e) * 16 + l15] = sc;
                }
#pragma unroll
            for (int e = 0; e < 2; ++e)
#pragma unroll
                for (int ks = 0; ks < 2; ++ks) bf[e][ks] = nb[e][ks];
        }
        asm volatile("" ::: "memory");
#pragma unroll 1
        for (int qq = 0; qq < 2; ++qq) {
            const unsigned long long m = select_row(SL + qq * TP, nall, lane);
            if (lane < 33) MASK[(size_t)(q0 + qq) * 33 + lane] = m;
        }
        asm volatile("" ::: "memory");
    }
}

__device__ __forceinline__ void attn_naive(float* lds, const f16* Q16, const f16* K16, const f16* V16, const unsigned long long* MASK, f16* O) {
    const int tid_ = otid(), lane = tid_ & 63, wv = tid_ >> 6, gw = obid() * (NTHREADS / 64) + wv, ngw = gridDim.x * (NTHREADS / 64);
    int* list = (int*)(lds + wv * 640);
    float* pl = lds + wv * 640 + 256;
    float* ql = lds + wv * 640 + 512;
    for (int item = gw; item < MMAIN * 16; item += ngw) {
        const int q = item >> 4, hq = item & 15, b = q >> 11, kvh = hq >> 2;
        int base = 0;
        for (int i = 0; i < 33; ++i) {
            const unsigned long long w = MASK[(size_t)q * 33 + i];
            if ((w >> lane) & 1ull) list[base + __popcll(w & ((1ull << lane) - 1ull))] = 64 * i + lane;
            base += __popcll(w);
        }
        const int nk = base;
        const f16* qp = Q16 + (size_t)q * D + hq * 128;
        ql[lane] = (float)qp[lane]; ql[64 + lane] = (float)qp[64 + lane];
        __builtin_amdgcn_s_waitcnt(0); __builtin_amdgcn_wave_barrier();
        float lg[4]; float mx = -INFINITY;
#pragma unroll
        for (int j = 0; j < 4; ++j) {
            const int kk = lane + 64 * j; lg[j] = -INFINITY;
            if (kk < nk) {
                const f16* kp = K16 + ((size_t)b * TP + list[kk]) * 512 + kvh * 128;
                float dot = 0.f;
#pragma unroll 4
                for (int d = 0; d < 128; d += 4) { const float4 kv = ld4(kp + d); dot += kv.x * ql[d] + kv.y * ql[d + 1] + kv.z * ql[d + 2] + kv.w * ql[d + 3]; }
                lg[j] = dot * 0.08838834764831845f;
            }
            mx = fmaxf(mx, lg[j]);
        }
        mx = wave_max(mx);
        float sm = 0.f;
#pragma unroll
        for (int j = 0; j < 4; ++j) { const int kk = lane + 64 * j; const float e = (kk < nk) ? expf(lg[j] - mx) : 0.f; sm += e; pl[kk] = e; }
        sm = wave_sum(sm);
        __builtin_amdgcn_s_waitcnt(0); __builtin_amdgcn_wave_barrier();
        float o0 = 0.f, o1 = 0.f;
#pragma unroll 2
        for (int kk = 0; kk < nk; ++kk) {
            const f16* vp = V16 + ((size_t)b * TP + list[kk]) * 512 + kvh * 128;
            const float pw = pl[kk];
            o0 = fmaf(pw, (float)vp[lane], o0); o1 = fmaf(pw, (float)vp[64 + lane], o1);
        }
        const float inv = 1.f / sm;
        O[(size_t)q * D + hq * 128 + lane] = (f16)(o0 * inv); O[(size_t)q * D + hq * 128 + 64 + lane] = (f16)(o1 * inv);
        __builtin_amdgcn_s_waitcnt(0); __builtin_amdgcn_wave_barrier();
    }
}

namespace att {
typedef short s16x4 __attribute__((ext_vector_type(4)));
typedef short s16x8 __attribute__((ext_vector_type(8)));
typedef float f32x16 __attribute__((ext_vector_type(16)));
typedef unsigned long long u64;
constexpr int NW = 8, QBLK = 32, KVBLK = 64, QS = 2048, KS = 512;
constexpr int SHM_V = KVBLK * 128 * 2, SHM_K = KVBLK * 128 * 2;
constexpr int LDS_BYTES = 2 * SHM_V + 2 * SHM_K + NW * 64 * 4;
constexpr float SCALE = 0.08838834764831845f, THR = 8.f;
#define AT_KSWZ(row, colB) ((row) * 256 + ((colB) ^ (((row) & 7) << 4)))
#define AT_SBAR() __builtin_amdgcn_sched_barrier(0)
__device__ __forceinline__ int v_st(int k, int c) { const int kk = (k & ~0xC) | ((k & 4) << 1) | ((k & 8) >> 1); return ((kk >> 3) * 4 + (c >> 5)) * 512 + ((kk & 7) * 32 + (c & 31)) * 2; }
__device__ __forceinline__ int v_rd_base(int lane) { return ((lane & 3) << 3) | (((lane >> 2) & 3) << 6) | (((lane >> 4) & 1) << 5) | (((lane >> 5) & 1) << 8); }
constexpr int v_rd_off(int d0, int ks, int half) { return d0 * 512 + ks * 4096 + half * 2048; }
__device__ __forceinline__ int crow(int r, int hi) { return (r & 3) + 8 * (r >> 2) + 4 * hi; }
__device__ __forceinline__ f16x8 load8(const f16* p) { return *(const f16x8*)p; }
__device__ __forceinline__ void mask_bits(f32x16& p0, f32x16& p1, u64 w, int hi) {
    const float NEG = -__builtin_inff();
    const unsigned lo = (unsigned)w >> (4 * hi), up = (unsigned)(w >> 32) >> (4 * hi);
#pragma unroll
    for (int r = 0; r < 16; ++r) {
        const int c = (r & 3) + 8 * (r >> 2);
        if (!((lo >> c) & 1u)) p0[r] = NEG;
        if (!((up >> c) & 1u)) p1[r] = NEG;
    }
}
__device__ __forceinline__ void partialSM(f32x16& p0, f32x16& p1, float& m_reg, float& mn, float& alpha) {
    float pmax = p0[0];
#pragma unroll
    for (int r = 1; r < 16; ++r) pmax = fmaxf(pmax, p0[r]);
#pragma unroll
    for (int r = 0; r < 16; ++r) pmax = fmaxf(pmax, p1[r]);
    { auto rr = __builtin_amdgcn_permlane32_swap(__float_as_uint(pmax), __float_as_uint(pmax), false, false);
      pmax = fmaxf(__uint_as_float(rr[0]), __uint_as_float(rr[1])); }
    constexpr float C2 = 1.4426950408889634f * SCALE;
    if (__builtin_expect(__all((pmax - m_reg) * SCALE <= THR), 1)) { mn = m_reg; alpha = 1.f; }
    else { mn = fmaxf(m_reg, pmax); alpha = __builtin_amdgcn_exp2f((m_reg - mn) * C2); m_reg = mn; }
    const float mnL = -mn * C2;
#pragma unroll
    for (int r = 0; r < 16; ++r) p0[r] = fmaf(p0[r], C2, mnL);
#pragma unroll
    for (int r = 0; r < 16; ++r) p1[r] = fmaf(p1[r], C2, mnL);
#pragma unroll
    for (int r = 0; r < 16; ++r) p0[r] = __builtin_amdgcn_exp2f(p0[r]);
}
__device__ __forceinline__ void finishSM(f32x16& p0, f32x16& p1, float alpha, float& l_reg, f16x8& pa0, f16x8& pa1, f16x8& pa2, f16x8& pa3) {
#pragma unroll
    for (int r = 0; r < 16; ++r) p1[r] = __builtin_amdgcn_exp2f(p1[r]);
    float ps = 0;
#pragma unroll
    for (int r = 0; r < 16; ++r) ps += p0[r];
#pragma unroll
    for (int r = 0; r < 16; ++r) ps += p1[r];
    { auto rr = __builtin_amdgcn_permlane32_swap(__float_as_uint(ps), __float_as_uint(ps), false, false);
      ps = __uint_as_float(rr[0]) + __uint_as_float(rr[1]); }
    l_reg = l_reg * alpha + ps;
#define AT_PK4(P, B_, OUT) do { unsigned a0 = pk2h(P[B_+0], P[B_+1]), a1 = pk2h(P[B_+2], P[B_+3]);                          \
        unsigned b0 = pk2h(P[B_+4], P[B_+5]), b1 = pk2h(P[B_+6], P[B_+7]);                                             \
        auto r0 = __builtin_amdgcn_permlane32_swap(a0, b0, false, false); auto r1 = __builtin_amdgcn_permlane32_swap(a1, b1, false, false); \
        u32x4 w_ = {r0[0], r1[0], r0[1], r1[1]}; OUT = __builtin_bit_cast(f16x8, w_); } while (0)
    AT_PK4(p0, 0, pa0); AT_PK4(p0, 8, pa1); AT_PK4(p1, 0, pa2); AT_PK4(p1, 8, pa3);
#undef AT_PK4
}
template <int KB>
__device__ __forceinline__ void qkt(f32x16& p0, f32x16& p1, LAS const unsigned char* K_lds, int r32, int hi, const f16x8* qr) {
    p0 = f32x16{}; p1 = f32x16{};
    LAS const unsigned char* kb[4];
#pragma unroll
    for (int dd = 0; dd < 4; ++dd) kb[dd] = K_lds + KB * SHM_K + AT_KSWZ(r32, (dd * 16 + hi * 8) * 2);
#pragma unroll
    for (int d0 = 0; d0 < 8; ++d0) { LAS const unsigned char* a = kb[d0 & 3] + (d0 >> 2) * 128;
        const f16x8 b0 = *(LAS const f16x8*)a;
        const f16x8 b1 = *(LAS const f16x8*)(a + 32 * 256);
        p0 = __builtin_amdgcn_mfma_f32_32x32x16_f16(b0, qr[d0], p0, 0, 0, 0);
        p1 = __builtin_amdgcn_mfma_f32_32x32x16_f16(b1, qr[d0], p1, 0, 0, 0); }
}
template <int VB>
__device__ __forceinline__ void pv_tile(f32x16* o, int vb0, f16x8 pa0, f16x8 pa1, f16x8 pa2, f16x8 pa3) {
#define AT_TRRD(dst, off) asm volatile("ds_read_b64_tr_b16 %0, %1 offset:%2" : "=&v"(dst) : "v"(vb0), "i"(off) : "memory")
#define AT_CAT(l, h) __builtin_bit_cast(f16x8, (s16x8){l[0], l[1], l[2], l[3], h[0], h[1], h[2], h[3]})
#define AT_PV_D0(d0) do { s16x4 l0, l1, l2, l3, h0, h1, h2, h3; constexpr int b_ = VB * SHM_V + v_rd_off(d0, 0, 0); \
        AT_TRRD(l0, b_); AT_TRRD(h0, b_ + 2048); AT_TRRD(l1, b_ + 4096); AT_TRRD(h1, b_ + 6144); AT_TRRD(l2, b_ + 8192); AT_TRRD(h2, b_ + 10240); AT_TRRD(l3, b_ + 12288); AT_TRRD(h3, b_ + 14336); \
        asm volatile("s_waitcnt lgkmcnt(0)" ::: "memory"); AT_SBAR();   \
        o[d0] = __builtin_amdgcn_mfma_f32_32x32x16_f16(pa0, AT_CAT(l0, h0), o[d0], 0, 0, 0);   \
        o[d0] = __builtin_amdgcn_mfma_f32_32x32x16_f16(pa1, AT_CAT(l1, h1), o[d0], 0, 0, 0);   \
        o[d0] = __builtin_amdgcn_mfma_f32_32x32x16_f16(pa2, AT_CAT(l2, h2), o[d0], 0, 0, 0);   \
        o[d0] = __builtin_amdgcn_mfma_f32_32x32x16_f16(pa3, AT_CAT(l3, h3), o[d0], 0, 0, 0); } while (0)
    AT_PV_D0(0); AT_PV_D0(1); AT_PV_D0(2); AT_PV_D0(3);
#undef AT_PV_D0
#undef AT_CAT
#undef AT_TRRD
}
struct BlockRef { const f16* Q; const f16* K; const f16* V; f16* O; const u64* M; int NT; };
struct Seam { f16x8 qr[8]; f16x8 st_v0, st_v1, st_k0, st_k1; };
#define AT_ROW(p, k0, rr) ((p) + (size_t)((k0) + (rr)) * KS + sc)
#define AT_VMW() asm volatile("s_waitcnt vmcnt(0)" ::: "memory")
#define AT_VMWN(n) asm volatile("s_waitcnt vmcnt(%0)" :: "i"(n) : "memory")
#define AT_SLOAD_H(Kp, Vp, k0) do { S.st_v0 = load8(AT_ROW(Vp, k0, sr)); S.st_v1 = load8(AT_ROW(Vp, k0, 32 + sr)); S.st_k0 = load8(AT_ROW(Kp, k0, sr)); S.st_k1 = load8(AT_ROW(Kp, k0, 32 + sr)); } while (0)
#define AT_SWRITE_HK(bf) do { *(LAS f16x8*)(K_lds + (bf) * SHM_K + kws) = S.st_k0; *(LAS f16x8*)(K_lds + (bf) * SHM_K + kws + 32 * 256) = S.st_k1; } while (0)
#define AT_SWRITE_HV(bf) do { *(LAS f16x8*)(V_lds + (bf) * SHM_V + vst0) = S.st_v0; *(LAS f16x8*)(V_lds + (bf) * SHM_V + vst1) = S.st_v1; } while (0)
#define AT_SWRITE_H(bf) do { AT_SWRITE_HV(bf); AT_SWRITE_HK(bf); } while (0)
__device__ __forceinline__ void prime(const BlockRef& cur, LAS unsigned char* lds, Seam& S) {
    const int tid = otid(), wid = __builtin_amdgcn_readfirstlane(tid >> 6), lane = tid & 63, r32 = lane & 31, hi = lane >> 5;
    const int sr = tid >> 4, sc = (tid & 15) * 8, kws = AT_KSWZ(sr, sc * 2); LAS unsigned char* K_lds = lds + 2 * SHM_V;
#pragma unroll
    for (int d0 = 0; d0 < 8; ++d0) S.qr[d0] = load8(cur.Q + (size_t)(wid * QBLK + r32) * QS + d0 * 16 + hi * 8);
    AT_SLOAD_H(cur.K, cur.V, 0); AT_VMW(); AT_SWRITE_HK(0);
    __syncthreads();
}
__device__ __forceinline__ void block(const BlockRef& cur, const BlockRef& nxt, LAS unsigned char* lds, Seam& S) {
    const int tid = otid(), wid = __builtin_amdgcn_readfirstlane(tid >> 6), lane = tid & 63, r32 = lane & 31, hi = lane >> 5;
    const int NT = cur.NT;
    LAS unsigned char* V_lds = lds; LAS unsigned char* K_lds = lds + 2 * SHM_V;
    LAS float* ws = (LAS float*)(lds + 2 * SHM_V + 2 * SHM_K) + wid * 64; LAS float* li_l = ws; LAS float* al_l = ws + 32;
    float m_reg = -1e30f, l_reg = 0; f32x16 o[4] = {};
    const int sr = tid >> 4, sc = (tid & 15) * 8, vst0 = v_st(sr, sc), vst1 = v_st(32 + sr, sc), kws = AT_KSWZ(sr, sc * 2);
    const int vb0 = (int)(unsigned)(size_t)V_lds + v_rd_base(lane);
    const f16* Kh = cur.K; const f16* Vh = cur.V;
    const u64* mrow = cur.M + (size_t)(wid * QBLK + r32) * 33;
    u64 mw;
#define AT_RESC(a) do { if (__any((a) < 1.f)) { if (hi == 0) al_l[r32] = (a); asm volatile("s_waitcnt lgkmcnt(0)" ::: "memory");              \
                     for (int d_ = 0; d_ < 4; ++d_) for (int r = 0; r < 16; ++r) o[d_][r] *= al_l[crow(r, hi)]; } } while (0)
#define AT_KBASE(t) ((t) * KVBLK)
#define AT_SEAM_K0() do { AT_VMWN(8); AT_SWRITE_HK(0); AT_SBAR(); } while (0)
    f32x16 pA0, pA1, pB0, pB1; float mnA, mnB, alA, alB; f16x8 pa0, pa1, pa2, pa3;
    AT_SWRITE_HV(0); AT_SBAR();
    mw = mrow[0];
    if (NT > 1) { AT_SLOAD_H(Kh, Vh, AT_KBASE(1)); }
    AT_SBAR(); qkt<0>(pA0, pA1, K_lds, r32, hi, S.qr);
    mask_bits(pA0, pA1, mw, hi); partialSM(pA0, pA1, m_reg, mnA, alA);
    if (NT > 1) { AT_VMW(); AT_SWRITE_H(1); }
    __syncthreads();
#define AT_HALF_STEP(PX0, PX1, mnX, alX, PY0, PY1, alY, t, KB, VB, SB) do {                                                      \
        AT_SBAR(); mw = mrow[(t)]; qkt<KB>(PX0, PX1, K_lds, r32, hi, S.qr);                                             \
        finishSM(PY0, PY1, alY, l_reg, pa0, pa1, pa2, pa3); AT_SBAR();                                                           \
        if ((t) + 1 < NT) { AT_SLOAD_H(Kh, Vh, AT_KBASE((t) + 1)); AT_SBAR(); }                                               \
        pv_tile<VB>(o, vb0, pa0, pa1, pa2, pa3); mask_bits(PX0, PX1, mw, hi); partialSM(PX0, PX1, m_reg, mnX, alX);                                        \
        __syncthreads();                                                                                                      \
        if ((t) + 1 < NT) { AT_VMW(); AT_SWRITE_H(SB); }                                                                          \
        AT_RESC(alX); __syncthreads(); } while (0)
    for (int t = 1; t + 1 < NT; t += 2) {
        AT_HALF_STEP(pB0, pB1, mnB, alB, pA0, pA1, alA, t, 1, 0, 0);
        AT_HALF_STEP(pA0, pA1, mnA, alA, pB0, pB1, alB, t + 1, 0, 1, 1);
    }
    const bool even = (NT & 1) == 0;
    if (even) { AT_SBAR(); mw = mrow[NT - 1]; qkt<1>(pB0, pB1, K_lds, r32, hi, S.qr); AT_SBAR(); }
    AT_SLOAD_H(nxt.K, nxt.V, 0); AT_SBAR();
#pragma unroll
    for (int d0 = 0; d0 < 8; ++d0) S.qr[d0] = load8(nxt.Q + (size_t)(wid * QBLK + r32) * QS + d0 * 16 + hi * 8);
    AT_SBAR();
    finishSM(pA0, pA1, alA, l_reg, pa0, pa1, pa2, pa3); AT_SBAR();
    pv_tile<0>(o, vb0, pa0, pa1, pa2, pa3);
    if (even) { mask_bits(pB0, pB1, mw, hi); partialSM(pB0, pB1, m_reg, mnB, alB); __syncthreads(); AT_RESC(alB);
        finishSM(pB0, pB1, alB, l_reg, pa0, pa1, pa2, pa3); AT_SBAR(); pv_tile<1>(o, vb0, pa0, pa1, pa2, pa3); }
    AT_SBAR(); AT_SEAM_K0();
    if (hi == 0) li_l[r32] = l_reg; asm volatile("s_waitcnt lgkmcnt(0)" ::: "memory");
    float rli[16];
#pragma unroll
    for (int r = 0; r < 16; ++r) rli[r] = __builtin_amdgcn_rcpf(li_l[crow(r, hi)]);
    f16* Ow = cur.O + (size_t)(wid * QBLK) * QS;
#pragma unroll
    for (int r = 0; r < 16; ++r) { const int orow = crow(r, hi);
#pragma unroll
        for (int d0 = 0; d0 < 4; ++d0) { const float v = o[d0][r] * rli[r];
            const float vn = __shfl_xor(v, 1);
            if ((r32 & 1) == 0) *(unsigned*)(Ow + (size_t)orow * QS + d0 * 32 + r32) = pk2h(v, vn); } }
    __syncthreads();
#undef AT_RESC
#undef AT_KBASE
#undef AT_SEAM_K0
#undef AT_HALF_STEP
}
#undef AT_ROW
#undef AT_VMW
#undef AT_VMWN
#undef AT_SLOAD_H
#undef AT_SWRITE_HK
#undef AT_SWRITE_HV
#undef AT_SWRITE_H
}
__device__ __forceinline__ att::BlockRef att_unit(const f16* Q16, const f16* K16, const f16* V16, const unsigned long long* MASK, f16* O16, int b, int h, int x) {
    att::BlockRef r; const size_t row0 = (size_t)b * SEQ + 256 * x; const int kvh = h >> 2;
    r.Q = Q16 + row0 * D + h * 128; r.K = K16 + (size_t)b * TP * 512 + kvh * 128; r.V = V16 + (size_t)b * TP * 512 + kvh * 128;
    r.O = O16 + row0 * D + h * 128; r.M = MASK + row0 * 33; r.NT = 4 * x + 5; return r;
}
__device__ __forceinline__ void attn_phase(LAS unsigned char* lds, const f16* Q16, const f16* K16, const f16* V16, const unsigned long long* MASK, f16* O16) {
    const int bid = obid();
    if (bid < 256) {
        const int xcd = bid & 7, j = bid >> 3, combo = xcd * 2 + (j & 1), item = j >> 1, hl = item >> 2, pp = item & 3;
        const int b = combo >> 2, kvh = combo & 3, h = kvh * 4 + hl;
        const att::BlockRef u0 = att_unit(Q16, K16, V16, MASK, O16, b, h, 7 - pp), u1 = att_unit(Q16, K16, V16, MASK, O16, b, h, pp);
        att::Seam S;
        att::prime(u0, lds, S);
        att::block(u0, u1, lds, S);
        att::block(u1, u1, lds, S);
    }
}

template <class F>
__device__ __forceinline__ void gemm(LAS unsigned char* lds, const f16* A, int lda, const f16* Bt, int ldb, int M, int N, int K, int cu, F f) {
    pg8::Gemm g{A, Bt, M, N, K, lda, ldb};
    pg8::StaticOrder S; S.init(M, N, (int)gridDim.x, cu);
    pg8::EpiRow8<F> E{f};
    pg8::gemm_phase<pg8::EpiRow8<F>, pg8::StaticOrder, true, true>(lds, g, S, E);
}

template <int KSPLIT, class F>
__device__ __forceinline__ void skinny_tile(LAS unsigned char* lds, const f16* A, int lda, const f16* Bt, int ldb, int K, int n0, F f) {
    constexpr int NT = 8 / KSPLIT, TW = NT * 16 + 4;
    const int tid = otid(), lane = tid & 63, wv = __builtin_amdgcn_readfirstlane(tid >> 6), l15 = lane & 15, g2 = lane >> 4;
    const int ti = wv / KSPLIT, kq = wv % KSPLIT, klen = K / KSPLIT;
    const f16* ap = A + (size_t)l15 * lda + kq * klen + 8 * g2;
    const f16* bp = Bt + (size_t)(n0 + 16 * ti + l15) * ldb + kq * klen + 8 * g2;
    f32x4 acc0 = {0.f, 0.f, 0.f, 0.f}, acc1 = {0.f, 0.f, 0.f, 0.f};
#pragma unroll 8
    for (int k = 0; k < klen; k += 64) {
        const f16x8 a0 = *(const f16x8*)(ap + k), b0 = *(const f16x8*)(bp + k), a1 = *(const f16x8*)(ap + k + 32), b1 = *(const f16x8*)(bp + k + 32);
        acc0 = __builtin_amdgcn_mfma_f32_16x16x32_f16(a0, b0, acc0, 0, 0, 0);
        acc1 = __builtin_amdgcn_mfma_f32_16x16x32_f16(a1, b1, acc1, 0, 0, 0);
    }
    __builtin_amdgcn_sched_barrier(0);
    asm volatile("s_nop 15\n\ts_nop 15" ::: "memory");
    __builtin_amdgcn_sched_barrier(0);
    LAS f32x4* RED = (LAS f32x4*)lds;
    LAS float* Tl = (LAS float*)(lds + 8192);
    RED[wv * 64 + lane] = acc0 + acc1;
    __syncthreads();
    if (tid < 64 * NT) {
        f32x4 v = RED[(wv * KSPLIT) * 64 + lane];
#pragma unroll
        for (int q = 1; q < KSPLIT; ++q) v = v + RED[(wv * KSPLIT + q) * 64 + lane];
#pragma unroll
        for (int j = 0; j < 4; ++j) Tl[(4 * g2 + j) * TW + 16 * wv + l15] = v[j];
    }
    __syncthreads();
    if (tid < 16 * NT * 4) {
        const int row = tid / (NT * 4), c4 = (tid % (NT * 4)) * 4;
        const f32x4 v = {Tl[row * TW + c4], Tl[row * TW + c4 + 1], Tl[row * TW + c4 + 2], Tl[row * TW + c4 + 3]};
        f(row, n0 + c4, v, (const LAS float*)Tl, TW, n0);
    }
    __syncthreads();
}
__device__ __forceinline__ void st4hv(f16* p, f32x4 v) { uint2 r; r.x = pk2h(v[0], v[1]); r.y = pk2h(v[2], v[3]); *(uint2*)p = r; }

__device__ __forceinline__ void idx_cols(LAS unsigned char* lds, const f16* A16, const f16* Wt, const CinOut& o) {
    const int tid = otid(), lane = tid & 63, wv = __builtin_amdgcn_readfirstlane(tid >> 6), l15 = lane & 15, g2 = lane >> 4;
    const int sub = wv >> 2, kq = wv & 3;
    LAS f32x4* RED = (LAS f32x4*)lds;
    const int bid_ = obid(), nmain = (512 - 2 * bid_ + 2 * (int)gridDim.x - 1) / (2 * (int)gridDim.x);
    for (int it = 0; it < nmain + (bid_ == 128 ? 1 : 0); ++it) {
        const int rt0 = (it < nmain) ? 2 * bid_ + 2 * (int)gridDim.x * it : 512;
        const int rt = rt0 + sub; const bool act = rt < 513 && (rt0 < 512 || sub == 0);
        f32x4 acc[5];
#pragma unroll
        for (int nt = 0; nt < 5; ++nt) acc[nt] = (f32x4){0.f, 0.f, 0.f, 0.f};
        if (act) {
            const f16* ap = A16 + (size_t)(rt * 16 + l15) * D + kq * 512 + 8 * g2;
            const f16* bp = Wt + (size_t)l15 * D + kq * 512 + 8 * g2;
#pragma unroll 4
            for (int k = 0; k < 512; k += 32) {
                const f16x8 a = *(const f16x8*)(ap + k);
#pragma unroll
                for (int nt = 0; nt < 5; ++nt) { const f16x8 bb = *(const f16x8*)(bp + (size_t)nt * 16 * D + k); acc[nt] = __builtin_amdgcn_mfma_f32_16x16x32_f16(a, bb, acc[nt], 0, 0, 0); }
            }
        }
        __builtin_amdgcn_sched_barrier(0);
        asm volatile("s_nop 15\n\ts_nop 15" ::: "memory");
        __builtin_amdgcn_sched_barrier(0);
#pragma unroll
        for (int nt = 0; nt < 5; ++nt) RED[((sub * 4 + kq) * 5 + nt) * 64 + lane] = acc[nt];
        __syncthreads();
        if (kq == 0 && act) {
            const int r0 = rt * 16 + 4 * g2;
#pragma unroll
            for (int nt = 0; nt < 5; ++nt) {
                f32x4 v = RED[((sub * 4 + 0) * 5 + nt) * 64 + lane];
                v = v + RED[((sub * 4 + 1) * 5 + nt) * 64 + lane]; v = v + RED[((sub * 4 + 2) * 5 + nt) * 64 + lane]; v = v + RED[((sub * 4 + 3) * 5 + nt) * 64 + lane];
#pragma unroll
                for (int j = 0; j < 4; ++j) {
                    const int r = r0 + j; const bool mainrow = r < MMAIN;
                    const int t = mainrow ? (r & 2047) + NMETA : r - MMAIN, b = r >> 11;
                    float x = v[j];
                    if (nt == 0) { const float oth = __shfl_xor(x, 8); const float2 cs = o.R8[t * 8 + (l15 & 7)]; x = (l15 < 8) ? x * cs.x - oth * cs.y : x * cs.x + oth * cs.y; }
                    if (nt < 4) {
                        if (mainrow) o.KI16[((size_t)b * TP + t) * 64 + 16 * nt + l15] = (f16)x;
                        else { for (int bb = 0; bb < 4; ++bb) o.KI16[((size_t)bb * TP + t) * 64 + 16 * nt + l15] = (f16)x; }
                    } else if (mainrow) o.WI[(size_t)r * 16 + l15] = x * 0.03125f;
                }
            }
        }
        __syncthreads();
    }
}
__device__ __forceinline__ void cin_meta_kv(const CinOut& o, int row, int c, f32x4 v, const LAS float* Tl, int TW, int n0) {
    const bool isk = c < 2560; const int cl = (c - 2048) & 127;
    if (isk && cl < 32) {
        const int pc = (c - n0) ^ 16;
#pragma unroll
        for (int e = 0; e < 4; ++e) { const float2 cs = o.R16[row * 16 + ((cl + e) & 15)]; const float oth = Tl[row * TW + pc + e];
            v[e] = (cl < 16) ? v[e] * cs.x - oth * cs.y : v[e] * cs.x + oth * cs.y; }
    }
    f16* dst = isk ? o.K16 : o.V16; const int cc = isk ? c - 2048 : c - 2560;
    for (int bb = 0; bb < 4; ++bb) st4hv(dst + ((size_t)bb * TP + row) * 512 + cc, v);
}

#define XB_TMO      128
#define XB_XCNT(j)  (256  + 64 * (j))
#define XB_XSUB(j)  (1280 + 64 * (j))
#define XB_XGEN(j)  (2304 + 64 * (j))
#define XB_TOP      3328
#define XB_TOPGEN   3392
#define XCD_BAR_WORDS 3456
#define XB_SPIN_CAP (1u << 18)

__device__ __forceinline__ unsigned xb_ld(unsigned* p)              { return __hip_atomic_load(p, __ATOMIC_RELAXED, __HIP_MEMORY_SCOPE_AGENT); }
__device__ __forceinline__ unsigned xb_add(unsigned* p, unsigned v) { return __hip_atomic_fetch_add(p, v, __ATOMIC_RELAXED, __HIP_MEMORY_SCOPE_AGENT); }
__device__ __forceinline__ unsigned xb_xcc_id() { return (unsigned)__builtin_amdgcn_s_getreg((3 << 11) | 20) & 0xFu; }
#define XB_SPIN(cond, bar) do { unsigned _sp = 0; while (cond) { __builtin_amdgcn_s_sleep(1); \
    if ((++_sp & 255u) == 0u) { if (xb_ld(&(bar)[XB_TMO])) break; if (_sp > XB_SPIN_CAP) { atomicAdd(&(bar)[XB_TMO], 1u); break; } } } } while (0)

struct XcdBarrier {
    unsigned* bar; unsigned x;
    volatile LAS unsigned* st;
};

__device__ __forceinline__ XcdBarrier xcd_barrier_post(unsigned* bar, volatile LAS unsigned* st) {
    XcdBarrier b; b.bar = bar; b.x = xb_xcc_id(); b.st = st;
    if (threadIdx.x == 0) (void)xb_add(&bar[XB_XCNT(b.x)], 1u);
    return b;
}
__device__ __forceinline__ void xcd_barrier_complete(unsigned* bar, unsigned x, unsigned& nloc, unsigned& nx) {
    const unsigned G = gridDim.x * gridDim.y * gridDim.z;
    unsigned sum, cnt, mine, sp = 0u;
    for (;;) {
        sum = 0u; cnt = 0u; mine = 0u;
#pragma unroll
        for (unsigned j = 0; j < 16; ++j) { const unsigned c = xb_ld(&bar[XB_XCNT(j)]); sum += c; cnt += (c > 0u) ? 1u : 0u; mine = (j == x) ? c : mine; }
        if (sum == G) break;
        __builtin_amdgcn_s_sleep(1);
        if ((++sp & 255u) == 0u) { if (xb_ld(&bar[XB_TMO])) break; if (sp > XB_SPIN_CAP) { atomicAdd(&bar[XB_TMO], 1u); break; } }
    }
    nloc = mine > 0u ? mine : 1u; nx = cnt > 0u ? cnt : 1u;
}

__device__ __forceinline__ void xcd_barrier(const XcdBarrier& b) {
    asm volatile("s_waitcnt vmcnt(0)" ::: "memory");
    __syncthreads();
    if (threadIdx.x == 0) {
        unsigned* bar = b.bar;
        __builtin_amdgcn_s_waitcnt(0);
        unsigned nloc = b.st[0], nx = b.st[1];
        if (nloc == 0u) { xcd_barrier_complete(bar, b.x, nloc, nx); b.st[0] = nloc; b.st[1] = nx; }
        const unsigned old = xb_add(&bar[XB_XSUB(b.x)], 1u);
        const unsigned gen = old / nloc;
        if (old + 1u == (gen + 1u) * nloc) {
            __builtin_amdgcn_fence(__ATOMIC_RELEASE, "agent");
            asm volatile("s_waitcnt vmcnt(0)" ::: "memory");
            const unsigned og = xb_add(&bar[XB_TOP], 1u);
            const unsigned tg = og / nx;
            if (og + 1u == (tg + 1u) * nx) xb_add(&bar[XB_TOPGEN], 1u);
            else XB_SPIN(xb_ld(&bar[XB_TOPGEN]) == tg, bar);
            __builtin_amdgcn_fence(__ATOMIC_ACQUIRE, "agent");
            xb_add(&bar[XB_XGEN(b.x)], 1u);
            asm volatile("s_waitcnt vmcnt(0)" ::: "memory");
        } else {
            XB_SPIN(xb_ld(&bar[XB_XGEN(b.x)]) == gen, bar);
            __builtin_amdgcn_fence(__ATOMIC_ACQUIRE, "agent");
            asm volatile("s_waitcnt vmcnt(0)" ::: "memory");
        }
    }
    __syncthreads();
}

__global__ void __launch_bounds__(NTHREADS, 2) fwd(Params p) {
    cg::grid_group grid = cg::this_grid();
    extern __shared__ __attribute__((aligned(16))) unsigned char smem[];
    LAS unsigned char* lds = (LAS unsigned char*)smem;
    float* ldsf = (float*)smem;
    unsigned char* ws = p.ws;
    float* H = (float*)(ws + OFF_H); f16* A16 = (f16*)(ws + OFF_A16); f16* U16 = (f16*)(ws + OFF_U16);
    f16* DY16 = (f16*)(ws + OFF_DY16); f16* CAT16 = (f16*)(ws + OFF_CAT16);
    f16* HID16 = (f16*)(ws + OFF_BIG);
    CinOut co{(f16*)(ws + OFF_Q16), (f16*)(ws + OFF_K16), (f16*)(ws + OFF_V16), (f16*)(ws + OFF_QI16), (f16*)(ws + OFF_KI16), (float*)(ws + OFF_WI), (const float2*)(ws + OFF_ROPE16), (const float2*)(ws + OFF_ROPE8)};
    float* SCORE = (float*)(ws + OFF_SCORE); unsigned long long* MASK = (unsigned long long*)(ws + OFF_MASK); f16* O16 = (f16*)(ws + OFF_O16);
    const float* ng = p.in[I_NORMG];
    const int bid = (int)blockIdx.x, G = (int)gridDim.x;
    volatile LAS unsigned* bst = (volatile LAS unsigned*)(lds + LDS_BYTES - 64);
    if (threadIdx.x < 16) bst[threadIdx.x] = 0u;
    __syncthreads();
    const XcdBarrier xbar = xcd_barrier_post((unsigned*)(ws + OFF_BAR), bst);

    const f16* A16m = A16 + (size_t)MMAIN * D; f16* U16m = U16 + (size_t)MMAIN * D; const f16* DY16m = DY16 + (size_t)MMAIN * D; f16* CAT16m = CAT16 + (size_t)MMAIN * D; f16* HID16m = HID16 + (size_t)MMAIN * DFF;
    for (int rep_ = 0; rep_ < (((PROBE_MASK >> 0) & 1) ? 2 : 1); ++rep_) {
    convert_weights(p, ldsf);
    init_rows(p, H, A16);
    build_rope((float2*)(ws + OFF_ROPE16), (float2*)(ws + OFF_ROPE8));
    grid.sync();
    }
    for (int rep_ = 0; rep_ < (((PROBE_MASK >> 1) & 1) ? 2 : 1); ++rep_) {
    for (int gi = bid; gi < 64; gi += G)
        skinny_tile<4>(lds, A16m, D, (const f16*)(ws + W_IN), D, D, 32 * gi, [=](int r, int c, f32x4 v, const LAS float*, int, int) { st4hv(U16m + (size_t)r * D + c, v); });
    gemm(lds, A16, D, (const f16*)(ws + W_IN), D, MMAIN, D, D, bid, [=](int r, int c, f32x4 v0, f32x4 v1) { st8h(U16 + (size_t)r * D + c, v0, v1); });
    xcd_barrier(xbar);
    }
    for (int rep_ = 0; rep_ < (((PROBE_MASK >> 2) & 1) ? 2 : 1); ++rep_) {
    pool_diff(U16, DY16);
    ssm_phase(p, U16, DY16, lds);
    xcd_barrier(xbar);
    }
    for (int rep_ = 0; rep_ < (((PROBE_MASK >> 3) & 1) ? 2 : 1); ++rep_) {
    for (int gi = bid; gi < 64; gi += G) {
        if (gi < 32) { const int g = gi >> 3, n0 = 32 * (gi & 7); const float* ps = p.in[I_POOLS] + g * 256;
            skinny_tile<4>(lds, DY16m + g * 256, D, (const f16*)(ws + W_POOL) + (size_t)g * 65536, 256, 256, n0,
                         [=](int r, int c, f32x4 v, const LAS float*, int, int) { st4hv(CAT16m + (size_t)r * D + g * 256 + c, v * *(const f32x4*)(ps + c)); });
        } else {
            skinny_tile<4>(lds, DY16m + 1024, D, (const f16*)(ws + W_GLU), 1024, 1024, 32 * (gi - 32), [=](int r, int c, f32x4 v, const LAS float*, int, int) {
                const float4 y = ld4(DY16m + (size_t)r * D + 1024 + c);
                f32x4 o; o[0] = y.x / (1.f + __expf(-v[0])); o[1] = y.y / (1.f + __expf(-v[1])); o[2] = y.z / (1.f + __expf(-v[2])); o[3] = y.w / (1.f + __expf(-v[3]));
                st4hv(CAT16m + (size_t)r * D + 1024 + c, o); });
        }
    }
    for (int g = 0; g < 4; ++g) {
        const float* ps = p.in[I_POOLS] + g * 256;
        gemm(lds, DY16 + g * 256, D, (const f16*)(ws + W_POOL) + (size_t)g * 65536, 256, MMAIN, 256, 256, (bid + G - 32 * g) % G,
             [=](int r, int c, f32x4 v0, f32x4 v1) { const f32x4 s0 = *(const f32x4*)(ps + c), s1 = *(const f32x4*)(ps + c + 4); st8h(CAT16 + (size_t)r * D + g * 256 + c, v0 * s0, v1 * s1); });
    }
    gemm(lds, DY16 + 1024, D, (const f16*)(ws + W_GLU), 1024, MMAIN, 1024, 1024, (bid + G - 128) % G,
         [=](int r, int c, f32x4 v0, f32x4 v1) {
             const f16* yp = DY16 + (size_t)r * D + 1024 + c; const float4 y0 = ld4(yp), y1 = ld4(yp + 4);
             f32x4 o0, o1;
             o0[0] = y0.x / (1.f + __expf(-v0[0])); o0[1] = y0.y / (1.f + __expf(-v0[1])); o0[2] = y0.z / (1.f + __expf(-v0[2])); o0[3] = y0.w / (1.f + __expf(-v0[3]));
             o1[0] = y1.x / (1.f + __expf(-v1[0])); o1[1] = y1.y / (1.f + __expf(-v1[1])); o1[2] = y1.z / (1.f + __expf(-v1[2])); o1[3] = y1.w / (1.f + __expf(-v1[3]));
             st8h(CAT16 + (size_t)r * D + 1024 + c, o0, o1); });
    xcd_barrier(xbar);
    }
    for (int rep_ = 0; rep_ < (((PROBE_MASK >> 4) & 1) ? 2 : 1); ++rep_) {
    for (int gi = bid; gi < 64; gi += G)
        skinny_tile<4>(lds, CAT16m, D, (const f16*)(ws + W_OUT), D, D, 32 * gi, [=](int r, int c, f32x4 v, const LAS float*, int, int) { st4hv(U16m + (size_t)r * D + c, v); });
    gemm(lds, CAT16, D, (const f16*)(ws + W_OUT), D, MMAIN, D, D, bid, [=](int r, int c, f32x4 v0, f32x4 v1) { st8h(U16 + (size_t)r * D + c, v0, v1); });
    xcd_barrier(xbar);
    }
    rowpass(U16, ng + 1 * D, ng + 2 * D, H, A16, nullptr, MREAL);
    xcd_barrier(xbar);
    for (int rep_ = 0; rep_ < (((PROBE_MASK >> 6) & 1) ? 2 : 1); ++rep_) {
    for (int gi = bid; gi < 256; gi += G)
        skinny_tile<4>(lds, A16m, D, (const f16*)(ws + W_1), D, D, 32 * gi, [=](int r, int c, f32x4 v, const LAS float*, int, int) {
            const f32x4 z = __builtin_elementwise_max(v, (f32x4){0.f, 0.f, 0.f, 0.f}); st4hv(HID16m + (size_t)r * DFF + c, z * z); });
    gemm(lds, A16, D, (const f16*)(ws + W_1), D, MMAIN, DFF, D, bid, [=](int r, int c, f32x4 v0, f32x4 v1) {
        f32x4 z0 = __builtin_elementwise_max(v0, (f32x4){0.f, 0.f, 0.f, 0.f}), z1 = __builtin_elementwise_max(v1, (f32x4){0.f, 0.f, 0.f, 0.f}); st8h(HID16 + (size_t)r * DFF + c, z0 * z0, z1 * z1); });
    xcd_barrier(xbar);
    }
    for (int rep_ = 0; rep_ < (((PROBE_MASK >> 7) & 1) ? 2 : 1); ++rep_) {
    for (int gi = bid; gi < 128; gi += G)
        skinny_tile<8>(lds, HID16m, DFF, (const f16*)(ws + W_2), DFF, DFF, 16 * gi, [=](int r, int c, f32x4 v, const LAS float*, int, int) { st4hv(U16m + (size_t)r * D + c, v); });
    gemm(lds, HID16, DFF, (const f16*)(ws + W_2), DFF, MMAIN, D, DFF, bid, [=](int r, int c, f32x4 v0, f32x4 v1) { st8h(U16 + (size_t)r * D + c, v0, v1); });
    xcd_barrier(xbar);
    }
    rowpass(U16, ng + 3 * D, ng + 4 * D, H, A16, nullptr, MREAL);
    zero_kv_pads(co.K16, co.V16, co.KI16);
    xcd_barrier(xbar);
    for (int rep_ = 0; rep_ < (((PROBE_MASK >> 9) & 1) ? 2 : 1); ++rep_) {
    idx_cols(lds, A16, (const f16*)(ws + W_CIN) + (size_t)4096 * D, co);
    for (int gi = bid; gi < 32; gi += G)
        skinny_tile<4>(lds, A16m, D, (const f16*)(ws + W_CIN), D, D, 2048 + 32 * gi, [=](int r, int c, f32x4 v, const LAS float* Tl, int TW, int n0) { cin_meta_kv(co, r, c, v, Tl, TW, n0); });
    gemm(lds, A16, D, (const f16*)(ws + W_CIN), D, MMAIN, 4096, D, bid, [=](int r, int c, f32x4 v0, f32x4 v1) { cin_epilogue(co, r, c, v0, v1); });
    xcd_barrier(xbar);
    }
    for (int rep_ = 0; rep_ < (((PROBE_MASK >> 10) & 1) ? 2 : 1); ++rep_) {
    index_select(co.QI16, co.KI16, co.WI, MASK, lds);
    xcd_barrier(xbar);
    }
    for (int rep_ = 0; rep_ < (((PROBE_MASK >> 12) & 1) ? 2 : 1); ++rep_) {
    attn_phase(lds, co.Q16, co.K16, co.V16, MASK, O16);
    xcd_barrier(xbar);
    }
    for (int rep_ = 0; rep_ < (((PROBE_MASK >> 13) & 1) ? 2 : 1); ++rep_) {
    gemm(lds, O16, D, (const f16*)(ws + W_COUT), D, MMAIN, D, D, bid, [=](int r, int c, f32x4 v0, f32x4 v1) { st8h(U16 + (size_t)r * D + c, v0, v1); });
    xcd_barrier(xbar);
    }
    rowpass(U16, ng + 5 * D, ng + 6 * D, H, A16, nullptr, MMAIN);
    xcd_barrier(xbar);
    for (int rep_ = 0; rep_ < (((PROBE_MASK >> 15) & 1) ? 2 : 1); ++rep_) {
    gemm(lds, A16, D, (const f16*)(ws + W_1) + (size_t)D * DFF, D, MMAIN, DFF, D, bid, [=](int r, int c, f32x4 v0, f32x4 v1) {
        f32x4 z0 = __builtin_elementwise_max(v0, (f32x4){0.f, 0.f, 0.f, 0.f}), z1 = __builtin_elementwise_max(v1, (f32x4){0.f, 0.f, 0.f, 0.f}); st8h(HID16 + (size_t)r * DFF + c, z0 * z0, z1 * z1); });
    xcd_barrier(xbar);
    }
    for (int rep_ = 0; rep_ < (((PROBE_MASK >> 16) & 1) ? 2 : 1); ++rep_) {
    gemm(lds, HID16, DFF, (const f16*)(ws + W_2) + (size_t)D * DFF, DFF, MMAIN, D, DFF, bid, [=](int r, int c, f32x4 v0, f32x4 v1) { st8h(U16 + (size_t)r * D + c, v0, v1); });
    xcd_barrier(xbar);
    }
    rowpass(U16, ng + 7 * D, nullptr, H, nullptr, p.out, MMAIN);
}

extern "C" void kernel_launch(void* const* d_in, const int* in_sizes, int n_in, void* d_out, int out_size, void* d_ws, size_t ws_size, hipStream_t stream) {
    static int grid_blocks = 0;
    if (!grid_blocks) {
        if (n_in != 20 || out_size != MMAIN * D || ws_size < WS_NEED) { fprintf(stderr, "kernel_launch: unexpected shapes n_in %d out %d ws %zu (need %zu)\n", n_in, out_size, ws_size, (size_t)WS_NEED); grid_blocks = -1; return; }
        int dev = 0, cus = 0, per_cu = 0;
        (void)hipGetDevice(&dev);
        (void)hipDeviceGetAttribute(&cus, hipDeviceAttributeMultiprocessorCount, dev);
        if (hipFuncSetAttribute((const void*)fwd, hipFuncAttributeMaxDynamicSharedMemorySize, LDS_BYTES) != hipSuccess) { fprintf(stderr, "kernel_launch: hipFuncSetAttribute failed\n"); grid_blocks = -1; return; }
        (void)hipOccupancyMaxActiveBlocksPerMultiprocessor(&per_cu, fwd, NTHREADS, LDS_BYTES);
        if (per_cu < 1) { fprintf(stderr, "kernel_launch: occupancy query says %d blocks per CU\n", per_cu); per_cu = 1; }
        grid_blocks = cus;
    }
    if (grid_blocks < 0) return;
    Params p{};
    for (int i = 0; i < 20; ++i) p.in[i] = (const float*)d_in[i];
    p.out = (float*)d_out; p.ws = (unsigned char*)d_ws;
    if (hipMemsetAsync((char*)d_ws + OFF_BAR, 0, SZ_BAR, stream) != hipSuccess) { fprintf(stderr, "kernel_launch: hipMemsetAsync failed\n"); return; }
    void* args[] = {&p};
    hipError_t e = hipLaunchCooperativeKernel((void*)fwd, dim3(grid_blocks), dim3(NTHREADS), args, LDS_BYTES, stream);
    if (e != hipSuccess) fprintf(stderr, "cooperative launch failed: %s (grid %d)\n", hipGetErrorString(e), grid_blocks);
}
```
